# Optimizing an MI355X kernel written in HIP

```python
import math
import jax, jax.numpy as jnp
from jax import lax
import numpy as np

D_MODEL = 1024
BATCH = 2
SEQ = 8192
DEPTH = 1

SSM_GROUP = 16
N_SSM_GROUPS = 32
SSM_WIDTH = SSM_GROUP * N_SSM_GROUPS
SSM_STATE = 64
DT_MIN = 0.001
DT_MAX = 0.1
N_HEADS = 8
HEAD_DIM = 64
ATTN_WIDTH = N_HEADS * HEAD_DIM
MOBA_BLOCK = 256
MOBA_TOPK = 3
Q_CHUNK = 128
ROPE_THETA = 10000.0
D_FF = 2816
RMS_EPS = 1e-6
NEG_INF = -1e30
IN_WIDTH = SSM_WIDTH + 3 * ATTN_WIDTH + 2 * D_MODEL

kernel_name = "hybrid_s5_moba_macaron_block"


def rmsnorm(x, gain):
    xf = x.astype(jnp.float32)
    inv = lax.rsqrt(jnp.mean(xf * xf, axis=-1, keepdims=True) + RMS_EPS)
    return (xf * inv).astype(x.dtype) * gain


def swiglu(h, w_gate, w_up, w_down):
    return (jax.nn.silu(h @ w_gate) * (h @ w_up)) @ w_down


def rotary(x):
    L = x.shape[1]
    pos = jnp.arange(L, dtype=jnp.float32)
    inv_freq = ROPE_THETA ** (-jnp.arange(0, HEAD_DIM, 2, dtype=jnp.float32) / HEAD_DIM)
    ang = pos[:, None] * inv_freq[None, :]
    cos = jnp.cos(ang)[None, :, None, :].astype(x.dtype)
    sin = jnp.sin(ang)[None, :, None, :].astype(x.dtype)
    x1, x2 = jnp.split(x, 2, axis=-1)
    return jnp.concatenate([x1 * cos - x2 * sin, x2 * cos + x1 * sin], axis=-1)


def _complex_linear_combine(e1, e2):
    a1r, a1i, b1r, b1i = e1
    a2r, a2i, b2r, b2i = e2
    ar = a2r * a1r - a2i * a1i
    ai = a2r * a1i + a2i * a1r
    br = a2r * b1r - a2i * b1i + b2r
    bi = a2r * b1i + a2i * b1r + b2i
    return (ar, ai, br, bi)


def s5_mixer(u, a_re, a_im, b_re, b_im, c_re, c_im, d, log_dt):
    Bsz, L, _ = u.shape
    ug = u.astype(jnp.float32).reshape(Bsz, L, N_SSM_GROUPS, SSM_GROUP)
    dt = jnp.exp(log_dt.astype(jnp.float32))[:, None]
    ar = a_re.astype(jnp.float32)
    ai = a_im.astype(jnp.float32)
    mag = jnp.exp(ar * dt)
    abar_r = mag * jnp.cos(ai * dt)
    abar_i = mag * jnp.sin(ai * dt)
    den = ar * ar + ai * ai
    nr = abar_r - 1.0
    ni = abar_i
    fr = ((nr * ar + ni * ai) / den)[..., None]
    fi = ((ni * ar - nr * ai) / den)[..., None]
    br = b_re.astype(jnp.float32)
    bi = b_im.astype(jnp.float32)
    bbar_r = fr * br - fi * bi
    bbar_i = fr * bi + fi * br
    bu_r = jnp.einsum('blgh,gph->blgp', ug, bbar_r)
    bu_i = jnp.einsum('blgh,gph->blgp', ug, bbar_i)
    a_r = jnp.broadcast_to(abar_r, bu_r.shape)
    a_i = jnp.broadcast_to(abar_i, bu_i.shape)
    _, _, xr, xi = lax.associative_scan(_complex_linear_combine, (a_r, a_i, bu_r, bu_i), axis=1)
    y = (jnp.einsum('blgp,ghp->blgh', xr, c_re.astype(jnp.float32))
         - jnp.einsum('blgp,ghp->blgh', xi, c_im.astype(jnp.float32))
         + d.astype(jnp.float32).reshape(N_SSM_GROUPS, SSM_GROUP) * ug)
    return y.reshape(Bsz, L, SSM_WIDTH).astype(u.dtype)


def moba_attention(q, k, v):
    Bsz, H, L, Dh = q.shape
    nb = -(-L // MOBA_BLOCK)
    pad = nb * MOBA_BLOCK - L
    kp = jnp.pad(k, ((0, 0), (0, 0), (0, pad), (0, 0)))
    vp = jnp.pad(v, ((0, 0), (0, 0), (0, pad), (0, 0)))
    kb = kp.reshape(Bsz, H, nb, MOBA_BLOCK, Dh)
    vb = vp.reshape(Bsz, H, nb, MOBA_BLOCK, Dh)
    kmean = jnp.mean(kb.astype(jnp.float32), axis=3)
    ksel = min(MOBA_TOPK, nb)
    scale = HEAD_DIM ** -0.5
    bi = jnp.arange(Bsz)[:, None, None, None]
    hi = jnp.arange(H)[None, :, None, None]
    blk_ids = jnp.arange(nb)

    def chunk(c):
        q0 = c * Q_CHUNK
        qc = lax.dynamic_slice_in_dim(q, q0, Q_CHUNK, axis=2)
        cur = q0 // MOBA_BLOCK
        gate = jnp.einsum('bhqd,bhnd->bhqn', qc.astype(jnp.float32), kmean)
        gate = jnp.where(blk_ids < cur, gate, NEG_INF)
        _, idx = lax.top_k(gate, ksel)
        valid = idx < cur
        kg = kb[bi, hi, idx]
        vg = vb[bi, hi, idx]
        s_sel = jnp.einsum('bhqd,bhqskd->bhqsk', qc, kg).astype(jnp.float32) * scale
        s_sel = jnp.where(valid[..., None], s_sel, NEG_INF).reshape(Bsz, H, Q_CHUNK, ksel * MOBA_BLOCK)
        k_own = lax.dynamic_slice_in_dim(kp, cur * MOBA_BLOCK, MOBA_BLOCK, axis=2)
        v_own = lax.dynamic_slice_in_dim(vp, cur * MOBA_BLOCK, MOBA_BLOCK, axis=2)
        s_own = jnp.einsum('bhqd,bhkd->bhqk', qc, k_own).astype(jnp.float32) * scale
        qpos = q0 + jnp.arange(Q_CHUNK)
        kpos = cur * MOBA_BLOCK + jnp.arange(MOBA_BLOCK)
        s_own = jnp.where(kpos[None, :] <= qpos[:, None], s_own, NEG_INF)
        p = jax.nn.softmax(jnp.concatenate([s_sel, s_own], axis=-1), axis=-1)
        p_sel = p[..., :ksel * MOBA_BLOCK].reshape(Bsz, H, Q_CHUNK, ksel, MOBA_BLOCK).astype(v.dtype)
        p_own = p[..., ksel * MOBA_BLOCK:].astype(v.dtype)
        return (jnp.einsum('bhqsk,bhqskd->bhqd', p_sel, vg)
                + jnp.einsum('bhqk,bhkd->bhqd', p_own, v_own))

    outs = lax.map(chunk, jnp.arange(L // Q_CHUNK))
    return outs.transpose(1, 0, 3, 2, 4).reshape(Bsz, L, H * Dh)


def hybrid_mixer(h, w_in, a_re, a_im, b_re, b_im, c_re, c_im, d, log_dt,
                 glu_w, glu_b, w_branch_ssm, w_branch_attn, w_out):
    Bsz, L, _ = h.shape
    proj = h @ w_in
    offs = np.cumsum([SSM_WIDTH, ATTN_WIDTH, ATTN_WIDTH, ATTN_WIDTH, D_MODEL]).tolist()
    u, q, k, v, g_ssm, g_attn = jnp.split(proj, offs, axis=-1)
    y_ssm = jax.nn.gelu(s5_mixer(u, a_re, a_im, b_re, b_im, c_re, c_im, d, log_dt))
    y_ssm = y_ssm * jax.nn.sigmoid(y_ssm @ glu_w + glu_b)
    branch_a = y_ssm @ w_branch_ssm
    q = rotary(q.reshape(Bsz, L, N_HEADS, HEAD_DIM)).transpose(0, 2, 1, 3)
    k = rotary(k.reshape(Bsz, L, N_HEADS, HEAD_DIM)).transpose(0, 2, 1, 3)
    v = v.reshape(Bsz, L, N_HEADS, HEAD_DIM).transpose(0, 2, 1, 3)
    branch_b = moba_attention(q, k, v) @ w_branch_attn
    merged = jax.nn.sigmoid(g_ssm) * branch_a + jax.nn.sigmoid(g_attn) * branch_b
    return merged @ w_out


def setup_inputs(seed: int = 0) -> dict:
    key = jax.random.key(seed)
    ks = iter(jax.random.split(key, 40))

    def nrm(shape, scale):
        return jax.random.normal(next(ks), shape, jnp.float32) * scale

    def gain(shape):
        return 1.0 + nrm(shape, 0.01)

    G, P, Hg = N_SSM_GROUPS, SSM_STATE, SSM_GROUP
    a_im_base = jnp.pi * jnp.arange(P, dtype=jnp.float32)
    return {
        "x": nrm((BATCH, SEQ, D_MODEL), 1.0),
        "ffn1_norm": gain((DEPTH, D_MODEL)),
        "ffn1_w_gate": nrm((DEPTH, D_MODEL, D_FF), D_MODEL ** -0.5),
        "ffn1_w_up": nrm((DEPTH, D_MODEL, D_FF), D_MODEL ** -0.5),
        "ffn1_w_down": nrm((DEPTH, D_FF, D_MODEL), D_FF ** -0.5),
        "mix_norm": gain((DEPTH, D_MODEL)),
        "w_in": nrm((DEPTH, D_MODEL, IN_WIDTH), D_MODEL ** -0.5),
        "ssm_a_re": -0.5 + nrm((DEPTH, G, P), 0.01),
        "ssm_a_im": a_im_base + nrm((DEPTH, G, P), 0.01),
        "ssm_b_re": nrm((DEPTH, G, P, Hg), (2.0 * Hg) ** -0.5),
        "ssm_b_im": nrm((DEPTH, G, P, Hg), (2.0 * Hg) ** -0.5),
        "ssm_c_re": nrm((DEPTH, G, Hg, P), (2.0 * P) ** -0.5),
        "ssm_c_im": nrm((DEPTH, G, Hg, P), (2.0 * P) ** -0.5),
        "ssm_d": nrm((DEPTH, SSM_WIDTH), 1.0),
        "ssm_log_dt": jax.random.uniform(next(ks), (DEPTH, G), jnp.float32, math.log(DT_MIN), math.log(DT_MAX)),
        "glu_w": nrm((DEPTH, SSM_WIDTH, SSM_WIDTH), SSM_WIDTH ** -0.5),
        "glu_b": nrm((DEPTH, SSM_WIDTH), 0.01),
        "w_branch_ssm": nrm((DEPTH, SSM_WIDTH, D_MODEL), SSM_WIDTH ** -0.5),
        "w_branch_attn": nrm((DEPTH, ATTN_WIDTH, D_MODEL), ATTN_WIDTH ** -0.5),
        "w_out": nrm((DEPTH, D_MODEL, D_MODEL), D_MODEL ** -0.5),
        "ffn2_norm": gain((DEPTH, D_MODEL)),
        "ffn2_w_gate": nrm((DEPTH, D_MODEL, D_FF), D_MODEL ** -0.5),
        "ffn2_w_up": nrm((DEPTH, D_MODEL, D_FF), D_MODEL ** -0.5),
        "ffn2_w_down": nrm((DEPTH, D_FF, D_MODEL), D_FF ** -0.5),
        "final_norm": gain((D_MODEL,)),
    }


def reference(x, ffn1_norm, ffn1_w_gate, ffn1_w_up, ffn1_w_down, mix_norm, w_in,
              ssm_a_re, ssm_a_im, ssm_b_re, ssm_b_im, ssm_c_re, ssm_c_im, ssm_d, ssm_log_dt,
              glu_w, glu_b, w_branch_ssm, w_branch_attn, w_out,
              ffn2_norm, ffn2_w_gate, ffn2_w_up, ffn2_w_down, final_norm):
    for l in range(DEPTH):
        h = rmsnorm(x, ffn1_norm[l])
        x = x + 0.5 * swiglu(h, ffn1_w_gate[l], ffn1_w_up[l], ffn1_w_down[l])
        h = rmsnorm(x, mix_norm[l])
        x = x + hybrid_mixer(h, w_in[l], ssm_a_re[l], ssm_a_im[l], ssm_b_re[l], ssm_b_im[l],
                             ssm_c_re[l], ssm_c_im[l], ssm_d[l], ssm_log_dt[l],
                             glu_w[l], glu_b[l], w_branch_ssm[l], w_branch_attn[l], w_out[l])
        h = rmsnorm(x, ffn2_norm[l])
        x = x + 0.5 * swiglu(h, ffn2_w_gate[l], ffn2_w_up[l], ffn2_w_down[l])
    return rmsnorm(x, final_norm)
```

```cpp
#include <hip/hip_runtime.h>
#include <hip/hip_cooperative_groups.h>
#include <cstdio>
#include <cstdint>
namespace cg = cooperative_groups;

#ifndef MULTI_LAUNCH
#define MULTI_LAUNCH 0
#endif

#define LAS __attribute__((address_space(3)))
typedef unsigned short bf16_t;
typedef short bf16x8 __attribute__((ext_vector_type(8)));
typedef float f32x4 __attribute__((ext_vector_type(4)));
typedef float f32x16 __attribute__((ext_vector_type(16)));
typedef unsigned u32x4 __attribute__((ext_vector_type(4)));
typedef unsigned u32x2 __attribute__((ext_vector_type(2)));
typedef float f32x2 __attribute__((ext_vector_type(2)));

constexpr int M = 16384, DM = 1024, FF = 2816, SEQ = 8192, NH = 8, INW = 4096;
constexpr int TCH = 32, AK = 640;
constexpr float EPS = 1e-6f;
constexpr float QSCALE = 0.125f * 1.4426950408889634f;
constexpr float NEGBIG = -1e30f;
constexpr int LDS_CTL = 149504;
constexpr int LDS_BYTES = LDS_CTL + 64;
constexpr int NPHASE = 13;

constexpr size_t WS_RS0 = 0, WS_RS1 = 65536, WS_RS2 = 131072, WS_RS3 = 196608, WS_KMEAN = 262144, WS_AT = 393216;
constexpr size_t WS_PCNT = 425984;
constexpr size_t WS_ATTQ = 442368;
constexpr size_t WS_BAR = 409600;
constexpr size_t WS_ROPE = 524288;
constexpr size_t WS_W1GU = WS_ROPE + 2097152;
constexpr size_t WS_W1D = WS_W1GU + (size_t)5632 * 1024 * 2;
constexpr size_t WS_W2GU = WS_W1D + (size_t)1024 * 2816 * 2;
constexpr size_t WS_W2D = WS_W2GU + (size_t)5632 * 1024 * 2;
constexpr size_t WS_WIN = WS_W2D + (size_t)1024 * 2816 * 2;
constexpr size_t WS_WGLU = WS_WIN + (size_t)4096 * 1024 * 2;
constexpr size_t WS_WBS = WS_WGLU + (size_t)512 * 512 * 2;
constexpr size_t WS_WBA = WS_WBS + (size_t)1024 * 512 * 2;
constexpr size_t WS_WOUT = WS_WBA + (size_t)1024 * 512 * 2;
constexpr size_t WS_BTY = WS_WOUT + (size_t)1024 * 1024 * 2;
constexpr size_t WS_BTS = WS_BTY + (size_t)32 * 512 * AK * 2;
constexpr size_t WS_XB = WS_BTS + (size_t)32 * 256 * 512 * 2;
constexpr size_t WS_MIX = WS_XB + (size_t)M * 1024 * 2;
constexpr size_t WS_AP = WS_MIX;
constexpr size_t WS_SOUT = WS_AP + (size_t)M * AK * 2;
constexpr size_t WS_Q = WS_SOUT + (size_t)M * 128 * 4;
constexpr size_t WS_K = WS_Q + (size_t)M * 512 * 2;
constexpr size_t WS_VT = WS_K + (size_t)M * 512 * 2;
constexpr size_t WS_GS = WS_VT + (size_t)M * 512 * 2;
constexpr size_t WS_GA = WS_GS + (size_t)M * 1024 * 2;
constexpr size_t WS_END = WS_GA + (size_t)M * 1024 * 2;
constexpr size_t WS_ACT = WS_MIX;
constexpr size_t WS_Y = WS_W1GU;
static_assert(WS_W1D == WS_W1GU + (size_t)5632 * 1024 * 2 && WS_W2GU - WS_W1GU >= (size_t)M * 512 * 2, "y_ssm overlay");
constexpr size_t WS_ATT = WS_XB;
constexpr size_t WS_GT = WS_XB + (size_t)M * 512 * 2;
static_assert(WS_ACT + (size_t)M * FF * 2 <= WS_END, "act overlay");
static_assert(WS_END <= (size_t)256 * 1024 * 1024, "workspace");

struct Args {
    const float* in[25];
    float* out;
    unsigned char* ws;
    int lo, hi;
};
typedef const __attribute__((address_space(4))) Args* ArgsP;

__device__ __forceinline__ int tidx() { int t = (int)threadIdx.x; asm volatile("" : "+v"(t)); return t; }
__device__ __forceinline__ unsigned cvt_pk_bf16(float lo, float hi) { unsigned r; asm("v_cvt_pk_bf16_f32 %0, %1, %2" : "=v"(r) : "v"(lo), "v"(hi)); return r; }
__device__ __forceinline__ u32x4 pack8(f32x4 a, f32x4 b) { u32x4 w; w.x = cvt_pk_bf16(a[0], a[1]); w.y = cvt_pk_bf16(a[2], a[3]); w.z = cvt_pk_bf16(b[0], b[1]); w.w = cvt_pk_bf16(b[2], b[3]); return w; }
__device__ __forceinline__ void unpack8(u32x4 w, f32x4& a, f32x4& b) {
    a[0] = __uint_as_float(w.x << 16); a[1] = __uint_as_float(w.x & 0xffff0000u); a[2] = __uint_as_float(w.y << 16); a[3] = __uint_as_float(w.y & 0xffff0000u);
    b[0] = __uint_as_float(w.z << 16); b[1] = __uint_as_float(w.z & 0xffff0000u); b[2] = __uint_as_float(w.w << 16); b[3] = __uint_as_float(w.w & 0xffff0000u);
}
__device__ __forceinline__ float fast_sigmoid(float x) { return __builtin_amdgcn_rcpf(1.f + __expf(-x)); }
__device__ __forceinline__ f32x4 sigmoid4(f32x4 v) { f32x4 r; r[0] = fast_sigmoid(v[0]); r[1] = fast_sigmoid(v[1]); r[2] = fast_sigmoid(v[2]); r[3] = fast_sigmoid(v[3]); return r; }
__device__ __forceinline__ float gelu_tanh(float x) { const float u = 1.5957691216057308f * (x + 0.044715f * x * x * x); return x * fast_sigmoid(u); }
__device__ __forceinline__ float inv_rms(float ss) { return rsqrtf(ss * (1.f / 1024.f) + EPS); }

__device__ __forceinline__ double exp_d(double x) {
    const double kf = rint(x * 1.4426950408889634);
    const double r = fma(-kf, 1.9082149292705877e-10, fma(-kf, 0.6931471803691238, x));
    double t = 1.0, s = 1.0;
#pragma unroll
    for (int i = 1; i <= 14; ++i) { t *= r * (1.0 / i); s += t; }
    const long long bits = (long long)(1023 + (int)kf) << 52;
    return s * __longlong_as_double(bits);
}
__device__ __forceinline__ void sincos_d(double x, double& sn, double& cs) {
    const double kf = rint(x * 0.6366197723675814);
    double r = fma(-kf, 1.5707963267948966, x); r = fma(-kf, 6.123233995736766e-17, r);
    const double r2 = r * r;
    double ts = r, ss = r, tc = 1.0, sc = 1.0;
#pragma unroll
    for (int i = 1; i <= 8; ++i) { ts *= -r2 * (1.0 / ((2 * i) * (2 * i + 1))); ss += ts; tc *= -r2 * (1.0 / ((2 * i - 1) * (2 * i))); sc += tc; }
    const int q = (int)((long long)kf & 3);
    sn = (q == 0) ? ss : (q == 1) ? sc : (q == 2) ? -ss : -sc;
    cs = (q == 0) ? sc : (q == 1) ? -ss : (q == 2) ? -sc : ss;
}

namespace pg8 {
constexpr int BM = 256, BK = 64, HALF = 128, HTB = HALF * BK * 2, STAGE_BYTES = 8 * HTB, NXCD = 8, WGM = 8;
__host__ __device__ __forceinline__ int lds_byte(int r, int c) { const int st = (r >> 4) * 2 + (c >> 5), rr = r & 15, cc = c & 31, ob = rr * 64 + cc * 2; return st * 1024 + (ob ^ (((ob >> 9) & 1) << 5)); }
__host__ __device__ __forceinline__ void stage_rc(int b, int& R, int& C) { const int st = b / 1024, sb = b % 1024, swz = sb ^ (((sb >> 9) & 1) << 5); R = (st >> 1) * 16 + swz / 64; C = (st & 1) * 32 + (swz % 64) / 2; }
__host__ __device__ __forceinline__ int perm32(int rho) { const int n = rho >> 4, i = rho & 15; return 8 * (i >> 2) + 4 * n + (i & 3); }

struct Unit { int pm, pn; };
struct Gemm { const bf16_t* A; const bf16_t* Bt; int K, lda, ldb; };

struct StaticOrder {
    int nM, nN, nwg, G, c;
    __device__ void init(int Mr, int N, int G_, int c_) { nM = Mr / BM; nN = N / BM; nwg = nM * nN; G = G_; c = c_; }
    __device__ bool next(int i, Unit& u) const {
        const long L = (long)i * G + c; if (L >= nwg) return false;
        int wgid = (int)L; { const int q = nwg / NXCD, r = nwg % NXCD, xcd = wgid % NXCD, off = wgid / NXCD; wgid = (xcd < r ? xcd * (q + 1) : r * (q + 1) + (xcd - r) * q) + off; }
        const int nig = WGM * nN, gid = wgid / nig, fm = gid * WGM, gsz = (nM - fm) < WGM ? (nM - fm) : WGM;
        u.pm = fm + ((wgid % nig) % gsz); u.pn = (wgid % nig) / gsz; return true;
    }
};
struct GroupOrder {
    int ntm, ntn, nwg, G, c;
    __device__ bool next(int i, Unit& u) const {
        const long L = (long)i * G + c; if (L >= nwg) return false;
        const int per = ntm * ntn, g = (int)L / per, r = (int)L % per; u.pm = g * ntm + r / ntn; u.pn = g * ntn + r % ntn; return true;
    }
};

struct RangeOrder {
    int ntm, ntn, first, count;
    __device__ bool next(int i, Unit& u) const {
        if (i >= count) return false; const int L = first + i, per = ntm * ntn, g = L / per, r = L % per; u.pm = g * ntm + r / ntn; u.pn = g * ntn + r % ntn; return true;
    }
};
template <class Epi, class Sched, bool ALIGN_EPI>
__device__ __forceinline__ void gemm_phase(LAS unsigned char* lds, const Gemm g, const Sched& S, const Epi& E) {
    const int tid = tidx(), wid = __builtin_amdgcn_readfirstlane(tid >> 6), lane = tid & 63, wr = wid >> 2, wc = wid & 3, fr = lane & 15, fq = lane >> 4;
    const int K = g.K, nt = K / BK;
    unsigned voffA[2], voffB[2];
#pragma unroll
    for (int i = 0; i < 2; ++i) { int R, C; stage_rc(tid * 16 + i * 8192, R, C); const int Rb = (R & ~31) + perm32(R & 31);
        voffA[i] = (unsigned)(R * g.lda + C) * 2u; voffB[i] = (unsigned)(Rb * g.ldb + C) * 2u; }
    const size_t kstep = (size_t)(BK * 2);
    const size_t hstepA = (size_t)HALF * g.lda * 2, hstepB = (size_t)HALF * g.ldb * 2;
    const size_t tstepA = 2 * hstepA, tstepB = 2 * hstepB;
    const unsigned ldsw = (unsigned)wid * 1024u;
    const int aoff = lds_byte(wr * 64 + fr, fq * 8), boff = lds_byte(wc * 32 + fr, fq * 8);
#define PG8_SA(b, h) (((b) * 2 + (h)) * HTB)
#define PG8_SB(b, h) ((4 + (b) * 2 + (h)) * HTB)
#define PG8_STAGE(bufoff, gbase, voff) do { _Pragma("unroll") for (int _i = 0; _i < 2; ++_i) \
        __builtin_amdgcn_global_load_lds((const unsigned*)((const char*)(gbase) + (voff)[_i]), (LAS unsigned*)(lds + (bufoff) + ldsw + _i * 8192), 16, 0, 0); } while (0)
#define PG8_LDA(dst, b, h) do { _Pragma("unroll") for (int m = 0; m < 4; ++m) _Pragma("unroll") for (int k = 0; k < 2; ++k) dst[m][k] = *(const LAS bf16x8*)(lds + PG8_SA(b, h) + aoff + m * 2048 + k * 1024); } while (0)
#define PG8_LDB(dst, b, h) do { _Pragma("unroll") for (int n = 0; n < 2; ++n) _Pragma("unroll") for (int k = 0; k < 2; ++k) dst[n][k] = *(const LAS bf16x8*)(lds + PG8_SB(b, h) + boff + n * 2048 + k * 1024); } while (0)
#define PG8_MMA(ai, bj, At, Bt) do { __builtin_amdgcn_s_setprio(1); _Pragma("unroll") for (int m = 0; m < 4; ++m) _Pragma("unroll") for (int n = 0; n < 2; ++n) _Pragma("unroll") for (int k = 0; k < 2; ++k) \
        acc[ai][bj][m][n] = __builtin_amdgcn_mfma_f32_16x16x32_bf16(Bt[n][k], At[m][k], acc[ai][bj][m][n], 0, 0, 0); __builtin_amdgcn_s_setprio(0); } while (0)
#define PG8_WAIT_V(n) asm volatile("s_waitcnt vmcnt(" #n ")" ::: "memory")
#define PG8_WAIT_L(n) asm volatile("s_waitcnt lgkmcnt(" #n ")" ::: "memory")
#define PG8_BAR __builtin_amdgcn_s_barrier()
#define PG8_SCHED __builtin_amdgcn_sched_barrier(0)
    Unit cur, nxt; int ui = 0;
    if (!S.next(0, cur)) return;
    f32x4 acc[2][2][4][2];
#pragma unroll
    for (int a = 0; a < 2; ++a)
#pragma unroll
        for (int b = 0; b < 2; ++b)
#pragma unroll
            for (int m = 0; m < 4; ++m)
#pragma unroll
                for (int n = 0; n < 2; ++n) acc[a][b][m][n] = (f32x4){0.f, 0.f, 0.f, 0.f};
    bf16x8 At[4][2], B0[2][2], B1[2][2];
    const char* cA = (const char*)g.A + (size_t)cur.pm * tstepA; const char* cB = (const char*)g.Bt + (size_t)cur.pn * tstepB;
    PG8_STAGE(PG8_SB(0, 0), cB, voffB); PG8_STAGE(PG8_SB(0, 1), cB + hstepB, voffB); PG8_STAGE(PG8_SA(0, 0), cA, voffA); PG8_STAGE(PG8_SA(0, 1), cA + hstepA, voffA);
    if (wr == 1) PG8_BAR;
    PG8_WAIT_V(2); PG8_BAR;
    PG8_STAGE(PG8_SB(1, 0), cB + kstep, voffB); PG8_STAGE(PG8_SA(1, 0), cA + kstep, voffA); PG8_STAGE(PG8_SB(1, 1), cB + hstepB + kstep, voffB);
    PG8_WAIT_V(6); PG8_BAR;
    for (;;) {
        const bool has_next = S.next(ui + 1, nxt);
        const char* nA = has_next ? (const char*)g.A + (size_t)nxt.pm * tstepA : cA; const char* nB = has_next ? (const char*)g.Bt + (size_t)nxt.pn * tstepB : cB;
        for (int t = 0; t < nt; t += 2) {
            const bool last = (t == nt - 2);
            const char* a1 = cA + (size_t)(t + 1) * kstep;
            const char* a2 = last ? nA : cA + (size_t)(t + 2) * kstep; const char* b2 = last ? nB : cB + (size_t)(t + 2) * kstep;
            const char* a3 = a2 + kstep; const char* b3 = b2 + kstep;
            PG8_LDB(B0, 0, 0); PG8_LDB(B1, 0, 1); PG8_SCHED; PG8_LDA(At, 0, 0); PG8_STAGE(PG8_SA(1, 1), a1 + hstepA, voffA);
            PG8_WAIT_V(8); PG8_WAIT_L(0); PG8_BAR; PG8_MMA(0, 0, At, B0); PG8_MMA(0, 1, At, B1); PG8_BAR; PG8_SCHED;
            PG8_LDA(At, 0, 1); PG8_STAGE(PG8_SB(0, 0), b2, voffB); PG8_STAGE(PG8_SB(0, 1), b2 + hstepB, voffB); PG8_STAGE(PG8_SA(0, 0), a2, voffA);
            PG8_WAIT_V(8); PG8_WAIT_L(0); PG8_BAR; PG8_MMA(1, 0, At, B0); PG8_MMA(1, 1, At, B1); PG8_BAR; PG8_SCHED;
            PG8_LDB(B0, 1, 0); PG8_LDB(B1, 1, 1); PG8_SCHED; PG8_LDA(At, 1, 0); PG8_STAGE(PG8_SA(0, 1), a2 + hstepA, voffA);
            PG8_WAIT_V(8); PG8_WAIT_L(0); PG8_BAR; PG8_MMA(0, 0, At, B0); PG8_MMA(0, 1, At, B1); PG8_BAR; PG8_SCHED;
            PG8_LDA(At, 1, 1); PG8_STAGE(PG8_SB(1, 0), b3, voffB); PG8_STAGE(PG8_SB(1, 1), b3 + hstepB, voffB); PG8_STAGE(PG8_SA(1, 0), a3, voffA);
            PG8_WAIT_V(8); PG8_WAIT_L(0); PG8_BAR; PG8_MMA(1, 0, At, B0); PG8_MMA(1, 1, At, B1); PG8_BAR; PG8_SCHED;
        }
        if constexpr (ALIGN_EPI) { if (wr == 0) PG8_BAR; }
        { int fr_ = fr, fq_ = fq; asm volatile("" : "+v"(fr_), "+v"(fq_)); if constexpr (!Epi::AFTER_DRAIN) E(acc, cur, wr, wc, fr_, fq_); }
        if (!has_next) break;
#pragma unroll
        for (int a = 0; a < 2; ++a)
#pragma unroll
            for (int b = 0; b < 2; ++b)
#pragma unroll
                for (int m = 0; m < 4; ++m)
#pragma unroll
                    for (int n = 0; n < 2; ++n) acc[a][b][m][n] = (f32x4){0.f, 0.f, 0.f, 0.f};
        cur = nxt; cA = nA; cB = nB; ++ui;
        if constexpr (ALIGN_EPI) { if (wr == 1) PG8_BAR; }
    }
    PG8_WAIT_V(0);
    if constexpr (!ALIGN_EPI) { if (wr == 0) PG8_BAR; }
    PG8_BAR;
    if constexpr (Epi::AFTER_DRAIN) { int fr_ = fr, fq_ = fq; asm volatile("" : "+v"(fr_), "+v"(fq_)); E.fused(acc, cur, wr, wc, fr_, fq_); }
#undef PG8_SA
#undef PG8_SB
#undef PG8_STAGE
#undef PG8_LDA
#undef PG8_LDB
#undef PG8_MMA
#undef PG8_WAIT_V
#undef PG8_WAIT_L
#undef PG8_BAR
#undef PG8_SCHED
}
}
using pg8::Unit;
typedef f32x4 Acc[2][2][4][2];

#define EPI_ROWS for (int ai = 0; ai < 2; ++ai) _Pragma("unroll") for (int m = 0; m < 4; ++m)

struct EpiGateUp {
    static constexpr bool AFTER_DRAIN = false;
    bf16_t* O; const float* ss;
    __device__ __forceinline__ void operator()(const Acc& acc, const Unit& u, int wr, int wc, int fr, int fq) const {
#pragma unroll
        EPI_ROWS {
            const int row = u.pm * 256 + ai * 128 + wr * 64 + m * 16 + fr;
            const float s = inv_rms(ss[row]);
            f32x4 o[2];
#pragma unroll
            for (int n = 0; n < 2; ++n) { const f32x4 g = acc[ai][0][m][n] * s, up = acc[ai][1][m][n] * s;
#pragma unroll
                for (int j = 0; j < 4; ++j) o[n][j] = g[j] * fast_sigmoid(g[j]) * up[j]; }
            *(u32x4*)(O + (size_t)row * FF + u.pn * 128 + wc * 32 + 8 * fq) = pack8(o[0], o[1]);
        }
    }
};

template <bool WB> struct EpiRes {
    static constexpr bool AFTER_DRAIN = false;
    const float* Xin; float* Xout; bf16_t* Xb; float* rowss; float coef;
    __device__ __forceinline__ void operator()(const Acc& acc, const Unit& u, int wr, int wc, int fr, int fq) const {
#pragma unroll
        EPI_ROWS {
            const int row = u.pm * 256 + ai * 128 + wr * 64 + m * 16 + fr;
            const size_t off = (size_t)row * DM + u.pn * 256 + wc * 32 + 8 * fq;
            float ss = 0.f;
#pragma unroll
            for (int bj = 0; bj < 2; ++bj) {
                const f32x4 x0 = *(const f32x4*)(Xin + off + bj * 128), x1 = *(const f32x4*)(Xin + off + bj * 128 + 4);
                const f32x4 o0 = x0 + acc[ai][bj][m][0] * coef, o1 = x1 + acc[ai][bj][m][1] * coef;
                *(f32x4*)(Xout + off + bj * 128) = o0; *(f32x4*)(Xout + off + bj * 128 + 4) = o1;
                ss += o0[0] * o0[0] + o0[1] * o0[1] + o0[2] * o0[2] + o0[3] * o0[3] + o1[0] * o1[0] + o1[1] * o1[1] + o1[2] * o1[2] + o1[3] * o1[3];
                if (WB) *(u32x4*)(Xb + off + bj * 128) = pack8(o0, o1);
            }
            ss += __shfl_xor(ss, 16); ss += __shfl_xor(ss, 32);
            if (fq == 0) atomicAdd(rowss + row, ss);
        }
    }
};

struct EpiWin {
    static constexpr bool AFTER_DRAIN = false;
    const float* ss; bf16_t* AP; bf16_t* Q; bf16_t* Kb; bf16_t* VT; bf16_t* GS; bf16_t* GA; const float* rope; float* kmean;
    __device__ __forceinline__ void operator()(const Acc& acc, const Unit& u, int wr, int wc, int fr, int fq) const {
        const int pn = u.pn;
        if (pn < 2) {
            int pm_ = u.pm; asm volatile("" : "+s"(pm_));
#pragma unroll
            EPI_ROWS {
                const int row = pm_ * 256 + ai * 128 + wr * 64 + m * 16 + fr; const float s = inv_rms(ss[row]);
                const int b = row >> 13, tok = row & 8191, c = tok >> 5, sidx = tok & 31;
#pragma unroll
                for (int bj = 0; bj < 2; ++bj) { const int col = pn * 256 + bj * 128 + wc * 32 + 8 * fq; const int g = col >> 4, hh = col & 15;
                    *(u32x4*)(AP + (size_t)(g * 512 + b * 256 + c) * AK + sidx * 16 + hh) = pack8(acc[ai][bj][m][0] * s, acc[ai][bj][m][1] * s); }
            }
        } else if (pn < 6) {
            int pm_ = u.pm; asm volatile("" : "+s"(pm_));
            const bool isq = pn < 4;
            bf16_t* dst = isq ? Q : Kb; const float osc = isq ? QSCALE : 1.f;
            float ks[2][8];
#pragma unroll
            for (int bj = 0; bj < 2; ++bj)
#pragma unroll
                for (int e = 0; e < 8; ++e) ks[bj][e] = 0.f;
#pragma unroll
            EPI_ROWS {
                const int row = pm_ * 256 + ai * 128 + wr * 64 + m * 16 + fr; const float s = inv_rms(ss[row]) * osc;
                const int tok = row & 8191; const int i0 = (wc & 1) * 16 + 4 * fq;
                const f32x4 cs = *(const f32x4*)(rope + (size_t)tok * 32 + i0), sn = *(const f32x4*)(rope + (size_t)SEQ * 32 + (size_t)tok * 32 + i0);
#pragma unroll
                for (int bj = 0; bj < 2; ++bj) { const int head = (pn & 1) * 4 + 2 * bj + (wc >> 1);
                    const f32x4 x1 = acc[ai][bj][m][0] * s, x2 = acc[ai][bj][m][1] * s;
                    const f32x4 o1 = x1 * cs - x2 * sn, o2 = x2 * cs + x1 * sn;
                    u32x2 w1, w2; w1.x = cvt_pk_bf16(o1[0], o1[1]); w1.y = cvt_pk_bf16(o1[2], o1[3]); w2.x = cvt_pk_bf16(o2[0], o2[1]); w2.y = cvt_pk_bf16(o2[2], o2[3]);
                    bf16_t* p = isq ? dst + (size_t)row * 512 + head * 64 + i0 : dst + ((size_t)(((row >> 13) * 8 + head)) * SEQ + tok) * 64 + i0;
                    *(u32x2*)p = w1; *(u32x2*)(p + 32) = w2;
#pragma unroll
                    for (int e = 0; e < 4; ++e) { ks[bj][e] += o1[e]; ks[bj][4 + e] += o2[e]; asm volatile("" : "+v"(ks[bj][e]), "+v"(ks[bj][4 + e])); } }
                asm volatile("" ::: "memory");
            }
            if (!isq) {
                const int b = (pm_ * 256) >> 13, blk = pm_ & 31; const int i0 = (wc & 1) * 16 + 4 * fq;
#pragma unroll
                for (int bj = 0; bj < 2; ++bj) { const int head = (pn & 1) * 4 + 2 * bj + (wc >> 1);
#pragma unroll
                    for (int e = 0; e < 8; ++e) { float v = ks[bj][e]; v += __shfl_xor(v, 1); v += __shfl_xor(v, 2); v += __shfl_xor(v, 4); v += __shfl_xor(v, 8);
                        if (fr == 0) atomicAdd(kmean + (size_t)((b * 8 + head) * 32 + blk) * 64 + i0 + (e & 3) + 32 * (e >> 2), v); } }
            }
        } else if (pn < 8) {
            int pm_ = u.pm; asm volatile("" : "+s"(pm_));
#pragma unroll
            EPI_ROWS {
                const int row = pm_ * 256 + ai * 128 + wr * 64 + m * 16 + fr; const float s = inv_rms(ss[row]);
                const int b = row >> 13, tok = row & 8191;
#pragma unroll
                for (int bj = 0; bj < 2; ++bj) { const int col = (pn - 6) * 256 + bj * 128 + wc * 32 + 8 * fq; const int head = col >> 6, d0 = col & 63;
                    bf16_t* p = VT + ((size_t)(((b * 8 + head) * 32 + (tok >> 8)) * 64 + d0)) * 256 + (tok & 255);
                    const f32x4 v0 = acc[ai][bj][m][0] * s, v1 = acc[ai][bj][m][1] * s;
#pragma unroll
                    for (int e = 0; e < 4; ++e) { p[e * 256] = (bf16_t)(cvt_pk_bf16(v0[e], 0.f) & 0xffffu); p[(4 + e) * 256] = (bf16_t)(cvt_pk_bf16(v1[e], 0.f) & 0xffffu); } }
                asm volatile("" ::: "memory");
            }
        } else {
            int pm_ = u.pm; asm volatile("" : "+s"(pm_));
            bf16_t* dst = pn < 12 ? GS : GA; const int cb = ((pn - 8) & 3) * 256;
#pragma unroll
            EPI_ROWS {
                const int row = pm_ * 256 + ai * 128 + wr * 64 + m * 16 + fr; const float s = inv_rms(ss[row]);
#pragma unroll
                for (int bj = 0; bj < 2; ++bj) { const int col = cb + bj * 128 + wc * 32 + 8 * fq;
                    *(u32x4*)(dst + (size_t)row * DM + col) = pack8(sigmoid4(acc[ai][bj][m][0] * s), sigmoid4(acc[ai][bj][m][1] * s)); }
            }
        }
    }
};


template <bool IN_BF16> struct EpiResB {
    static constexpr bool AFTER_DRAIN = false;
    const void* Xin; bf16_t* Xb; float* rowss; float coef;
    __device__ __forceinline__ void operator()(const Acc& acc, const Unit& u, int wr, int wc, int fr, int fq) const {
#pragma unroll
        EPI_ROWS {
            const int row = u.pm * 256 + ai * 128 + wr * 64 + m * 16 + fr;
            const size_t off = (size_t)row * DM + u.pn * 256 + wc * 32 + 8 * fq;
            float ss = 0.f;
#pragma unroll
            for (int bj = 0; bj < 2; ++bj) {
                f32x4 x0, x1;
                if (IN_BF16) unpack8(*(const u32x4*)((const bf16_t*)Xin + off + bj * 128), x0, x1);
                else { x0 = *(const f32x4*)((const float*)Xin + off + bj * 128); x1 = *(const f32x4*)((const float*)Xin + off + bj * 128 + 4); }
                const f32x4 o0 = x0 + acc[ai][bj][m][0] * coef, o1 = x1 + acc[ai][bj][m][1] * coef;
                ss += o0[0] * o0[0] + o0[1] * o0[1] + o0[2] * o0[2] + o0[3] * o0[3] + o1[0] * o1[0] + o1[1] * o1[1] + o1[2] * o1[2] + o1[3] * o1[3];
                *(u32x4*)(Xb + off + bj * 128) = pack8(o0, o1);
            }
            ss += __shfl_xor(ss, 16); ss += __shfl_xor(ss, 32);
            if (fq == 0) atomicAdd(rowss + row, ss);
        }
    }
};

struct EpiResF {
    static constexpr bool AFTER_DRAIN = false;
    const bf16_t* Xin; float* Xout; float* rowss; float coef;
    __device__ __forceinline__ void operator()(const Acc& acc, const Unit& u, int wr, int wc, int fr, int fq) const {
#pragma unroll
        EPI_ROWS {
            const int row = u.pm * 256 + ai * 128 + wr * 64 + m * 16 + fr;
            const size_t off = (size_t)row * DM + u.pn * 256 + wc * 32 + 8 * fq;
            float ss = 0.f;
#pragma unroll
            for (int bj = 0; bj < 2; ++bj) {
                f32x4 x0, x1; unpack8(*(const u32x4*)(Xin + off + bj * 128), x0, x1);
                const f32x4 o0 = x0 + acc[ai][bj][m][0] * coef, o1 = x1 + acc[ai][bj][m][1] * coef;
                *(f32x4*)(Xout + off + bj * 128) = o0; *(f32x4*)(Xout + off + bj * 128 + 4) = o1;
                ss += o0[0] * o0[0] + o0[1] * o0[1] + o0[2] * o0[2] + o0[3] * o0[3] + o1[0] * o1[0] + o1[1] * o1[1] + o1[2] * o1[2] + o1[3] * o1[3];
            }
            ss += __shfl_xor(ss, 16); ss += __shfl_xor(ss, 32);
            if (fq == 0) atomicAdd(rowss + row, ss);
        }
    }
};

struct EpiResNorm {
    static constexpr bool AFTER_DRAIN = true;
    const bf16_t* Xin; float* Xout; float* rowss; unsigned* pcnt; const float* gain; float coef;
    __device__ __forceinline__ void operator()(Acc&, const Unit&, int, int, int, int) const {}
    __device__ __forceinline__ void fused(Acc& acc, const Unit& u, int wr, int wc, int fr, int fq) const {
#pragma unroll
        EPI_ROWS {
            const int row = u.pm * 256 + ai * 128 + wr * 64 + m * 16 + fr;
            const size_t off = (size_t)row * DM + u.pn * 256 + wc * 32 + 8 * fq;
            float ss = 0.f;
#pragma unroll
            for (int bj = 0; bj < 2; ++bj) {
                f32x4 x0, x1; unpack8(*(const u32x4*)(Xin + off + bj * 128), x0, x1);
                const f32x4 o0 = x0 + acc[ai][bj][m][0] * coef, o1 = x1 + acc[ai][bj][m][1] * coef;
                acc[ai][bj][m][0] = o0; acc[ai][bj][m][1] = o1;
                ss += o0[0] * o0[0] + o0[1] * o0[1] + o0[2] * o0[2] + o0[3] * o0[3] + o1[0] * o1[0] + o1[1] * o1[1] + o1[2] * o1[2] + o1[3] * o1[3];
            }
            ss += __shfl_xor(ss, 16); ss += __shfl_xor(ss, 32);
            if (fq == 0) atomicAdd(rowss + row, ss);
        }
        asm volatile("s_waitcnt vmcnt(0)" ::: "memory");
        __syncthreads();
        if (tidx() == 0) {
            __builtin_amdgcn_fence(__ATOMIC_RELEASE, "agent");
            asm volatile("s_waitcnt vmcnt(0)" ::: "memory");
            __hip_atomic_fetch_add(pcnt + u.pm * 64, 1u, __ATOMIC_RELAXED, __HIP_MEMORY_SCOPE_AGENT);
            unsigned sp = 0;
            while (__hip_atomic_load(pcnt + u.pm * 64, __ATOMIC_RELAXED, __HIP_MEMORY_SCOPE_AGENT) < 4u) { __builtin_amdgcn_s_sleep(1); if (++sp > (1u << 22)) break; }
            __builtin_amdgcn_fence(__ATOMIC_ACQUIRE, "agent");
            asm volatile("s_waitcnt vmcnt(0)" ::: "memory");
        }
        __syncthreads();
#pragma unroll
        EPI_ROWS {
            const int row = u.pm * 256 + ai * 128 + wr * 64 + m * 16 + fr;
            const size_t off = (size_t)row * DM + u.pn * 256 + wc * 32 + 8 * fq;
            const float s = inv_rms(__hip_atomic_load(rowss + row, __ATOMIC_RELAXED, __HIP_MEMORY_SCOPE_AGENT));
#pragma unroll
            for (int bj = 0; bj < 2; ++bj) { const int col = u.pn * 256 + bj * 128 + wc * 32 + 8 * fq;
                const f32x4 g0 = *(const f32x4*)(gain + col), g1 = *(const f32x4*)(gain + col + 4);
                *(f32x4*)(Xout + off + bj * 128) = acc[ai][bj][m][0] * s * g0; *(f32x4*)(Xout + off + bj * 128 + 4) = acc[ai][bj][m][1] * s * g1; }
        }
    }
};

struct EpiS {
    static constexpr bool AFTER_DRAIN = false;
    float* S;
    __device__ __forceinline__ void operator()(const Acc& acc, const Unit& u, int wr, int wc, int fr, int fq) const {
#pragma unroll
        EPI_ROWS {
            const int row = u.pm * 256 + ai * 128 + wr * 64 + m * 16 + fr;
            float* p = S + (size_t)row * 128 + wc * 32 + 8 * fq; *(f32x4*)p = acc[ai][0][m][0]; *(f32x4*)(p + 4) = acc[ai][0][m][1];
        }
    }
};
struct EpiY {
    static constexpr bool AFTER_DRAIN = false;
    bf16_t* Y;
    __device__ __forceinline__ void operator()(const Acc& acc, const Unit& u, int wr, int wc, int fr, int fq) const {
#pragma unroll
        EPI_ROWS {
            const int row = u.pm * 256 + ai * 128 + wr * 64 + m * 16 + fr; const int g = row >> 9, b = (row >> 8) & 1, c = row & 255;
#pragma unroll
            for (int bj = 0; bj < 2; ++bj) { const int n = (u.pn & 1) * 256 + bj * 128 + wc * 32 + 8 * fq; const int t = n >> 4, hh = n & 15;
                f32x4 o0, o1;
#pragma unroll
                for (int e = 0; e < 4; ++e) { o0[e] = gelu_tanh(acc[ai][bj][m][0][e]); o1[e] = gelu_tanh(acc[ai][bj][m][1][e]); }
                *(u32x4*)(Y + (size_t)(b * SEQ + c * TCH + t) * 512 + g * 16 + hh) = pack8(o0, o1); }
        }
    }
};
struct EpiGlu {
    static constexpr bool AFTER_DRAIN = false;
    const bf16_t* Y; const float* bias; bf16_t* O;
    __device__ __forceinline__ void operator()(const Acc& acc, const Unit& u, int wr, int wc, int fr, int fq) const {
#pragma unroll
        EPI_ROWS {
            const int row = u.pm * 256 + ai * 128 + wr * 64 + m * 16 + fr;
#pragma unroll
            for (int bj = 0; bj < 2; ++bj) { const int col = u.pn * 256 + bj * 128 + wc * 32 + 8 * fq;
                const f32x4 b0 = *(const f32x4*)(bias + col), b1 = *(const f32x4*)(bias + col + 4);
                f32x4 y0, y1; unpack8(*(const u32x4*)(Y + (size_t)row * 512 + col), y0, y1);
                *(u32x4*)(O + (size_t)row * 512 + col) = pack8(y0 * sigmoid4(acc[ai][bj][m][0] + b0), y1 * sigmoid4(acc[ai][bj][m][1] + b1)); }
        }
    }
};
template <int MODE> struct EpiBranch {
    static constexpr bool AFTER_DRAIN = false;
    bf16_t* G1; bf16_t* G2;
    __device__ __forceinline__ void operator()(const Acc& acc, const Unit& u, int wr, int wc, int fr, int fq) const {
#pragma unroll
        EPI_ROWS {
            const int row = u.pm * 256 + ai * 128 + wr * 64 + m * 16 + fr;
#pragma unroll
            for (int bj = 0; bj < 2; ++bj) { const size_t off = (size_t)row * DM + u.pn * 256 + bj * 128 + wc * 32 + 8 * fq;
                f32x4 a0, a1; unpack8(*(const u32x4*)(G1 + off), a0, a1);
                if (MODE == 0) { *(u32x4*)(G1 + off) = pack8(a0 * acc[ai][bj][m][0], a1 * acc[ai][bj][m][1]); }
                else { f32x4 g0, g1; unpack8(*(const u32x4*)(G2 + off), g0, g1); *(u32x4*)(G2 + off) = pack8(a0 + g0 * acc[ai][bj][m][0], a1 + g1 * acc[ai][bj][m][1]); } }
        }
    }
};

struct WJob { const float* s0; const float* s1; const float* gain; bf16_t* dst; int K, ld, ndst, mode; };
__device__ __forceinline__ WJob get_job(ArgsP a, int j) {
    unsigned char* ws = a->ws; WJob J;
    switch (j) {
    case 0: J = WJob{a->in[2], a->in[3], a->in[1], (bf16_t*)(ws + WS_W1GU), 1024, 2816, 5632, 1}; break;
    case 1: J = WJob{a->in[4], a->in[4], nullptr, (bf16_t*)(ws + WS_W1D), 2816, 1024, 1024, 0}; break;
    case 2: J = WJob{a->in[6], a->in[6], a->in[5], (bf16_t*)(ws + WS_WIN), 1024, 4096, 4096, 2}; break;
    case 3: J = WJob{a->in[15], a->in[15], nullptr, (bf16_t*)(ws + WS_WGLU), 512, 512, 512, 0}; break;
    case 4: J = WJob{a->in[17], a->in[17], nullptr, (bf16_t*)(ws + WS_WBS), 512, 1024, 1024, 0}; break;
    case 5: J = WJob{a->in[18], a->in[18], nullptr, (bf16_t*)(ws + WS_WBA), 512, 1024, 1024, 0}; break;
    case 6: J = WJob{a->in[19], a->in[19], nullptr, (bf16_t*)(ws + WS_WOUT), 1024, 1024, 1024, 0}; break;
    case 7: J = WJob{a->in[21], a->in[22], a->in[20], (bf16_t*)(ws + WS_W2GU), 1024, 2816, 5632, 1}; break;
    default: J = WJob{a->in[23], a->in[23], nullptr, (bf16_t*)(ws + WS_W2D), 2816, 1024, 1024, 0}; break;
    }
    return J;
}
__device__ __forceinline__ void wconv_item(const WJob& J, int item) {
    const int nkb = J.K >> 6, kb = item % nkb, nb = item / nkb;
    const int tid = tidx(), lane = tid & 63, wave = tid >> 6;
    const int n = nb * 256 + lane * 4, k0 = kb * 64 + wave * 8;
    const float* src = J.s0; int sc = n;
    if (J.mode == 1) { const int tl = n >> 8, wi = n & 255; if (wi >= 128) src = J.s1; sc = tl * 128 + (wi & 127); }
    else if (J.mode == 2) { if (n >= 512 && n < 1536) { const int t_ = n & 255, bj = t_ >> 7, wc = (t_ >> 5) & 3, fq = (t_ >> 3) & 3, n2 = (t_ >> 2) & 1;
            sc = (n & ~255) + 64 * (2 * bj + (wc >> 1)) + (wc & 1) * 16 + 4 * fq + 32 * n2; } }
    f32x4 v[8];
#pragma unroll
    for (int e = 0; e < 8; ++e) v[e] = *(const f32x4*)(src + (size_t)(k0 + e) * J.ld + sc);
    if (J.gain) {
#pragma unroll
        for (int e = 0; e < 8; ++e) v[e] = v[e] * J.gain[k0 + e]; }
#pragma unroll
    for (int j = 0; j < 4; ++j) { u32x4 w; w.x = cvt_pk_bf16(v[0][j], v[1][j]); w.y = cvt_pk_bf16(v[2][j], v[3][j]); w.z = cvt_pk_bf16(v[4][j], v[5][j]); w.w = cvt_pk_bf16(v[6][j], v[7][j]);
        *(u32x4*)(J.dst + (size_t)(n + j) * J.K + k0) = w; }
}

__device__ __forceinline__ void ssm_precompute(LAS unsigned char* lds, ArgsP a, int g, int hsel) {
    LAS float* pwr = (LAS float*)lds; LAS float* pwi = pwr + 33 * 64; LAS float* Bbr = pwi + 33 * 64; LAS float* Bbi = Bbr + 1024;
    LAS float* Cr = Bbi + 1024; LAS float* Ci = Cr + 1024; LAS float* Kt = Ci + 1024;
    const float* a_re = a->in[7]; const float* a_im = a->in[8]; const float* b_re = a->in[9]; const float* b_im = a->in[10];
    const float* c_re = a->in[11]; const float* c_im = a->in[12]; const float* dsk = a->in[13]; const float* log_dt = a->in[14];
    bf16_t* BTY = (bf16_t*)(a->ws + WS_BTY); bf16_t* BTS = (bf16_t*)(a->ws + WS_BTS); float* aT = (float*)(a->ws + WS_AT);
    const int tid = tidx();
    const double dt = exp_d((double)log_dt[g]);
    for (int it = tid; it < 33 * 64; it += 512) { const int tau = it >> 6, p = it & 63; const double ar = a_re[g * 64 + p], ai = a_im[g * 64 + p];
        const double mag = exp_d(tau * ar * dt); double sn, cs; sincos_d(tau * ai * dt, sn, cs); pwr[it] = (float)(mag * cs); pwi[it] = (float)(mag * sn);
        if (tau == 32 && hsel == 0) { aT[(g * 64 + p) * 2] = (float)(mag * cs); aT[(g * 64 + p) * 2 + 1] = (float)(mag * sn); } }
    for (int it = tid; it < 1024; it += 512) { const int p = it >> 4, hh = it & 15; const double ar = a_re[g * 64 + p], ai = a_im[g * 64 + p];
        const double mag = exp_d(ar * dt); double sn, cs; sincos_d(ai * dt, sn, cs); const double nr = mag * cs - 1.0, ni = mag * sn, den = ar * ar + ai * ai;
        const double fr = (nr * ar + ni * ai) / den, fi = (ni * ar - nr * ai) / den; const double br = b_re[(g * 64 + p) * 16 + hh], bi = b_im[(g * 64 + p) * 16 + hh];
        Bbr[it] = (float)(fr * br - fi * bi); Bbi[it] = (float)(fr * bi + fi * br); }
    for (int it = tid; it < 1024; it += 512) { const int h_ = it >> 6, p_ = it & 63; Cr[p_ * 16 + h_] = c_re[g * 1024 + it]; Ci[p_ * 16 + h_] = c_im[g * 1024 + it]; }
    __syncthreads();
    { const int h = tid & 15, tau = tid >> 4;
      float kacc[16];
#pragma unroll
      for (int e = 0; e < 16; ++e) kacc[e] = 0.f;
      for (int p = 0; p < 64; ++p) { const float cr = Cr[p * 16 + h], ci = Ci[p * 16 + h], pr = pwr[tau * 64 + p], pi = pwi[tau * 64 + p];
          const float wre = cr * pr - ci * pi, wim = cr * pi + ci * pr;
#pragma unroll
          for (int q4 = 0; q4 < 4; ++q4) { const f32x4 br = *(const LAS f32x4*)(Bbr + p * 16 + 4 * q4), bi = *(const LAS f32x4*)(Bbi + p * 16 + 4 * q4);
#pragma unroll
              for (int e = 0; e < 4; ++e) kacc[4 * q4 + e] += wre * br[e] - wim * bi[e]; } }
#pragma unroll
      for (int hp = 0; hp < 16; ++hp) { float v = kacc[hp]; if (tau == 0 && h == hp) v += dsk[g * 16 + h]; Kt[(tau * 16 + h) * 16 + hp] = v; } }
    __syncthreads();
    for (int it = tid; it < 256 * 80; it += 512) { const int nl = it / 80, o = it - nl * 80, n = hsel * 256 + nl, t = n >> 4, h = n & 15, k0 = o * 8; f32x4 v0, v1;
        if (k0 < 512) { const int s = k0 >> 4, hp0 = k0 & 15;
#pragma unroll
            for (int e = 0; e < 4; ++e) { v0[e] = (s <= t) ? Kt[((t - s) * 16 + h) * 16 + hp0 + e] : 0.f; v1[e] = (s <= t) ? Kt[((t - s) * 16 + h) * 16 + hp0 + 4 + e] : 0.f; } }
        else { const bool im = k0 >= 576; const int p0 = k0 - (im ? 576 : 512);
#pragma unroll
            for (int e = 0; e < 8; ++e) { const int p = p0 + e; const float cr = Cr[p * 16 + h], ci = Ci[p * 16 + h], pr = pwr[(t + 1) * 64 + p], pi = pwi[(t + 1) * 64 + p];
                const float v = im ? -(cr * pi + ci * pr) : (cr * pr - ci * pi); if (e < 4) v0[e] = v; else v1[e - 4] = v; } }
        *(u32x4*)(BTY + ((size_t)(g * 512 + n)) * AK + k0) = pack8(v0, v1); }
    for (int it = tid; it < 128 * 64; it += 512) { const int n = hsel * 128 + (it >> 6), o = it & 63, k0 = o * 8, s = k0 >> 4, hp0 = k0 & 15; f32x4 v0 = {0.f, 0.f, 0.f, 0.f}, v1 = v0;
        if (n < 128) { const int p = n & 63, tau = 31 - s; const float pr = pwr[tau * 64 + p], pi = pwi[tau * 64 + p];
#pragma unroll
            for (int e = 0; e < 8; ++e) { const float br = Bbr[p * 16 + hp0 + e], bi = Bbi[p * 16 + hp0 + e]; const float v = (n < 64) ? (pr * br - pi * bi) : (pr * bi + pi * br);
                if (e < 4) v0[e] = v; else v1[e - 4] = v; } }
        *(u32x4*)(BTS + ((size_t)(g * 256 + n)) * 512 + k0) = pack8(v0, v1); }
    __syncthreads();
}

__device__ __forceinline__ void p0_prologue(LAS unsigned char* lds, ArgsP a) {
    const int tid = tidx(), lane = tid & 63, wave = tid >> 6, G = gridDim.x, bx = blockIdx.x;
    unsigned char* ws = a->ws;
    const bool split = G >= 128;
    if (!split || bx < 64) for (int u = bx; u < 64; u += G) ssm_precompute(lds, a, u >> 1, u & 1);
    if (split && bx < 64) return;
    const int nw = split ? G - 64 : G, wk = split ? bx - 64 : bx;
    { float* z1 = (float*)(ws + WS_RS1); for (int i = wk * 512 + tid; i < 3 * 16384; i += nw * 512) z1[i] = 0.f;
      float* z2 = (float*)(ws + WS_KMEAN); for (int i = wk * 512 + tid; i < 32768; i += nw * 512) z2[i] = 0.f;
      unsigned* z3 = (unsigned*)(ws + WS_PCNT); for (int i = wk * 512 + tid; i < 64 * 64 + 128; i += nw * 512) z3[i] = 0u; }
    { int gi = wk, base = 0; const int jend = (G == 256) ? 2 : 9;
      for (int j = 0; j < jend; ++j) { const WJob J = get_job(a, j); const int cnt = (J.K >> 6) * (J.ndst >> 8);
          while (gi < base + cnt) { wconv_item(J, gi - base); gi += nw; } base += cnt; } }
    { const float* x = a->in[0]; bf16_t* xb = (bf16_t*)(ws + WS_XB); float* rs0 = (float*)(ws + WS_RS0);
      for (int row = (wk * 8 + wave) * 4; row < M; row += nw * 32) { const f32x4* xr = (const f32x4*)(x + (size_t)row * DM); float ssr[4] = {0.f, 0.f, 0.f, 0.f}; f32x4 v[16];
#pragma unroll
          for (int i = 0; i < 16; ++i) v[i] = xr[lane + 64 * i];
#pragma unroll
          for (int i = 0; i < 16; ++i) { ssr[i >> 2] += v[i][0] * v[i][0] + v[i][1] * v[i][1] + v[i][2] * v[i][2] + v[i][3] * v[i][3];
              u32x2 w; w.x = cvt_pk_bf16(v[i][0], v[i][1]); w.y = cvt_pk_bf16(v[i][2], v[i][3]); *(u32x2*)(xb + (size_t)row * DM + (lane + 64 * i) * 4) = w; }
#pragma unroll
          for (int o = 32; o > 0; o >>= 1) {
#pragma unroll
              for (int r = 0; r < 4; ++r) ssr[r] += __shfl_xor(ssr[r], o); }
          if (lane == 0) { rs0[row] = ssr[0]; rs0[row + 1] = ssr[1]; rs0[row + 2] = ssr[2]; rs0[row + 3] = ssr[3]; } } }
    { float* rope = (float*)(ws + WS_ROPE);
      for (int i = wk * 512 + tid; i < SEQ * 32; i += nw * 512) { const int pos = i >> 5, fi = i & 31;
          const double invf = exp_d(-9.210340371976184 * (double)fi * (1.0 / 32.0)); double sn, cs; sincos_d((double)pos * invf, sn, cs);
          rope[i] = (float)cs; rope[SEQ * 32 + i] = (float)sn; } }
}

#define MFMA32(a, b, c) __builtin_amdgcn_mfma_f32_32x32x16_bf16((a), (b), (c), 0, 0, 0)

__device__ __forceinline__ void moba_assign(const LAS unsigned* mk, int r, int& ql, bool& valid, int& ntile) {
    unsigned tot = 0, word = 0, base = 0; int wsel = 0; bool found = false;
#pragma unroll
    for (int ww = 0; ww < 8; ++ww) { const unsigned m = mk[ww]; const unsigned pc = __popc(m); if (!found && (unsigned)r < tot + pc) { word = m; base = tot; wsel = ww; found = true; } tot += pc; }
    valid = found; ntile = (int)((tot + 31u) >> 5);
    int k = found ? r - (int)base : 0, pos = 0;
#pragma unroll
    for (int sft = 16; sft >= 1; sft >>= 1) { const int c = __popc(word & (((1u << sft) - 1u) << pos)); if (k >= c) { k -= c; pos += sft; } }
    ql = found ? wsel * 32 + (pos & 31) : 0;
}
__device__ __forceinline__ void attn_unit_h(LAS unsigned char* lds, const bf16_t* Q, const bf16_t* Kb, const bf16_t* VT, const float* kmean, bf16_t* O, int b, int h, int qb) {
    const int tid = tidx(), w = tid >> 6, lane = tid & 63, qi = lane & 31, hf = lane >> 5;
    LAS bf16_t* Kt = (LAS bf16_t*)lds;
    LAS bf16_t* Vt = (LAS bf16_t*)(lds + 36864);
    LAS float* km = (LAS float*)(lds + 70656);
    LAS unsigned* msk = (LAS unsigned*)(lds + 78592);
    LAS float* stt = (LAS float*)(lds + 79616);
    const int cur = qb;
    for (int i = tid; i < cur * 64; i += 512) km[i] = kmean[(size_t)((b * 8 + h) * 32) * 64 + i];
    const int row0 = b * SEQ + qb * 256, qown = 32 * w + qi;
    bf16x8 qf[4];
#pragma unroll
    for (int st = 0; st < 4; ++st) qf[st] = *(const bf16x8*)(Q + (size_t)(row0 + qown) * 512 + h * 64 + 16 * st + 8 * hf);
    const int sr = tid >> 3, sc = (tid & 7) * 8;
    const bf16_t* kg = Kb + ((size_t)(b * 8 + h) * SEQ + sr) * 64 + sc;
    const bf16_t* vg = VT + ((size_t)((b * 8 + h) * 32) * 64 + sr) * 256 + sc;
    u32x4 kreg[4], vreg[4];
    { const int kb0 = qb * 256;
#pragma unroll
      for (int p = 0; p < 4; ++p) { kreg[p] = *(const u32x4*)(kg + (size_t)(kb0 + 64 * p) * 64); vreg[p] = *(const u32x4*)(vg + (size_t)(kb0 >> 8) * 16384 + 64 * p); } }
    __syncthreads();
    int i0 = 0, i1 = 1, i2 = 2;
    if (cur > 3) {
        float qv[32];
#pragma unroll
        for (int st = 0; st < 4; ++st)
#pragma unroll
            for (int e = 0; e < 8; ++e) qv[st * 8 + e] = __uint_as_float(((unsigned)(unsigned short)qf[st][e]) << 16);
        float b0 = -3e38f, b1 = -3e38f, b2 = -3e38f;
        for (int j = 0; j < cur; ++j) { float g = 0.f;
#pragma unroll
            for (int st = 0; st < 4; ++st) { const f32x4 k0 = *(const LAS f32x4*)(km + j * 64 + 16 * st + 8 * hf), k1 = *(const LAS f32x4*)(km + j * 64 + 16 * st + 8 * hf + 4);
#pragma unroll
                for (int e = 0; e < 4; ++e) { g += qv[st * 8 + e] * k0[e]; g += qv[st * 8 + 4 + e] * k1[e]; } }
            g += __shfl_xor(g, 32);
            if (g > b0) { b2 = b1; i2 = i1; b1 = b0; i1 = i0; b0 = g; i0 = j; } else if (g > b1) { b2 = b1; i2 = i1; b1 = g; i1 = j; } else if (g > b2) { b2 = g; i2 = j; } }
    }
    for (int j = 0; j < cur; ++j) { const bool sj = (cur <= 3) || j == i0 || j == i1 || j == i2; const unsigned long long bal = __ballot(sj); if (lane == 0) msk[j * 8 + w] = (unsigned)bal; }
#pragma unroll
    for (int p = 0; p < 4; ++p) { *(LAS u32x4*)(Kt + (sr + 64 * p) * 72 + sc) = kreg[p]; *(LAS u32x4*)(Vt + sr * 264 + sc + 64 * p) = vreg[p]; }
    __syncthreads();
    f32x16 o0, o1;
#pragma unroll
    for (int e = 0; e < 16; ++e) { o0[e] = 0.f; o1[e] = 0.f; }
    float mrun = NEGBIG, lrun = 0.f;
    const int krow = (qi & 19) | ((qi & 4) << 1) | ((qi & 8) >> 1);
    int qln = 0, ntn = 0; bool validn = false; bf16x8 gqA[4], gqB[4];
    if (cur > 0) { moba_assign(msk, 32 * w + qi, qln, validn, ntn); if (ntn <= 4) moba_assign(msk, 32 * (w >> 1) + qi, qln, validn, ntn);
#pragma unroll
        for (int st = 0; st < 4; ++st) gqA[st] = *(const bf16x8*)(Q + (size_t)(row0 + qln) * 512 + h * 64 + 16 * st + 8 * hf); }
    int qlc = qown, ntc = 8; bool validc = true; bool pairm = false, second = false; int tq = w;
    { const int blk0 = 0;
    {
        const bool own = true;
        if (blk0 < cur) { const int kb1 = blk0 * 256;
#pragma unroll
            for (int p = 0; p < 4; ++p) { kreg[p] = *(const u32x4*)(kg + (size_t)(kb1 + 64 * p) * 64); vreg[p] = *(const u32x4*)(vg + (size_t)(kb1 >> 8) * 16384 + 64 * p); } }
        if (!own) {
            qlc = qln; ntc = ntn; validc = validn;
            if (blk0 < cur) { moba_assign(msk + blk0 * 8, 32 * w + qi, qln, validn, ntn); if (ntn <= 4) moba_assign(msk + blk0 * 8, 32 * (w >> 1) + qi, qln, validn, ntn);
#pragma unroll
                for (int st = 0; st < 4; ++st) gqA[st] = *(const bf16x8*)(Q + (size_t)(row0 + qln) * 512 + h * 64 + 16 * st + 8 * hf); }
            pairm = ntc <= 4; tq = pairm ? (w >> 1) : w; second = pairm && (w & 1);
            if (second) {
#pragma unroll
                for (int e = 0; e < 16; ++e) { o0[e] = 0.f; o1[e] = 0.f; }
                mrun = NEGBIG; lrun = 0.f;
            } else if (tq < ntc) { const LAS float* sp = stt + qlc * 68;
#pragma unroll
                for (int g4 = 0; g4 < 4; ++g4) { const f32x4 a = *(const LAS f32x4*)(sp + 8 * g4 + 4 * hf), c = *(const LAS f32x4*)(sp + 32 + 8 * g4 + 4 * hf);
#pragma unroll
                    for (int e = 0; e < 4; ++e) { o0[4 * g4 + e] = a[e]; o1[4 * g4 + e] = c[e]; } }
                mrun = sp[64]; lrun = hf == 0 ? sp[65] : 0.f; }
        }
        const bool allowed = own || validc;
        const int tlo = (!own && second) ? 2 : 0, thi = (!own && pairm && !second) ? 2 : 4;
        for (int ti = tlo; ti < thi; ++ti) {
            bool active, partial = false;
            if (own) { const int klo = 64 * ti, qlo = 32 * w; active = !(klo > qlo + 31); partial = (klo + 63 > qlo); }
            else active = (tq < ntc);
            if (active) {
                f32x16 s0, s1;
#pragma unroll
                for (int e = 0; e < 16; ++e) { s0[e] = 0.f; s1[e] = 0.f; }
                const LAS bf16_t* kt = Kt + (64 * ti) * 72;
#pragma unroll
                for (int st = 0; st < 4; ++st) { const bf16x8 a0 = *(const LAS bf16x8*)(kt + krow * 72 + 16 * st + 8 * hf), a1 = *(const LAS bf16x8*)(kt + (32 + krow) * 72 + 16 * st + 8 * hf);
                    s0 = MFMA32(a0, qf[st], s0); s1 = MFMA32(a1, qf[st], s1); }
                if (partial) { const int qrel = 32 * w + qi - 64 * ti;
#pragma unroll
                    for (int e = 0; e < 16; ++e) { const int ko = 16 * (e >> 3) + 8 * hf + (e & 7); if (ko > qrel) s0[e] = NEGBIG; if (ko + 32 > qrel) s1[e] = NEGBIG; } }
                float mx = s0[0];
#pragma unroll
                for (int e = 1; e < 16; ++e) mx = fmaxf(mx, s0[e]);
#pragma unroll
                for (int e = 0; e < 16; ++e) mx = fmaxf(mx, s1[e]);
                if (!allowed) mx = NEGBIG;
                mx = fmaxf(mx, __shfl_xor(mx, 32));
                const bool need = mx > mrun + 40.f;
                if (__ballot(need) != 0ull) {
                    const float mn = need ? mx : mrun, alpha = __builtin_amdgcn_exp2f(mrun - mn); mrun = mn; lrun *= alpha;
#pragma unroll
                    for (int e = 0; e < 16; ++e) { o0[e] *= alpha; o1[e] *= alpha; }
                }
                const float msub = allowed ? mrun : 1e30f;
                f32x2 ps2 = {0.f, 0.f};
#pragma unroll
                for (int e = 0; e < 16; e += 2) { f32x2 d0 = {s0[e], s0[e + 1]}, d1 = {s1[e], s1[e + 1]}; d0 = d0 - msub; d1 = d1 - msub;
                    s0[e] = __builtin_amdgcn_exp2f(d0.x); s0[e + 1] = __builtin_amdgcn_exp2f(d0.y); s1[e] = __builtin_amdgcn_exp2f(d1.x); s1[e + 1] = __builtin_amdgcn_exp2f(d1.y);
                    ps2 = ps2 + (f32x2){s0[e], s0[e + 1]}; ps2 = ps2 + (f32x2){s1[e], s1[e + 1]}; }
                lrun += ps2.x + ps2.y;
                const LAS bf16_t* vt = Vt + 64 * ti;
#pragma unroll
                for (int kh = 0; kh < 2; ++kh)
#pragma unroll
                    for (int s = 0; s < 2; ++s) {
                        union { u32x4 u; bf16x8 v; } pf;
                        if (kh == 0) { pf.u.x = cvt_pk_bf16(s0[8 * s], s0[8 * s + 1]); pf.u.y = cvt_pk_bf16(s0[8 * s + 2], s0[8 * s + 3]); pf.u.z = cvt_pk_bf16(s0[8 * s + 4], s0[8 * s + 5]); pf.u.w = cvt_pk_bf16(s0[8 * s + 6], s0[8 * s + 7]); }
                        else { pf.u.x = cvt_pk_bf16(s1[8 * s], s1[8 * s + 1]); pf.u.y = cvt_pk_bf16(s1[8 * s + 2], s1[8 * s + 3]); pf.u.z = cvt_pk_bf16(s1[8 * s + 4], s1[8 * s + 5]); pf.u.w = cvt_pk_bf16(s1[8 * s + 6], s1[8 * s + 7]); }
                        const bf16x8 v0 = *(const LAS bf16x8*)(vt + qi * 264 + 32 * kh + 16 * s + 8 * hf), v1 = *(const LAS bf16x8*)(vt + (32 + qi) * 264 + 32 * kh + 16 * s + 8 * hf);
                        o0 = MFMA32(v0, pf.v, o0); o1 = MFMA32(v1, pf.v, o1);
                    }
            }
        }
        if (own || (!second && tq < ntc && validc)) {
            const float lt = lrun + __shfl_xor(lrun, 32);
            LAS float* sp = stt + qlc * 68;
#pragma unroll
            for (int g4 = 0; g4 < 4; ++g4) { f32x4 a, c;
#pragma unroll
                for (int e = 0; e < 4; ++e) { a[e] = o0[4 * g4 + e]; c[e] = o1[4 * g4 + e]; }
                *(LAS f32x4*)(sp + 8 * g4 + 4 * hf) = a; *(LAS f32x4*)(sp + 32 + 8 * g4 + 4 * hf) = c; }
            if (hf == 0) { sp[64] = mrun; sp[65] = lt; }
        }
        __syncthreads();
        if (!own && second && tq < ntc && validc) {
            const float lB = lrun + __shfl_xor(lrun, 32);
            LAS float* sp = stt + qlc * 68;
            const float mA = sp[64], lA = sp[65], mM = fmaxf(mA, mrun), ca = __builtin_amdgcn_exp2f(mA - mM), cb = __builtin_amdgcn_exp2f(mrun - mM);
#pragma unroll
            for (int g4 = 0; g4 < 4; ++g4) { f32x4 x = *(const LAS f32x4*)(sp + 8 * g4 + 4 * hf), y = *(const LAS f32x4*)(sp + 32 + 8 * g4 + 4 * hf);
#pragma unroll
                for (int e = 0; e < 4; ++e) { x[e] = x[e] * ca + o0[4 * g4 + e] * cb; y[e] = y[e] * ca + o1[4 * g4 + e] * cb; }
                *(LAS f32x4*)(sp + 8 * g4 + 4 * hf) = x; *(LAS f32x4*)(sp + 32 + 8 * g4 + 4 * hf) = y; }
            if (hf == 0) { sp[64] = mM; sp[65] = lA * ca + lB * cb; }
        }
        if (blk0 < cur) {
#pragma unroll
            for (int p = 0; p < 4; ++p) { *(LAS u32x4*)(Kt + (sr + 64 * p) * 72 + sc) = kreg[p]; *(LAS u32x4*)(Vt + sr * 264 + sc + 64 * p) = vreg[p]; }
            __syncthreads();
        }
        }
    }
    for (int blk = 1; blk <= cur; blk += 2) {
    {
        const bool own = false;
        if (blk < cur) { const int kb1 = blk * 256;
#pragma unroll
            for (int p = 0; p < 4; ++p) { kreg[p] = *(const u32x4*)(kg + (size_t)(kb1 + 64 * p) * 64); vreg[p] = *(const u32x4*)(vg + (size_t)(kb1 >> 8) * 16384 + 64 * p); } }
        if (!own) {
            qlc = qln; ntc = ntn; validc = validn;
            if (blk < cur) { moba_assign(msk + blk * 8, 32 * w + qi, qln, validn, ntn); if (ntn <= 4) moba_assign(msk + blk * 8, 32 * (w >> 1) + qi, qln, validn, ntn);
#pragma unroll
                for (int st = 0; st < 4; ++st) gqB[st] = *(const bf16x8*)(Q + (size_t)(row0 + qln) * 512 + h * 64 + 16 * st + 8 * hf); }
            pairm = ntc <= 4; tq = pairm ? (w >> 1) : w; second = pairm && (w & 1);
            if (second) {
#pragma unroll
                for (int e = 0; e < 16; ++e) { o0[e] = 0.f; o1[e] = 0.f; }
                mrun = NEGBIG; lrun = 0.f;
            } else if (tq < ntc) { const LAS float* sp = stt + qlc * 68;
#pragma unroll
                for (int g4 = 0; g4 < 4; ++g4) { const f32x4 a = *(const LAS f32x4*)(sp + 8 * g4 + 4 * hf), c = *(const LAS f32x4*)(sp + 32 + 8 * g4 + 4 * hf);
#pragma unroll
                    for (int e = 0; e < 4; ++e) { o0[4 * g4 + e] = a[e]; o1[4 * g4 + e] = c[e]; } }
                mrun = sp[64]; lrun = hf == 0 ? sp[65] : 0.f; }
        }
        const bool allowed = own || validc;
        const int tlo = (!own && second) ? 2 : 0, thi = (!own && pairm && !second) ? 2 : 4;
        for (int ti = tlo; ti < thi; ++ti) {
            bool active, partial = false;
            if (own) { const int klo = 64 * ti, qlo = 32 * w; active = !(klo > qlo + 31); partial = (klo + 63 > qlo); }
            else active = (tq < ntc);
            if (active) {
                f32x16 s0, s1;
#pragma unroll
                for (int e = 0; e < 16; ++e) { s0[e] = 0.f; s1[e] = 0.f; }
                const LAS bf16_t* kt = Kt + (64 * ti) * 72;
#pragma unroll
                for (int st = 0; st < 4; ++st) { const bf16x8 a0 = *(const LAS bf16x8*)(kt + krow * 72 + 16 * st + 8 * hf), a1 = *(const LAS bf16x8*)(kt + (32 + krow) * 72 + 16 * st + 8 * hf);
                    s0 = MFMA32(a0, gqA[st], s0); s1 = MFMA32(a1, gqA[st], s1); }
                if (partial) { const int qrel = 32 * w + qi - 64 * ti;
#pragma unroll
                    for (int e = 0; e < 16; ++e) { const int ko = 16 * (e >> 3) + 8 * hf + (e & 7); if (ko > qrel) s0[e] = NEGBIG; if (ko + 32 > qrel) s1[e] = NEGBIG; } }
                float mx = s0[0];
#pragma unroll
                for (int e = 1; e < 16; ++e) mx = fmaxf(mx, s0[e]);
#pragma unroll
                for (int e = 0; e < 16; ++e) mx = fmaxf(mx, s1[e]);
                if (!allowed) mx = NEGBIG;
                mx = fmaxf(mx, __shfl_xor(mx, 32));
                const bool need = mx > mrun + 40.f;
                if (__ballot(need) != 0ull) {
                    const float mn = need ? mx : mrun, alpha = __builtin_amdgcn_exp2f(mrun - mn); mrun = mn; lrun *= alpha;
#pragma unroll
                    for (int e = 0; e < 16; ++e) { o0[e] *= alpha; o1[e] *= alpha; }
                }
                const float msub = allowed ? mrun : 1e30f;
                f32x2 ps2 = {0.f, 0.f};
#pragma unroll
                for (int e = 0; e < 16; e += 2) { f32x2 d0 = {s0[e], s0[e + 1]}, d1 = {s1[e], s1[e + 1]}; d0 = d0 - msub; d1 = d1 - msub;
                    s0[e] = __builtin_amdgcn_exp2f(d0.x); s0[e + 1] = __builtin_amdgcn_exp2f(d0.y); s1[e] = __builtin_amdgcn_exp2f(d1.x); s1[e + 1] = __builtin_amdgcn_exp2f(d1.y);
                    ps2 = ps2 + (f32x2){s0[e], s0[e + 1]}; ps2 = ps2 + (f32x2){s1[e], s1[e + 1]}; }
                lrun += ps2.x + ps2.y;
                const LAS bf16_t* vt = Vt + 64 * ti;
#pragma unroll
                for (int kh = 0; kh < 2; ++kh)
#pragma unroll
                    for (int s = 0; s < 2; ++s) {
                        union { u32x4 u; bf16x8 v; } pf;
                        if (kh == 0) { pf.u.x = cvt_pk_bf16(s0[8 * s], s0[8 * s + 1]); pf.u.y = cvt_pk_bf16(s0[8 * s + 2], s0[8 * s + 3]); pf.u.z = cvt_pk_bf16(s0[8 * s + 4], s0[8 * s + 5]); pf.u.w = cvt_pk_bf16(s0[8 * s + 6], s0[8 * s + 7]); }
                        else { pf.u.x = cvt_pk_bf16(s1[8 * s], s1[8 * s + 1]); pf.u.y = cvt_pk_bf16(s1[8 * s + 2], s1[8 * s + 3]); pf.u.z = cvt_pk_bf16(s1[8 * s + 4], s1[8 * s + 5]); pf.u.w = cvt_pk_bf16(s1[8 * s + 6], s1[8 * s + 7]); }
                        const bf16x8 v0 = *(const LAS bf16x8*)(vt + qi * 264 + 32 * kh + 16 * s + 8 * hf), v1 = *(const LAS bf16x8*)(vt + (32 + qi) * 264 + 32 * kh + 16 * s + 8 * hf);
                        o0 = MFMA32(v0, pf.v, o0); o1 = MFMA32(v1, pf.v, o1);
                    }
            }
        }
        if (own || (!second && tq < ntc && validc)) {
            const float lt = lrun + __shfl_xor(lrun, 32);
            LAS float* sp = stt + qlc * 68;
#pragma unroll
            for (int g4 = 0; g4 < 4; ++g4) { f32x4 a, c;
#pragma unroll
                for (int e = 0; e < 4; ++e) { a[e] = o0[4 * g4 + e]; c[e] = o1[4 * g4 + e]; }
                *(LAS f32x4*)(sp + 8 * g4 + 4 * hf) = a; *(LAS f32x4*)(sp + 32 + 8 * g4 + 4 * hf) = c; }
            if (hf == 0) { sp[64] = mrun; sp[65] = lt; }
        }
        __syncthreads();
        if (!own && second && tq < ntc && validc) {
            const float lB = lrun + __shfl_xor(lrun, 32);
            LAS float* sp = stt + qlc * 68;
            const float mA = sp[64], lA = sp[65], mM = fmaxf(mA, mrun), ca = __builtin_amdgcn_exp2f(mA - mM), cb = __builtin_amdgcn_exp2f(mrun - mM);
#pragma unroll
            for (int g4 = 0; g4 < 4; ++g4) { f32x4 x = *(const LAS f32x4*)(sp + 8 * g4 + 4 * hf), y = *(const LAS f32x4*)(sp + 32 + 8 * g4 + 4 * hf);
#pragma unroll
                for (int e = 0; e < 4; ++e) { x[e] = x[e] * ca + o0[4 * g4 + e] * cb; y[e] = y[e] * ca + o1[4 * g4 + e] * cb; }
                *(LAS f32x4*)(sp + 8 * g4 + 4 * hf) = x; *(LAS f32x4*)(sp + 32 + 8 * g4 + 4 * hf) = y; }
            if (hf == 0) { sp[64] = mM; sp[65] = lA * ca + lB * cb; }
        }
        if (blk < cur) {
#pragma unroll
            for (int p = 0; p < 4; ++p) { *(LAS u32x4*)(Kt + (sr + 64 * p) * 72 + sc) = kreg[p]; *(LAS u32x4*)(Vt + sr * 264 + sc + 64 * p) = vreg[p]; }
            __syncthreads();
        }
        }
        if (blk + 1 <= cur) { const int blkb = blk + 1;
    {
        const bool own = false;
        if (blkb < cur) { const int kb1 = blkb * 256;
#pragma unroll
            for (int p = 0; p < 4; ++p) { kreg[p] = *(const u32x4*)(kg + (size_t)(kb1 + 64 * p) * 64); vreg[p] = *(const u32x4*)(vg + (size_t)(kb1 >> 8) * 16384 + 64 * p); } }
        if (!own) {
            qlc = qln; ntc = ntn; validc = validn;
            if (blkb < cur) { moba_assign(msk + blkb * 8, 32 * w + qi, qln, validn, ntn); if (ntn <= 4) moba_assign(msk + blkb * 8, 32 * (w >> 1) + qi, qln, validn, ntn);
#pragma unroll
                for (int st = 0; st < 4; ++st) gqA[st] = *(const bf16x8*)(Q + (size_t)(row0 + qln) * 512 + h * 64 + 16 * st + 8 * hf); }
            pairm = ntc <= 4; tq = pairm ? (w >> 1) : w; second = pairm && (w & 1);
            if (second) {
#pragma unroll
                for (int e = 0; e < 16; ++e) { o0[e] = 0.f; o1[e] = 0.f; }
                mrun = NEGBIG; lrun = 0.f;
            } else if (tq < ntc) { const LAS float* sp = stt + qlc * 68;
#pragma unroll
                for (int g4 = 0; g4 < 4; ++g4) { const f32x4 a = *(const LAS f32x4*)(sp + 8 * g4 + 4 * hf), c = *(const LAS f32x4*)(sp + 32 + 8 * g4 + 4 * hf);
#pragma unroll
                    for (int e = 0; e < 4; ++e) { o0[4 * g4 + e] = a[e]; o1[4 * g4 + e] = c[e]; } }
                mrun = sp[64]; lrun = hf == 0 ? sp[65] : 0.f; }
        }
        const bool allowed = own || validc;
        const int tlo = (!own && second) ? 2 : 0, thi = (!own && pairm && !second) ? 2 : 4;
        for (int ti = tlo; ti < thi; ++ti) {
            bool active, partial = false;
            if (own) { const int klo = 64 * ti, qlo = 32 * w; active = !(klo > qlo + 31); partial = (klo + 63 > qlo); }
            else active = (tq < ntc);
            if (active) {
                f32x16 s0, s1;
#pragma unroll
                for (int e = 0; e < 16; ++e) { s0[e] = 0.f; s1[e] = 0.f; }
                const LAS bf16_t* kt = Kt + (64 * ti) * 72;
#pragma unroll
                for (int st = 0; st < 4; ++st) { const bf16x8 a0 = *(const LAS bf16x8*)(kt + krow * 72 + 16 * st + 8 * hf), a1 = *(const LAS bf16x8*)(kt + (32 + krow) * 72 + 16 * st + 8 * hf);
                    s0 = MFMA32(a0, gqB[st], s0); s1 = MFMA32(a1, gqB[st], s1); }
                if (partial) { const int qrel = 32 * w + qi - 64 * ti;
#pragma unroll
                    for (int e = 0; e < 16; ++e) { const int ko = 16 * (e >> 3) + 8 * hf + (e & 7); if (ko > qrel) s0[e] = NEGBIG; if (ko + 32 > qrel) s1[e] = NEGBIG; } }
                float mx = s0[0];
#pragma unroll
                for (int e = 1; e < 16; ++e) mx = fmaxf(mx, s0[e]);
#pragma unroll
                for (int e = 0; e < 16; ++e) mx = fmaxf(mx, s1[e]);
                if (!allowed) mx = NEGBIG;
                mx = fmaxf(mx, __shfl_xor(mx, 32));
                const bool need = mx > mrun + 40.f;
                if (__ballot(need) != 0ull) {
                    const float mn = need ? mx : mrun, alpha = __builtin_amdgcn_exp2f(mrun - mn); mrun = mn; lrun *= alpha;
#pragma unroll
                    for (int e = 0; e < 16; ++e) { o0[e] *= alpha; o1[e] *= alpha; }
                }
                const float msub = allowed ? mrun : 1e30f;
                f32x2 ps2 = {0.f, 0.f};
#pragma unroll
                for (int e = 0; e < 16; e += 2) { f32x2 d0 = {s0[e], s0[e + 1]}, d1 = {s1[e], s1[e + 1]}; d0 = d0 - msub; d1 = d1 - msub;
                    s0[e] = __builtin_amdgcn_exp2f(d0.x); s0[e + 1] = __builtin_amdgcn_exp2f(d0.y); s1[e] = __builtin_amdgcn_exp2f(d1.x); s1[e + 1] = __builtin_amdgcn_exp2f(d1.y);
                    ps2 = ps2 + (f32x2){s0[e], s0[e + 1]}; ps2 = ps2 + (f32x2){s1[e], s1[e + 1]}; }
                lrun += ps2.x + ps2.y;
                const LAS bf16_t* vt = Vt + 64 * ti;
#pragma unroll
                for (int kh = 0; kh < 2; ++kh)
#pragma unroll
                    for (int s = 0; s < 2; ++s) {
                        union { u32x4 u; bf16x8 v; } pf;
                        if (kh == 0) { pf.u.x = cvt_pk_bf16(s0[8 * s], s0[8 * s + 1]); pf.u.y = cvt_pk_bf16(s0[8 * s + 2], s0[8 * s + 3]); pf.u.z = cvt_pk_bf16(s0[8 * s + 4], s0[8 * s + 5]); pf.u.w = cvt_pk_bf16(s0[8 * s + 6], s0[8 * s + 7]); }
                        else { pf.u.x = cvt_pk_bf16(s1[8 * s], s1[8 * s + 1]); pf.u.y = cvt_pk_bf16(s1[8 * s + 2], s1[8 * s + 3]); pf.u.z = cvt_pk_bf16(s1[8 * s + 4], s1[8 * s + 5]); pf.u.w = cvt_pk_bf16(s1[8 * s + 6], s1[8 * s + 7]); }
                        const bf16x8 v0 = *(const LAS bf16x8*)(vt + qi * 264 + 32 * kh + 16 * s + 8 * hf), v1 = *(const LAS bf16x8*)(vt + (32 + qi) * 264 + 32 * kh + 16 * s + 8 * hf);
                        o0 = MFMA32(v0, pf.v, o0); o1 = MFMA32(v1, pf.v, o1);
                    }
            }
        }
        if (own || (!second && tq < ntc && validc)) {
            const float lt = lrun + __shfl_xor(lrun, 32);
            LAS float* sp = stt + qlc * 68;
#pragma unroll
            for (int g4 = 0; g4 < 4; ++g4) { f32x4 a, c;
#pragma unroll
                for (int e = 0; e < 4; ++e) { a[e] = o0[4 * g4 + e]; c[e] = o1[4 * g4 + e]; }
                *(LAS f32x4*)(sp + 8 * g4 + 4 * hf) = a; *(LAS f32x4*)(sp + 32 + 8 * g4 + 4 * hf) = c; }
            if (hf == 0) { sp[64] = mrun; sp[65] = lt; }
        }
        __syncthreads();
        if (!own && second && tq < ntc && validc) {
            const float lB = lrun + __shfl_xor(lrun, 32);
            LAS float* sp = stt + qlc * 68;
            const float mA = sp[64], lA = sp[65], mM = fmaxf(mA, mrun), ca = __builtin_amdgcn_exp2f(mA - mM), cb = __builtin_amdgcn_exp2f(mrun - mM);
#pragma unroll
            for (int g4 = 0; g4 < 4; ++g4) { f32x4 x = *(const LAS f32x4*)(sp + 8 * g4 + 4 * hf), y = *(const LAS f32x4*)(sp + 32 + 8 * g4 + 4 * hf);
#pragma unroll
                for (int e = 0; e < 4; ++e) { x[e] = x[e] * ca + o0[4 * g4 + e] * cb; y[e] = y[e] * ca + o1[4 * g4 + e] * cb; }
                *(LAS f32x4*)(sp + 8 * g4 + 4 * hf) = x; *(LAS f32x4*)(sp + 32 + 8 * g4 + 4 * hf) = y; }
            if (hf == 0) { sp[64] = mM; sp[65] = lA * ca + lB * cb; }
        }
        if (blkb < cur) {
#pragma unroll
            for (int p = 0; p < 4; ++p) { *(LAS u32x4*)(Kt + (sr + 64 * p) * 72 + sc) = kreg[p]; *(LAS u32x4*)(Vt + sr * 264 + sc + 64 * p) = vreg[p]; }
            __syncthreads();
        }
        }
        }
    }
    __syncthreads();
    {
        const LAS float* sp = stt + qown * 68; const float il = 1.f / sp[65];
        bf16_t* op = O + (size_t)(row0 + qown) * 512 + h * 64 + 4 * hf;
#pragma unroll
        for (int g4 = 0; g4 < 4; ++g4) { const f32x4 a = *(const LAS f32x4*)(sp + 8 * g4 + 4 * hf), c = *(const LAS f32x4*)(sp + 32 + 8 * g4 + 4 * hf); u32x2 w0, w1;
            w0.x = cvt_pk_bf16(a[0] * il, a[1] * il); w0.y = cvt_pk_bf16(a[2] * il, a[3] * il); w1.x = cvt_pk_bf16(c[0] * il, c[1] * il); w1.y = cvt_pk_bf16(c[2] * il, c[3] * il);
            *(u32x2*)(op + 8 * g4) = w0; *(u32x2*)(op + 32 + 8 * g4) = w1; }
    }
    __syncthreads();
}

__device__ __forceinline__ void ssm_scan_pairs(LAS unsigned char* lds, unsigned char* ws, int pr0, int prstep) {
    const int tid = tidx();
        LAS float* Es = (LAS float*)lds;
        for (int pr = pr0; pr < 64; pr += prstep) { const int g = pr >> 1, b = pr & 1, p = tid & 63, seg = tid >> 6; const int row0 = g * 512 + b * 256 + seg * 32;
            const float* aT = (const float*)(ws + WS_AT); const float ar = aT[(g * 64 + p) * 2], ai = aT[(g * 64 + p) * 2 + 1];
            const float* S = (const float*)(ws + WS_SOUT) + (size_t)row0 * 128; bf16_t* AP = (bf16_t*)(ws + WS_AP) + (size_t)row0 * AK + 512;
            float sr_[32], si_[32];
#pragma unroll
            for (int e = 0; e < 32; ++e) { sr_[e] = S[(size_t)e * 128 + p]; si_[e] = S[(size_t)e * 128 + 64 + p]; }
            float hr = 0.f, hi_ = 0.f;
#pragma unroll
            for (int e = 0; e < 32; ++e) { const float nr = ar * hr - ai * hi_ + sr_[e], ni = ar * hi_ + ai * hr + si_[e]; hr = nr; hi_ = ni; }
            Es[(seg * 64 + p) * 2] = hr; Es[(seg * 64 + p) * 2 + 1] = hi_;
            float a32r = ar, a32i = ai;
#pragma unroll
            for (int q = 0; q < 5; ++q) { const float nr = a32r * a32r - a32i * a32i, ni = 2.f * a32r * a32i; a32r = nr; a32i = ni; }
            __syncthreads();
            hr = 0.f; hi_ = 0.f;
            for (int j = 0; j < seg; ++j) { const float er = Es[(j * 64 + p) * 2], ei = Es[(j * 64 + p) * 2 + 1]; const float nr = a32r * hr - a32i * hi_ + er, ni = a32r * hi_ + a32i * hr + ei; hr = nr; hi_ = ni; }
#pragma unroll
            for (int e = 0; e < 32; ++e) { bf16_t* o = AP + (size_t)e * AK; o[p] = (bf16_t)(cvt_pk_bf16(hr, 0.f) & 0xffffu); o[64 + p] = (bf16_t)(cvt_pk_bf16(hi_, 0.f) & 0xffffu);
                const float nr = ar * hr - ai * hi_ + sr_[e], ni = ar * hi_ + ai * hr + si_[e]; hr = nr; hi_ = ni; }
            __syncthreads(); }
}

#define XB_TMO      128
#define XB_XCNT(j)  (256  + 64 * (j))
#define XB_XSUB(j)  (1280 + 64 * (j))
#define XB_XGEN(j)  (2304 + 64 * (j))
#define XB_TOP      3328
#define XB_TOPGEN   3392
#define XCD_BAR_WORDS 3456
#define XB_SPIN_CAP (1u << 18)
__device__ __forceinline__ unsigned xb_ld(unsigned* p)              { return __hip_atomic_load(p, __ATOMIC_RELAXED, __HIP_MEMORY_SCOPE_AGENT); }
__device__ __forceinline__ unsigned xb_add(unsigned* p, unsigned v) { return __hip_atomic_fetch_add(p, v, __ATOMIC_RELAXED, __HIP_MEMORY_SCOPE_AGENT); }
__device__ __forceinline__ unsigned xb_xcc_id() { return (unsigned)__builtin_amdgcn_s_getreg((3 << 11) | 20) & 0xFu; }
#define XB_SPIN(cond, bar) do { unsigned _sp = 0; while (cond) { __builtin_amdgcn_s_sleep(1); \
    if ((++_sp & 255u) == 0u) { if (xb_ld(&(bar)[XB_TMO])) break; if (_sp > XB_SPIN_CAP) { atomicAdd(&(bar)[XB_TMO], 1u); break; } } } } while (0)
struct XcdBarrier { unsigned* bar; unsigned x; volatile LAS unsigned* st; };
__device__ __forceinline__ XcdBarrier xcd_barrier_post(unsigned* bar, volatile LAS unsigned* st) {
    XcdBarrier b; b.bar = bar; b.x = xb_xcc_id(); b.st = st;
    if (tidx() == 0) (void)xb_add(&bar[XB_XCNT(b.x)], 1u);
    return b;
}
__device__ __forceinline__ void xcd_barrier_complete(unsigned* bar, unsigned x, unsigned& nloc, unsigned& nx) {
    const unsigned G = gridDim.x * gridDim.y * gridDim.z;
    unsigned sum, cnt, mine, sp = 0u;
    for (;;) {
        sum = 0u; cnt = 0u; mine = 0u;
#pragma unroll
        for (unsigned j = 0; j < 16; ++j) { const unsigned c = xb_ld(&bar[XB_XCNT(j)]); sum += c; cnt += (c > 0u) ? 1u : 0u; mine = (j == x) ? c : mine; }
        if (sum == G) break;
        __builtin_amdgcn_s_sleep(1);
        if ((++sp & 255u) == 0u) { if (xb_ld(&bar[XB_TMO])) break; if (sp > XB_SPIN_CAP) { atomicAdd(&bar[XB_TMO], 1u); break; } }
    }
    nloc = mine > 0u ? mine : 1u; nx = cnt > 0u ? cnt : 1u;
}
__device__ __forceinline__ void xcd_barrier(const XcdBarrier& b) {
    asm volatile("s_waitcnt vmcnt(0)" ::: "memory");
    __syncthreads();
    if (tidx() == 0) {
        unsigned* bar = b.bar;
        __builtin_amdgcn_s_waitcnt(0);
        unsigned nloc = b.st[0], nx = b.st[1];
        if (nloc == 0u) { xcd_barrier_complete(bar, b.x, nloc, nx); b.st[0] = nloc; b.st[1] = nx; }
        const unsigned old = xb_add(&bar[XB_XSUB(b.x)], 1u);
        const unsigned gen = old / nloc;
        if (old + 1u == (gen + 1u) * nloc) {
            __builtin_amdgcn_fence(__ATOMIC_RELEASE, "agent");
            asm volatile("s_waitcnt vmcnt(0)" ::: "memory");
            const unsigned og = xb_add(&bar[XB_TOP], 1u);
            const unsigned tg = og / nx;
            if (og + 1u == (tg + 1u) * nx) xb_add(&bar[XB_TOPGEN], 1u);
            else XB_SPIN(xb_ld(&bar[XB_TOPGEN]) == tg, bar);
            __builtin_amdgcn_fence(__ATOMIC_ACQUIRE, "agent");
            xb_add(&bar[XB_XGEN(b.x)], 1u);
            asm volatile("s_waitcnt vmcnt(0)" ::: "memory");
        } else {
            XB_SPIN(xb_ld(&bar[XB_XGEN(b.x)]) == gen, bar);
            __builtin_amdgcn_fence(__ATOMIC_ACQUIRE, "agent");
            asm volatile("s_waitcnt vmcnt(0)" ::: "memory");
        }
    }
    __syncthreads();
}

__global__ void __launch_bounds__(512, 2) fwd_kernel(Args a_unused) {
    const ArgsP ap = (ArgsP)__builtin_amdgcn_kernarg_segment_ptr();
    extern __shared__ __attribute__((aligned(16))) unsigned char lds_raw[];
    LAS unsigned char* lds = (LAS unsigned char*)lds_raw;
    cg::grid_group grid = cg::this_grid();
    const int G = gridDim.x, bx = blockIdx.x, tid = tidx();
    const int lo = ap->lo, hi = ap->hi;
    unsigned char* const ws0 = ap->ws;
    XcdBarrier xbar; xbar.bar = (unsigned*)(ws0 + WS_BAR); xbar.x = 0; xbar.st = (volatile LAS unsigned*)(lds + LDS_CTL);
    if (hi - lo > 1) { if (tid < 2) xbar.st[tid] = 0u; __syncthreads(); xbar = xcd_barrier_post((unsigned*)(ws0 + WS_BAR), (volatile LAS unsigned*)(lds + LDS_CTL)); }
    if (lo < 0) grid.sync();
#ifndef PH_MASK
#define PH_MASK 0xffff
#endif
#ifndef DUP_MASK
#define DUP_MASK 0
#endif
#ifndef EXTRA_SYNCS
#define EXTRA_SYNCS 0
#endif
#define REP(k) for (int rep_ = 0; rep_ < 1 + ((DUP_MASK >> (k)) & 1); ++rep_, ((DUP_MASK >> (k)) & 1) ? GSYNC() : (void)0)
#define IN(k) (((PH_MASK >> (k)) & 1) && lo <= (k) && (k) < hi)
#define GSYNC() xcd_barrier(xbar)
#define SEAM(k) do { if (IN(k) && IN((k) + 1)) GSYNC(); } while (0)
#define PHASE_VARS ArgsP a = ap; asm volatile("" : "+s"(a)); unsigned char* ws = a->ws; float* RS0 = (float*)(ws + WS_RS0); float* RS1 = (float*)(ws + WS_RS1); float* RS2 = (float*)(ws + WS_RS2); float* RS3 = (float*)(ws + WS_RS3); \
    bf16_t* XB = (bf16_t*)(ws + WS_XB); bf16_t* ACT = (bf16_t*)(ws + WS_ACT); (void)RS0; (void)RS1; (void)RS2; (void)RS3; (void)XB; (void)ACT;

    REP(0) if (IN(0)) { PHASE_VARS p0_prologue(lds, a); }
    SEAM(0);
    REP(1) if (IN(1)) { PHASE_VARS pg8::Gemm g{XB, (const bf16_t*)(ws + WS_W1GU), 1024, 1024, 1024}; pg8::StaticOrder S; S.init(M, 5632, G, bx);
        EpiGateUp E{ACT, RS0}; pg8::gemm_phase<EpiGateUp, pg8::StaticOrder, true>(lds, g, S, E);
        if (G == 256 && bx >= 128) {
            int gi = bx - 128, base = 0;
            for (int j = 2; j < 9; ++j) { const WJob J = get_job(a, j); const int cnt = (J.K >> 6) * (J.ndst >> 8);
                while (gi < base + cnt) { wconv_item(J, gi - base); gi += 128; } base += cnt; } } }
    SEAM(1);
    if (IN(2)) { PHASE_VARS pg8::Gemm g{ACT, (const bf16_t*)(ws + WS_W1D), FF, FF, FF}; pg8::StaticOrder S; S.init(M, 1024, G, bx);
        EpiResB<true> E{XB, (bf16_t*)a->out, RS1, 0.5f}; pg8::gemm_phase<EpiResB<true>, pg8::StaticOrder, true>(lds, g, S, E); }
    SEAM(2);
    REP(3) if (IN(3)) { PHASE_VARS pg8::Gemm g{(const bf16_t*)a->out, (const bf16_t*)(ws + WS_WIN), 1024, 1024, 1024}; pg8::StaticOrder S; S.init(M, INW, G, bx);
        EpiWin E{RS1, (bf16_t*)(ws + WS_AP), (bf16_t*)(ws + WS_Q), (bf16_t*)(ws + WS_K), (bf16_t*)(ws + WS_VT), (bf16_t*)(ws + WS_GS), (bf16_t*)(ws + WS_GA), (const float*)(ws + WS_ROPE), (float*)(ws + WS_KMEAN)};
        pg8::gemm_phase<EpiWin, pg8::StaticOrder, true>(lds, g, S, E); }
    SEAM(3);
    const bool merged = (G >= 64);
    if (IN(4)) { PHASE_VARS
        if (merged) {
            if (bx < 64) {
                { pg8::Gemm g{(const bf16_t*)(ws + WS_AP), (const bf16_t*)(ws + WS_BTS), 512, AK, 512}; pg8::RangeOrder S{2, 1, bx, 1};
                  EpiS E{(float*)(ws + WS_SOUT)}; pg8::gemm_phase<EpiS, pg8::RangeOrder, true>(lds, g, S, E); }
                asm volatile("s_waitcnt vmcnt(0)" ::: "memory"); __syncthreads();
                ssm_scan_pairs(lds, ws, bx, 64);
                asm volatile("s_waitcnt vmcnt(0)" ::: "memory"); __syncthreads();
                { pg8::Gemm g{(const bf16_t*)(ws + WS_AP), (const bf16_t*)(ws + WS_BTY), AK, AK, AK}; pg8::RangeOrder S{2, 2, 2 * bx, 2};
                  EpiY E{(bf16_t*)(ws + WS_Y)}; pg8::gemm_phase<EpiY, pg8::RangeOrder, true>(lds, g, S, E); }
                asm volatile("s_waitcnt vmcnt(0)" ::: "memory"); __syncthreads();
                if (tid == 0) { __builtin_amdgcn_fence(__ATOMIC_RELEASE, "agent"); asm volatile("s_waitcnt vmcnt(0)" ::: "memory");
                    __hip_atomic_fetch_add((unsigned*)(ws + WS_ATTQ) + 64, 1u, __ATOMIC_RELAXED, __HIP_MEMORY_SCOPE_AGENT); }
                __syncthreads();
            }
            volatile LAS unsigned* qw = (volatile LAS unsigned*)(lds + LDS_CTL + 16);
            for (;;) {
                if (tid == 0) qw[0] = __hip_atomic_fetch_add((unsigned*)(ws + WS_ATTQ), 1u, __ATOMIC_RELAXED, __HIP_MEMORY_SCOPE_AGENT);
                __syncthreads();
                const unsigned u = qw[0];
                __syncthreads();
                if (u >= 640u) break;
                if (u >= 512u) {
                    if (tid == 0) { unsigned sp = 0; while (__hip_atomic_load((unsigned*)(ws + WS_ATTQ) + 64, __ATOMIC_RELAXED, __HIP_MEMORY_SCOPE_AGENT) < 64u) { __builtin_amdgcn_s_sleep(2); if (++sp > (1u << 22)) break; }
                        __builtin_amdgcn_fence(__ATOMIC_ACQUIRE, "agent"); asm volatile("s_waitcnt vmcnt(0)" ::: "memory"); }
                    __syncthreads();
                    pg8::Gemm g{(const bf16_t*)(ws + WS_Y), (const bf16_t*)(ws + WS_WGLU), 512, 512, 512}; pg8::RangeOrder S{64, 2, (int)u - 512, 1};
                    EpiGlu E{(const bf16_t*)(ws + WS_Y), a->in[16], (bf16_t*)(ws + WS_GT)}; pg8::gemm_phase<EpiGlu, pg8::RangeOrder, true>(lds, g, S, E);
                    __syncthreads();
                    continue;
                }
                const int qb = 31 - (int)(u >> 4), bh = (int)(u & 15);
                attn_unit_h(lds, (const bf16_t*)(ws + WS_Q), (const bf16_t*)(ws + WS_K), (const bf16_t*)(ws + WS_VT), (const float*)(ws + WS_KMEAN), (bf16_t*)(ws + WS_ATT), bh >> 3, bh & 7, qb);
            }
        } else {
            { pg8::Gemm g{(const bf16_t*)(ws + WS_AP), (const bf16_t*)(ws + WS_BTS), 512, AK, 512}; pg8::GroupOrder S{2, 1, 64, G, bx};
              EpiS E{(float*)(ws + WS_SOUT)}; pg8::gemm_phase<EpiS, pg8::GroupOrder, true>(lds, g, S, E); }
            __syncthreads();
            for (int pi = bx; pi < 256; pi += G) { const int b = pi >> 7, h = (pi >> 4) & 7, x = pi & 15;
                attn_unit_h(lds, (const bf16_t*)(ws + WS_Q), (const bf16_t*)(ws + WS_K), (const bf16_t*)(ws + WS_VT), (const float*)(ws + WS_KMEAN), (bf16_t*)(ws + WS_ATT), b, h, 31 - x);
                attn_unit_h(lds, (const bf16_t*)(ws + WS_Q), (const bf16_t*)(ws + WS_K), (const bf16_t*)(ws + WS_VT), (const float*)(ws + WS_KMEAN), (bf16_t*)(ws + WS_ATT), b, h, x); }
        }
    }
    SEAM(4);
    if (!merged) {
    if (IN(5)) { PHASE_VARS ssm_scan_pairs(lds, ws, bx, G); }
    SEAM(5);
    if (IN(6)) { PHASE_VARS pg8::Gemm g{(const bf16_t*)(ws + WS_AP), (const bf16_t*)(ws + WS_BTY), AK, AK, AK}; pg8::GroupOrder S{2, 2, 128, G, bx};
        EpiY E{(bf16_t*)(ws + WS_Y)}; pg8::gemm_phase<EpiY, pg8::GroupOrder, true>(lds, g, S, E); }
    }
    if (!merged) SEAM(6);
    if (!merged) if (IN(7)) { PHASE_VARS pg8::Gemm g{(const bf16_t*)(ws + WS_Y), (const bf16_t*)(ws + WS_WGLU), 512, 512, 512}; pg8::StaticOrder S; S.init(M, 512, G, bx);
        EpiGlu E{(const bf16_t*)(ws + WS_Y), a->in[16], (bf16_t*)(ws + WS_GT)}; pg8::gemm_phase<EpiGlu, pg8::StaticOrder, true>(lds, g, S, E); }
    if (!merged) SEAM(7);
    if (IN(8)) { PHASE_VARS
        { pg8::Gemm g{(const bf16_t*)(ws + WS_GT), (const bf16_t*)(ws + WS_WBS), 512, 512, 512}; pg8::StaticOrder S; S.init(M, 1024, G, bx);
          EpiBranch<0> E{(bf16_t*)(ws + WS_GS), (bf16_t*)(ws + WS_GA)}; pg8::gemm_phase<EpiBranch<0>, pg8::StaticOrder, true>(lds, g, S, E); }
        __syncthreads();
        { pg8::Gemm g{(const bf16_t*)(ws + WS_ATT), (const bf16_t*)(ws + WS_WBA), 512, 512, 512}; pg8::StaticOrder S; S.init(M, 1024, G, bx);
          EpiBranch<1> E{(bf16_t*)(ws + WS_GS), (bf16_t*)(ws + WS_GA)}; pg8::gemm_phase<EpiBranch<1>, pg8::StaticOrder, true>(lds, g, S, E); }
    }
    SEAM(8);
    if (IN(9)) { PHASE_VARS pg8::Gemm g{(const bf16_t*)(ws + WS_GA), (const bf16_t*)(ws + WS_WOUT), 1024, 1024, 1024}; pg8::StaticOrder S; S.init(M, 1024, G, bx);
        EpiResB<true> E{(const bf16_t*)a->out, XB, RS2, 1.0f}; pg8::gemm_phase<EpiResB<true>, pg8::StaticOrder, true>(lds, g, S, E); }
    SEAM(9);
    if (IN(10)) { PHASE_VARS pg8::Gemm g{XB, (const bf16_t*)(ws + WS_W2GU), 1024, 1024, 1024}; pg8::StaticOrder S; S.init(M, 5632, G, bx);
        EpiGateUp E{ACT, RS2}; pg8::gemm_phase<EpiGateUp, pg8::StaticOrder, true>(lds, g, S, E); }
    SEAM(10);
    const bool fuse_norm = (G == 256);
    if (IN(11)) { PHASE_VARS pg8::Gemm g{ACT, (const bf16_t*)(ws + WS_W2D), FF, FF, FF}; pg8::StaticOrder S; S.init(M, 1024, G, bx);
        if (fuse_norm) { EpiResNorm E{XB, a->out, RS3, (unsigned*)(ws + WS_PCNT), a->in[24], 0.5f}; pg8::gemm_phase<EpiResNorm, pg8::StaticOrder, true>(lds, g, S, E); }
        else { EpiResF E{XB, a->out, RS3, 0.5f}; pg8::gemm_phase<EpiResF, pg8::StaticOrder, true>(lds, g, S, E); } }
    if (!fuse_norm) {
    SEAM(11);
    for (int es_ = 0; es_ < EXTRA_SYNCS; ++es_) GSYNC();
    if (IN(12)) { PHASE_VARS const float* gain = a->in[24]; const int lane = tid & 63, wave = tid >> 6;
        for (int row = bx * 8 + wave; row < M; row += G * 8) { const float s = inv_rms(RS3[row]); f32x4* xr = (f32x4*)(a->out + (size_t)row * DM);
#pragma unroll
            for (int i = 0; i < 4; ++i) { const f32x4 gv = *(const f32x4*)(gain + (lane + 64 * i) * 4); xr[lane + 64 * i] = xr[lane + 64 * i] * s * gv; } } }
    }
#undef IN
#undef SEAM
}

extern "C" void kernel_launch(void* const* d_in, const int* in_sizes, int n_in, void* d_out, int out_size, void* d_ws, size_t ws_size, hipStream_t stream) {
    static int grid = 0;
    if (grid == 0) {
        if (n_in != 25 || out_size != M * DM || ws_size < WS_END) { fprintf(stderr, "kernel_launch: unexpected problem (n_in %d out %d ws %zu need %zu)\n", n_in, out_size, ws_size, (size_t)WS_END); grid = -1; return; }
        int dev = 0, cus = 0, per_cu = 0;
        hipGetDevice(&dev); hipDeviceGetAttribute(&cus, hipDeviceAttributeMultiprocessorCount, dev);
        if (hipFuncSetAttribute((const void*)fwd_kernel, hipFuncAttributeMaxDynamicSharedMemorySize, LDS_BYTES) != hipSuccess) { fprintf(stderr, "kernel_launch: hipFuncSetAttribute failed\n"); grid = -1; return; }
        if (hipOccupancyMaxActiveBlocksPerMultiprocessor(&per_cu, (const void*)fwd_kernel, 512, LDS_BYTES) != hipSuccess || per_cu < 1) { fprintf(stderr, "kernel_launch: occupancy query says %d\n", per_cu); per_cu = 1; }
        (void)hipGetLastError();
        grid = cus * 1;
        if (grid > 256) grid = 256;
    }
    if (grid < 0) return;
    Args a{};
    for (int i = 0; i < 25; ++i) a.in[i] = (const float*)d_in[i];
    a.out = (float*)d_out; a.ws = (unsigned char*)d_ws;
#if MULTI_LAUNCH
    for (int p = 0; p < NPHASE; ++p) { a.lo = p; a.hi = p + 1; hipLaunchKernelGGL(fwd_kernel, dim3(grid), dim3(512), LDS_BYTES, stream, a); }
#else
    a.lo = 0; a.hi = NPHASE;
    (void)hipMemsetAsync((char*)d_ws + WS_BAR, 0, XCD_BAR_WORDS * 4, stream);
    void* args[] = {&a};
    hipError_t e = hipLaunchCooperativeKernel((const void*)fwd_kernel, dim3(grid), dim3(512), args, LDS_BYTES, stream);
    if (e != hipSuccess) fprintf(stderr, "kernel_launch: cooperative launch failed: %s (grid %d)\n", hipGetErrorString(e), grid);
#endif
}
```

```cpp
#include <hip/hip_runtime.h>
#include <hip/hip_cooperative_groups.h>
#include <cstdio>
#include <cstdint>
namespace cg = cooperative_groups;

#ifndef MULTI_LAUNCH
#define MULTI_LAUNCH 0
#endif

#define LAS __attribute__((address_space(3)))
typedef unsigned short bf16_t;
typedef short bf16x8 __attribute__((ext_vector_type(8)));
typedef float f32x4 __attribute__((ext_vector_type(4)));
typedef float f32x16 __attribute__((ext_vector_type(16)));
typedef unsigned u32x4 __attribute__((ext_vector_type(4)));
typedef unsigned u32x2 __attribute__((ext_vector_type(2)));
typedef float f32x2 __attribute__((ext_vector_type(2)));

constexpr int M = 16384, DM = 1024, FF = 2816, SEQ = 8192, NH = 8, INW = 4096;
constexpr int TCH = 32, AK = 640;
constexpr float EPS = 1e-6f;
constexpr float QSCALE = 0.125f * 1.4426950408889634f;
constexpr float NEGBIG = -1e30f;
constexpr int LDS_CTL = 149504;
constexpr int LDS_BYTES = LDS_CTL + 64;
constexpr int NPHASE = 13;

constexpr size_t WS_RS0 = 0, WS_RS1 = 65536, WS_RS2 = 131072, WS_RS3 = 196608, WS_KMEAN = 262144, WS_AT = 393216;
constexpr size_t WS_PCNT = 425984;
constexpr size_t WS_ATTQ = 442368;
constexpr size_t WS_BAR = 409600;
constexpr size_t WS_ROPE = 524288;
constexpr size_t WS_W1GU = WS_ROPE + 2097152;
constexpr size_t WS_W1D = WS_W1GU + (size_t)5632 * 1024 * 2;
constexpr size_t WS_W2GU = WS_W1D + (size_t)1024 * 2816 * 2;
constexpr size_t WS_W2D = WS_W2GU + (size_t)5632 * 1024 * 2;
constexpr size_t WS_WIN = WS_W2D + (size_t)1024 * 2816 * 2;
constexpr size_t WS_WGLU = WS_WIN + (size_t)4096 * 1024 * 2;
constexpr size_t WS_WBS = WS_WGLU + (size_t)512 * 512 * 2;
constexpr size_t WS_WBA = WS_WBS + (size_t)1024 * 512 * 2;
constexpr size_t WS_WOUT = WS_WBA + (size_t)1024 * 512 * 2;
constexpr size_t WS_BTY = WS_WOUT + (size_t)1024 * 1024 * 2;
constexpr size_t WS_BTS = WS_BTY + (size_t)32 * 512 * AK * 2;
constexpr size_t WS_XB = WS_BTS + (size_t)32 * 256 * 512 * 2;
constexpr size_t WS_MIX = WS_XB + (size_t)M * 1024 * 2;
constexpr size_t WS_AP = WS_MIX;
constexpr size_t WS_SOUT = WS_AP + (size_t)M * AK * 2;
constexpr size_t WS_Q = WS_SOUT + (size_t)M * 128 * 4;
constexpr size_t WS_K = WS_Q + (size_t)M * 512 * 2;
constexpr size_t WS_VT = WS_K + (size_t)M * 512 * 2;
constexpr size_t WS_GS = WS_VT + (size_t)M * 512 * 2;
constexpr size_t WS_GA = WS_GS + (size_t)M * 1024 * 2;
constexpr size_t WS_END = WS_GA + (size_t)M * 1024 * 2;
constexpr size_t WS_ACT = WS_MIX;
constexpr size_t WS_Y = WS_W1GU;
static_assert(WS_W1D == WS_W1GU + (size_t)5632 * 1024 * 2 && WS_W2GU - WS_W1GU >= (size_t)M * 512 * 2, "y_ssm overlay");
constexpr size_t WS_ATT = WS_XB;
constexpr size_t WS_GT = WS_XB + (size_t)M * 512 * 2;
static_assert(WS_ACT + (size_t)M * FF * 2 <= WS_END, "act overlay");
static_assert(WS_END <= (size_t)256 * 1024 * 1024, "workspace");

struct Args {
    const float* in[25];
    float* out;
    unsigned char* ws;
    int lo, hi;
};
typedef const __attribute__((address_space(4))) Args* ArgsP;

__device__ __forceinline__ int tidx() { int t = (int)threadIdx.x; asm volatile("" : "+v"(t)); return t; }
__device__ __forceinline__ unsigned cvt_pk_bf16(float lo, float hi) { unsigned r; asm("v_cvt_pk_bf16_f32 %0, %1, %2" : "=v"(r) : "v"(lo), "v"(hi)); return r; }
__device__ __forceinline__ u32x4 pack8(f32x4 a, f32x4 b) { u32x4 w; w.x = cvt_pk_bf16(a[0], a[1]); w.y = cvt_pk_bf16(a[2], a[3]); w.z = cvt_pk_bf16(b[0], b[1]); w.w = cvt_pk_bf16(b[2], b[3]); return w; }
__device__ __forceinline__ void unpack8(u32x4 w, f32x4& a, f32x4& b) {
    a[0] = __uint_as_float(w.x << 16); a[1] = __uint_as_float(w.x & 0xffff0000u); a[2] = __uint_as_float(w.y << 16); a[3] = __uint_as_float(w.y & 0xffff0000u);
    b[0] = __uint_as_float(w.z << 16); b[1] = __uint_as_float(w.z & 0xffff0000u); b[2] = __uint_as_float(w.w << 16); b[3] = __uint_as_float(w.w & 0xffff0000u);
}
__device__ __forceinline__ float fast_sigmoid(float x) { return __builtin_amdgcn_rcpf(1.f + __expf(-x)); }
__device__ __forceinline__ f32x4 sigmoid4(f32x4 v) { f32x4 r; r[0] = fast_sigmoid(v[0]); r[1] = fast_sigmoid(v[1]); r[2] = fast_sigmoid(v[2]); r[3] = fast_sigmoid(v[3]); return r; }
__device__ __forceinline__ float gelu_tanh(float x) { const float u = 1.5957691216057308f * (x + 0.044715f * x * x * x); return x * fast_sigmoid(u); }
__device__ __forceinline__ float inv_rms(float ss) { return rsqrtf(ss * (1.f / 1024.f) + EPS); }

__device__ __forceinline__ double exp_d(double x) {
    const double kf = rint(x * 1.4426950408889634);
    const double r = fma(-kf, 1.9082149292705877e-10, fma(-kf, 0.6931471803691238, x));
    double t = 1.0, s = 1.0;
#pragma unroll
    for (int i = 1; i <= 14; ++i) { t *= r * (1.0 / i); s += t; }
    const long long bits = (long long)(1023 + (int)kf) << 52;
    return s * __longlong_as_double(bits);
}
__device__ __forceinline__ void sincos_d(double x, double& sn, double& cs) {
    const double kf = rint(x * 0.6366197723675814);
    double r = fma(-kf, 1.5707963267948966, x); r = fma(-kf, 6.123233995736766e-17, r);
    const double r2 = r * r;
    double ts = r, ss = r, tc = 1.0, sc = 1.0;
#pragma unroll
    for (int i = 1; i <= 8; ++i) { ts *= -r2 * (1.0 / ((2 * i) * (2 * i + 1))); ss += ts; tc *= -r2 * (1.0 / ((2 * i - 1) * (2 * i))); sc += tc; }
    const int q = (int)((long long)kf & 3);
    sn = (q == 0) ? ss : (q == 1) ? sc : (q == 2) ? -ss : -sc;
    cs = (q == 0) ? sc : (q == 1) ? -ss : (q == 2) ? -sc : ss;
}

namespace pg8 {
constexpr int BM = 256, BK = 64, HALF = 128, HTB = HALF * BK * 2, STAGE_BYTES = 8 * HTB, NXCD = 8, WGM = 8;
__host__ __device__ __forceinline__ int lds_byte(int r, int c) { const int st = (r >> 4) * 2 + (c >> 5), rr = r & 15, cc = c & 31, ob = rr * 64 + cc * 2; return st * 1024 + (ob ^ (((ob >> 9) & 1) << 5)); }
__host__ __device__ __forceinline__ void stage_rc(int b, int& R, int& C) { const int st = b / 1024, sb = b % 1024, swz = sb ^ (((sb >> 9) & 1) << 5); R = (st >> 1) * 16 + swz / 64; C = (st & 1) * 32 + (swz % 64) / 2; }
__host__ __device__ __forceinline__ int perm32(int rho) { const int n = rho >> 4, i = rho & 15; return 8 * (i >> 2) + 4 * n + (i & 3); }

struct Unit { int pm, pn; };
struct Gemm { const bf16_t* A; const bf16_t* Bt; int K, lda, ldb; };

struct StaticOrder {
    int nM, nN, nwg, G, c;
    __device__ void init(int Mr, int N, int G_, int c_) { nM = Mr / BM; nN = N / BM; nwg = nM * nN; G = G_; c = c_; }
    __device__ bool next(int i, Unit& u) const {
        const long L = (long)i * G + c; if (L >= nwg) return false;
        int wgid = (int)L; { const int q = nwg / NXCD, r = nwg % NXCD, xcd = wgid % NXCD, off = wgid / NXCD; wgid = (xcd < r ? xcd * (q + 1) : r * (q + 1) + (xcd - r) * q) + off; }
        const int nig = WGM * nN, gid = wgid / nig, fm = gid * WGM, gsz = (nM - fm) < WGM ? (nM - fm) : WGM;
        u.pm = fm + ((wgid % nig) % gsz); u.pn = (wgid % nig) / gsz; return true;
    }
};
struct GroupOrder {
    int ntm, ntn, nwg, G, c;
    __device__ bool next(int i, Unit& u) const {
        const long L = (long)i * G + c; if (L >= nwg) return false;
        const int per = ntm * ntn, g = (int)L / per, r = (int)L % per; u.pm = g * ntm + r / ntn; u.pn = g * ntn + r % ntn; return true;
    }
};

struct RangeOrder {
    int ntm, ntn, first, count;
    __device__ bool next(int i, Unit& u) const {
        if (i >= count) return false; const int L = first + i, per = ntm * ntn, g = L / per, r = L % per; u.pm = g * ntm + r / ntn; u.pn = g * ntn + r % ntn; return true;
    }
};
template <class Epi, class Sched, bool ALIGN_EPI>
__device__ __forceinline__ void gemm_phase(LAS unsigned char* lds, const Gemm g, const Sched& S, const Epi& E) {
    const int tid = tidx(), wid = __builtin_amdgcn_readfirstlane(tid >> 6), lane = tid & 63, wr = wid >> 2, wc = wid & 3, fr = lane & 15, fq = lane >> 4;
    const int K = g.K, nt = K / BK;
    unsigned voffA[2], voffB[2];
#pragma unroll
    for (int i = 0; i < 2; ++i) { int R, C; stage_rc(tid * 16 + i * 8192, R, C); const int Rb = (R & ~31) + perm32(R & 31);
        voffA[i] = (unsigned)(R * g.lda + C) * 2u; voffB[i] = (unsigned)(Rb * g.ldb + C) * 2u; }
    const size_t kstep = (size_t)(BK * 2);
    const size_t hstepA = (size_t)HALF * g.lda * 2, hstepB = (size_t)HALF * g.ldb * 2;
    const size_t tstepA = 2 * hstepA, tstepB = 2 * hstepB;
    const unsigned ldsw = (unsigned)wid * 1024u;
    const int aoff = lds_byte(wr * 64 + fr, fq * 8), boff = lds_byte(wc * 32 + fr, fq * 8);
#define PG8_SA(b, h) (((b) * 2 + (h)) * HTB)
#define PG8_SB(b, h) ((4 + (b) * 2 + (h)) * HTB)
#define PG8_STAGE(bufoff, gbase, voff) do { _Pragma("unroll") for (int _i = 0; _i < 2; ++_i) \
        __builtin_amdgcn_global_load_lds((const unsigned*)((const char*)(gbase) + (voff)[_i]), (LAS unsigned*)(lds + (bufoff) + ldsw + _i * 8192), 16, 0, 0); } while (0)
#define PG8_LDA(dst, b, h) do { _Pragma("unroll") for (int m = 0; m < 4; ++m) _Pragma("unroll") for (int k = 0; k < 2; ++k) dst[m][k] = *(const LAS bf16x8*)(lds + PG8_SA(b, h) + aoff + m * 2048 + k * 1024); } while (0)
#define PG8_LDB(dst, b, h) do { _Pragma("unroll") for (int n = 0; n < 2; ++n) _Pragma("unroll") for (int k = 0; k < 2; ++k) dst[n][k] = *(const LAS bf16x8*)(lds + PG8_SB(b, h) + boff + n * 2048 + k * 1024); } while (0)
#define PG8_MMA(ai, bj, At, Bt) do { __builtin_amdgcn_s_setprio(1); _Pragma("unroll") for (int m = 0; m < 4; ++m) _Pragma("unroll") for (int n = 0; n < 2; ++n) _Pragma("unroll") for (int k = 0; k < 2; ++k) \
        acc[ai][bj][m][n] = __builtin_amdgcn_mfma_f32_16x16x32_bf16(Bt[n][k], At[m][k], acc[ai][bj][m][n], 0, 0, 0); __builtin_amdgcn_s_setprio(0); } while (0)
#define PG8_WAIT_V(n) asm volatile("s_waitcnt vmcnt(" #n ")" ::: "memory")
#define PG8_WAIT_L(n) asm volatile("s_waitcnt lgkmcnt(" #n ")" ::: "memory")
#define PG8_BAR __builtin_amdgcn_s_barrier()
#define PG8_SCHED __builtin_amdgcn_sched_barrier(0)
    Unit cur, nxt; int ui = 0;
    if (!S.next(0, cur)) return;
    f32x4 acc[2][2][4][2];
#pragma unroll
    for (int a = 0; a < 2; ++a)
#pragma unroll
        for (int b = 0; b < 2; ++b)
#pragma unroll
            for (int m = 0; m < 4; ++m)
#pragma unroll
                for (int n = 0; n < 2; ++n) acc[a][b][m][n] = (f32x4){0.f, 0.f, 0.f, 0.f};
    bf16x8 At[4][2], B0[2][2], B1[2][2];
    const char* cA = (const char*)g.A + (size_t)cur.pm * tstepA; const char* cB = (const char*)g.Bt + (size_t)cur.pn * tstepB;
    PG8_STAGE(PG8_SB(0, 0), cB, voffB); PG8_STAGE(PG8_SB(0, 1), cB + hstepB, voffB); PG8_STAGE(PG8_SA(0, 0), cA, voffA); PG8_STAGE(PG8_SA(0, 1), cA + hstepA, voffA);
    if (wr == 1) PG8_BAR;
    PG8_WAIT_V(2); PG8_BAR;
    PG8_STAGE(PG8_SB(1, 0), cB + kstep, voffB); PG8_STAGE(PG8_SA(1, 0), cA + kstep, voffA); PG8_STAGE(PG8_SB(1, 1), cB + hstepB + kstep, voffB);
    PG8_WAIT_V(6); PG8_BAR;
    for (;;) {
        const bool has_next = S.next(ui + 1, nxt);
        const char* nA = has_next ? (const char*)g.A + (size_t)nxt.pm * tstepA : cA; const char* nB = has_next ? (const char*)g.Bt + (size_t)nxt.pn * tstepB : cB;
        for (int t = 0; t < nt; t += 2) {
            const bool last = (t == nt - 2);
            const char* a1 = cA + (size_t)(t + 1) * kstep;
            const char* a2 = last ? nA : cA + (size_t)(t + 2) * kstep; const char* b2 = last ? nB : cB + (size_t)(t + 2) * kstep;
            const char* a3 = a2 + kstep; const char* b3 = b2 + kstep;
            PG8_LDB(B0, 0, 0); PG8_LDB(B1, 0, 1); PG8_SCHED; PG8_LDA(At, 0, 0); PG8_STAGE(PG8_SA(1, 1), a1 + hstepA, voffA);
            PG8_WAIT_V(8); PG8_WAIT_L(0); PG8_BAR; PG8_MMA(0, 0, At, B0); PG8_MMA(0, 1, At, B1); PG8_BAR; PG8_SCHED;
            PG8_LDA(At, 0, 1); PG8_STAGE(PG8_SB(0, 0), b2, voffB); PG8_STAGE(PG8_SB(0, 1), b2 + hstepB, voffB); PG8_STAGE(PG8_SA(0, 0), a2, voffA);
            PG8_WAIT_V(8); PG8_WAIT_L(0); PG8_BAR; PG8_MMA(1, 0, At, B0); PG8_MMA(1, 1, At, B1); PG8_BAR; PG8_SCHED;
            PG8_LDB(B0, 1, 0); PG8_LDB(B1, 1, 1); PG8_SCHED; PG8_LDA(At, 1, 0); PG8_STAGE(PG8_SA(0, 1), a2 + hstepA, voffA);
            PG8_WAIT_V(8); PG8_WAIT_L(0); PG8_BAR; PG8_MMA(0, 0, At, B0); PG8_MMA(0, 1, At, B1); PG8_BAR; PG8_SCHED;
            PG8_LDA(At, 1, 1); PG8_STAGE(PG8_SB(1, 0), b3, voffB); PG8_STAGE(PG8_SB(1, 1), b3 + hstepB, voffB); PG8_STAGE(PG8_SA(1, 0), a3, voffA);
            PG8_WAIT_V(8); PG8_WAIT_L(0); PG8_BAR; PG8_MMA(1, 0, At, B0); PG8_MMA(1, 1, At, B1); PG8_BAR; PG8_SCHED;
        }
        if constexpr (ALIGN_EPI) { if (wr == 0) PG8_BAR; }
        { int fr_ = fr, fq_ = fq; asm volatile("" : "+v"(fr_), "+v"(fq_)); if constexpr (!Epi::AFTER_DRAIN) E(acc, cur, wr, wc, fr_, fq_); }
        if (!has_next) break;
#pragma unroll
        for (int a = 0; a < 2; ++a)
#pragma unroll
            for (int b = 0; b < 2; ++b)
#pragma unroll
                for (int m = 0; m < 4; ++m)
#pragma unroll
                    for (int n = 0; n < 2; ++n) acc[a][b][m][n] = (f32x4){0.f, 0.f, 0.f, 0.f};
        cur = nxt; cA = nA; cB = nB; ++ui;
        if constexpr (ALIGN_EPI) { if (wr == 1) PG8_BAR; }
    }
    PG8_WAIT_V(0);
    if constexpr (!ALIGN_EPI) { if (wr == 0) PG8_BAR; }
    PG8_BAR;
    if constexpr (Epi::AFTER_DRAIN) { int fr_ = fr, fq_ = fq; asm volatile("" : "+v"(fr_), "+v"(fq_)); E.fused(acc, cur, wr, wc, fr_, fq_); }
#undef PG8_SA
#undef PG8_SB
#undef PG8_STAGE
#undef PG8_LDA
#undef PG8_LDB
#undef PG8_MMA
#undef PG8_WAIT_V
#undef PG8_WAIT_L
#undef PG8_BAR
#undef PG8_SCHED
}
}
using pg8::Unit;
typedef f32x4 Acc[2][2][4][2];

#define EPI_ROWS for (int ai = 0; ai < 2; ++ai) _Pragma("unroll") for (int m = 0; m < 4; ++m)

struct EpiGateUp {
    static constexpr bool AFTER_DRAIN = false;
    bf16_t* O; const float* ss;
    __device__ __forceinline__ void operator()(const Acc& acc, const Unit& u, int wr, int wc, int fr, int fq) const {
#pragma unroll
        EPI_ROWS {
            const int row = u.pm * 256 + ai * 128 + wr * 64 + m * 16 + fr;
            const float s = inv_rms(ss[row]);
            f32x4 o[2];
#pragma unroll
            for (int n = 0; n < 2; ++n) { const f32x4 g = acc[ai][0][m][n] * s, up = acc[ai][1][m][n] * s;
#pragma unroll
                for (int j = 0; j < 4; ++j) o[n][j] = g[j] * fast_sigmoid(g[j]) * up[j]; }
            *(u32x4*)(O + (size_t)row * FF + u.pn * 128 + wc * 32 + 8 * fq) = pack8(o[0], o[1]);
        }
    }
};

template <bool WB> struct EpiRes {
    static constexpr bool AFTER_DRAIN = false;
    const float* Xin; float* Xout; bf16_t* Xb; float* rowss; float coef;
    __device__ __forceinline__ void operator()(const Acc& acc, const Unit& u, int wr, int wc, int fr, int fq) const {
#pragma unroll
        EPI_ROWS {
            const int row = u.pm * 256 + ai * 128 + wr * 64 + m * 16 + fr;
            const size_t off = (size_t)row * DM + u.pn * 256 + wc * 32 + 8 * fq;
            float ss = 0.f;
#pragma unroll
            for (int bj = 0; bj < 2; ++bj) {
                const f32x4 x0 = *(const f32x4*)(Xin + off + bj * 128), x1 = *(const f32x4*)(Xin + off + bj * 128 + 4);
                const f32x4 o0 = x0 + acc[ai][bj][m][0] * coef, o1 = x1 + acc[ai][bj][m][1] * coef;
                *(f32x4*)(Xout + off + bj * 128) = o0; *(f32x4*)(Xout + off + bj * 128 + 4) = o1;
                ss += o0[0] * o0[0] + o0[1] * o0[1] + o0[2] * o0[2] + o0[3] * o0[3] + o1[0] * o1[0] + o1[1] * o1[1] + o1[2] * o1[2] + o1[3] * o1[3];
                if (WB) *(u32x4*)(Xb + off + bj * 128) = pack8(o0, o1);
            }
            ss += __shfl_xor(ss, 16); ss += __shfl_xor(ss, 32);
            if (fq == 0) atomicAdd(rowss + row, ss);
        }
    }
};

struct EpiWin {
    static constexpr bool AFTER_DRAIN = false;
    const float* ss; bf16_t* AP; bf16_t* Q; bf16_t* Kb; bf16_t* VT; bf16_t* GS; bf16_t* GA; const float* rope; float* kmean;
    __device__ __forceinline__ void operator()(const Acc& acc, const Unit& u, int wr, int wc, int fr, int fq) const {
        const int pn = u.pn;
        if (pn < 2) {
            int pm_ = u.pm; asm volatile("" : "+s"(pm_));
#pragma unroll
            EPI_ROWS {
                const int row = pm_ * 256 + ai * 128 + wr * 64 + m * 16 + fr; const float s = inv_rms(ss[row]);
                const int b = row >> 13, tok = row & 8191, c = tok >> 5, sidx = tok & 31;
#pragma unroll
                for (int bj = 0; bj < 2; ++bj) { const int col = pn * 256 + bj * 128 + wc * 32 + 8 * fq; const int g = col >> 4, hh = col & 15;
                    *(u32x4*)(AP + (size_t)(g * 512 + b * 256 + c) * AK + sidx * 16 + hh) = pack8(acc[ai][bj][m][0] * s, acc[ai][bj][m][1] * s); }
            }
        } else if (pn < 6) {
            int pm_ = u.pm; asm volatile("" : "+s"(pm_));
            const bool isq = pn < 4;
            bf16_t* dst = isq ? Q : Kb; const float osc = isq ? QSCALE : 1.f;
            float ks[2][8];
#pragma unroll
            for (int bj = 0; bj < 2; ++bj)
#pragma unroll
                for (int e = 0; e < 8; ++e) ks[bj][e] = 0.f;
#pragma unroll
            EPI_ROWS {
                const int row = pm_ * 256 + ai * 128 + wr * 64 + m * 16 + fr; const float s = inv_rms(ss[row]) * osc;
                const int tok = row & 8191; const int i0 = (wc & 1) * 16 + 4 * fq;
                const f32x4 cs = *(const f32x4*)(rope + (size_t)tok * 32 + i0), sn = *(const f32x4*)(rope + (size_t)SEQ * 32 + (size_t)tok * 32 + i0);
#pragma unroll
                for (int bj = 0; bj < 2; ++bj) { const int head = (pn & 1) * 4 + 2 * bj + (wc >> 1);
                    const f32x4 x1 = acc[ai][bj][m][0] * s, x2 = acc[ai][bj][m][1] * s;
                    const f32x4 o1 = x1 * cs - x2 * sn, o2 = x2 * cs + x1 * sn;
                    u32x2 w1, w2; w1.x = cvt_pk_bf16(o1[0], o1[1]); w1.y = cvt_pk_bf16(o1[2], o1[3]); w2.x = cvt_pk_bf16(o2[0], o2[1]); w2.y = cvt_pk_bf16(o2[2], o2[3]);
                    bf16_t* p = isq ? dst + (size_t)row * 512 + head * 64 + i0 : dst + ((size_t)(((row >> 13) * 8 + head)) * SEQ + tok) * 64 + i0;
                    *(u32x2*)p = w1; *(u32x2*)(p + 32) = w2;
#pragma unroll
                    for (int e = 0; e < 4; ++e) { ks[bj][e] += o1[e]; ks[bj][4 + e] += o2[e]; asm volatile("" : "+v"(ks[bj][e]), "+v"(ks[bj][4 + e])); } }
                asm volatile("" ::: "memory");
            }
            if (!isq) {
                const int b = (pm_ * 256) >> 13, blk = pm_ & 31; const int i0 = (wc & 1) * 16 + 4 * fq;
#pragma unroll
                for (int bj = 0; bj < 2; ++bj) { const int head = (pn & 1) * 4 + 2 * bj + (wc >> 1);
#pragma unroll
                    for (int e = 0; e < 8; ++e) { float v = ks[bj][e]; v += __shfl_xor(v, 1); v += __shfl_xor(v, 2); v += __shfl_xor(v, 4); v += __shfl_xor(v, 8);
                        if (fr == 0) atomicAdd(kmean + (size_t)((b * 8 + head) * 32 + blk) * 64 + i0 + (e & 3) + 32 * (e >> 2), v); } }
            }
        } else if (pn < 8) {
            int pm_ = u.pm; asm volatile("" : "+s"(pm_));
#pragma unroll
            EPI_ROWS {
                const int row = pm_ * 256 + ai * 128 + wr * 64 + m * 16 + fr; const float s = inv_rms(ss[row]);
                const int b = row >> 13, tok = row & 8191;
#pragma unroll
                for (int bj = 0; bj < 2; ++bj) { const int col = (pn - 6) * 256 + bj * 128 + wc * 32 + 8 * fq; const int head = col >> 6, d0 = col & 63;
                    bf16_t* p = VT + ((size_t)(((b * 8 + head) * 32 + (tok >> 8)) * 64 + d0)) * 256 + (tok & 255);
                    const f32x4 v0 = acc[ai][bj][m][0] * s, v1 = acc[ai][bj][m][1] * s;
#pragma unroll
                    for (int e = 0; e < 4; ++e) { p[e * 256] = (bf16_t)(cvt_pk_bf16(v0[e], 0.f) & 0xffffu); p[(4 + e) * 256] = (bf16_t)(cvt_pk_bf16(v1[e], 0.f) & 0xffffu); } }
                asm volatile("" ::: "memory");
            }
        } else {
            int pm_ = u.pm; asm volatile("" : "+s"(pm_));
            bf16_t* dst = pn < 12 ? GS : GA; const int cb = ((pn - 8) & 3) * 256;
#pragma unroll
            EPI_ROWS {
                const int row = pm_ * 256 + ai * 128 + wr * 64 + m * 16 + fr; const float s = inv_rms(ss[row]);
#pragma unroll
                for (int bj = 0; bj < 2; ++bj) { const int col = cb + bj * 128 + wc * 32 + 8 * fq;
                    *(u32x4*)(dst + (size_t)row * DM + col) = pack8(sigmoid4(acc[ai][bj][m][0] * s), sigmoid4(acc[ai][bj][m][1] * s)); }
            }
        }
    }
};


template <bool IN_BF16> struct EpiResB {
    static constexpr bool AFTER_DRAIN = false;
    const void* Xin; bf16_t* Xb; float* rowss; float coef;
    __device__ __forceinline__ void operator()(const Acc& acc, const Unit& u, int wr, int wc, int fr, int fq) const {
#pragma unroll
        EPI_ROWS {
            const int row = u.pm * 256 + ai * 128 + wr * 64 + m * 16 + fr;
            const size_t off = (size_t)row * DM + u.pn * 256 + wc * 32 + 8 * fq;
            float ss = 0.f;
#pragma unroll
            for (int bj = 0; bj < 2; ++bj) {
                f32x4 x0, x1;
                if (IN_BF16) unpack8(*(const u32x4*)((const bf16_t*)Xin + off + bj * 128), x0, x1);
                else { x0 = *(const f32x4*)((const float*)Xin + off + bj * 128); x1 = *(const f32x4*)((const float*)Xin + off + bj * 128 + 4); }
                const f32x4 o0 = x0 + acc[ai][bj][m][0] * coef, o1 = x1 + acc[ai][bj][m][1] * coef;
                ss += o0[0] * o0[0] + o0[1] * o0[1] + o0[2] * o0[2] + o0[3] * o0[3] + o1[0] * o1[0] + o1[1] * o1[1] + o1[2] * o1[2] + o1[3] * o1[3];
                *(u32x4*)(Xb + off + bj * 128) = pack8(o0, o1);
            }
            ss += __shfl_xor(ss, 16); ss += __shfl_xor(ss, 32);
            if (fq == 0) atomicAdd(rowss + row, ss);
        }
    }
};

struct EpiResF {
    static constexpr bool AFTER_DRAIN = false;
    const bf16_t* Xin; float* Xout; float* rowss; float coef;
    __device__ __forceinline__ void operator()(const Acc& acc, const Unit& u, int wr, int wc, int fr, int fq) const {
#pragma unroll
        EPI_ROWS {
            const int row = u.pm * 256 + ai * 128 + wr * 64 + m * 16 + fr;
            const size_t off = (size_t)row * DM + u.pn * 256 + wc * 32 + 8 * fq;
            float ss = 0.f;
#pragma unroll
            for (int bj = 0; bj < 2; ++bj) {
                f32x4 x0, x1; unpack8(*(const u32x4*)(Xin + off + bj * 128), x0, x1);
                const f32x4 o0 = x0 + acc[ai][bj][m][0] * coef, o1 = x1 + acc[ai][bj][m][1] * coef;
                *(f32x4*)(Xout + off + bj * 128) = o0; *(f32x4*)(Xout + off + bj * 128 + 4) = o1;
                ss += o0[0] * o0[0] + o0[1] * o0[1] + o0[2] * o0[2] + o0[3] * o0[3] + o1[0] * o1[0] + o1[1] * o1[1] + o1[2] * o1[2] + o1[3] * o1[3];
            }
            ss += __shfl_xor(ss, 16); ss += __shfl_xor(ss, 32);
            if (fq == 0) atomicAdd(rowss + row, ss);
        }
    }
};

struct EpiResNorm {
    static constexpr bool AFTER_DRAIN = true;
    const bf16_t* Xin; float* Xout; float* rowss; unsigned* pcnt; const float* gain; float coef;
    __device__ __forceinline__ void operator()(Acc&, const Unit&, int, int, int, int) const {}
    __device__ __forceinline__ void fused(Acc& acc, const Unit& u, int wr, int wc, int fr, int fq) const {
#pragma unroll
        EPI_ROWS {
            const int row = u.pm * 256 + ai * 128 + wr * 64 + m * 16 + fr;
            const size_t off = (size_t)row * DM + u.pn * 256 + wc * 32 + 8 * fq;
            float ss = 0.f;
#pragma unroll
            for (int bj = 0; bj < 2; ++bj) {
                f32x4 x0, x1; unpack8(*(const u32x4*)(Xin + off + bj * 128), x0, x1);
                const f32x4 o0 = x0 + acc[ai][bj][m][0] * coef, o1 = x1 + acc[ai][bj][m][1] * coef;
                acc[ai][bj][m][0] = o0; acc[ai][bj][m][1] = o1;
                ss += o0[0] * o0[0] + o0[1] * o0[1] + o0[2] * o0[2] + o0[3] * o0[3] + o1[0] * o1[0] + o1[1] * o1[1] + o1[2] * o1[2] + o1[3] * o1[3];
            }
            ss += __shfl_xor(ss, 16); ss += __shfl_xor(ss, 32);
            if (fq == 0) atomicAdd(rowss + row, ss);
        }
        asm volatile("s_waitcnt vmcnt(0)" ::: "memory");
        __syncthreads();
        if (tidx() == 0) {
            __builtin_amdgcn_fence(__ATOMIC_RELEASE, "agent");
            asm volatile("s_waitcnt vmcnt(0)" ::: "memory");
            __hip_atomic_fetch_add(pcnt + u.pm * 64, 1u, __ATOMIC_RELAXED, __HIP_MEMORY_SCOPE_AGENT);
            unsigned sp = 0;
            while (__hip_atomic_load(pcnt + u.pm * 64, __ATOMIC_RELAXED, __HIP_MEMORY_SCOPE_AGENT) < 4u) { __builtin_amdgcn_s_sleep(1); if (++sp > (1u << 22)) break; }
            __builtin_amdgcn_fence(__ATOMIC_ACQUIRE, "agent");
            asm volatile("s_waitcnt vmcnt(0)" ::: "memory");
        }
        __syncthreads();
#pragma unroll
        EPI_ROWS {
            const int row = u.pm * 256 + ai * 128 + wr * 64 + m * 16 + fr;
            const size_t off = (size_t)row * DM + u.pn * 256 + wc * 32 + 8 * fq;
            const float s = inv_rms(__hip_atomic_load(rowss + row, __ATOMIC_RELAXED, __HIP_MEMORY_SCOPE_AGENT));
#pragma unroll
            for (int bj = 0; bj < 2; ++bj) { const int col = u.pn * 256 + bj * 128 + wc * 32 + 8 * fq;
                const f32x4 g0 = *(const f32x4*)(gain + col), g1 = *(const f32x4*)(gain + col + 4);
                *(f32x4*)(Xout + off + bj * 128) = acc[ai][bj][m][0] * s * g0; *(f32x4*)(Xout + off + bj * 128 + 4) = acc[ai][bj][m][1] * s * g1; }
        }
    }
};

struct EpiS {
    static constexpr bool AFTER_DRAIN = false;
    float* S;
    __device__ __forceinline__ void operator()(const Acc& acc, const Unit& u, int wr, int wc, int fr, int fq) const {
#pragma unroll
        EPI_ROWS {
            const int row = u.pm * 256 + ai * 128 + wr * 64 + m * 16 + fr;
            float* p = S + (size_t)row * 128 + wc * 32 + 8 * fq; *(f32x4*)p = acc[ai][0][m][0]; *(f32x4*)(p + 4) = acc[ai][0][m][1];
        }
    }
};
struct EpiY {
    static constexpr bool AFTER_DRAIN = false;
    bf16_t* Y;
    __device__ __forceinline__ void operator()(const Acc& acc, const Unit& u, int wr, int wc, int fr, int fq) const {
#pragma unroll
        EPI_ROWS {
            const int row = u.pm * 256 + ai * 128 + wr * 64 + m * 16 + fr; const int g = row >> 9, b = (row >> 8) & 1, c = row & 255;
#pragma unroll
            for (int bj = 0; bj < 2; ++bj) { const int n = (u.pn & 1) * 256 + bj * 128 + wc * 32 + 8 * fq; const int t = n >> 4, hh = n & 15;
                f32x4 o0, o1;
#pragma unroll
                for (int e = 0; e < 4; ++e) { o0[e] = gelu_tanh(acc[ai][bj][m][0][e]); o1[e] = gelu_tanh(acc[ai][bj][m][1][e]); }
                *(u32x4*)(Y + (size_t)(b * SEQ + c * TCH + t) * 512 + g * 16 + hh) = pack8(o0, o1); }
        }
    }
};
struct EpiGlu {
    static constexpr bool AFTER_DRAIN = false;
    const bf16_t* Y; const float* bias; bf16_t* O;
    __device__ __forceinline__ void operator()(const Acc& acc, const Unit& u, int wr, int wc, int fr, int fq) const {
#pragma unroll
        EPI_ROWS {
            const int row = u.pm * 256 + ai * 128 + wr * 64 + m * 16 + fr;
#pragma unroll
            for (int bj = 0; bj < 2; ++bj) { const int col = u.pn * 256 + bj * 128 + wc * 32 + 8 * fq;
                const f32x4 b0 = *(const f32x4*)(bias + col), b1 = *(const f32x4*)(bias + col + 4);
                f32x4 y0, y1; unpack8(*(const u32x4*)(Y + (size_t)row * 512 + col), y0, y1);
                *(u32x4*)(O + (size_t)row * 512 + col) = pack8(y0 * sigmoid4(acc[ai][bj][m][0] + b0), y1 * sigmoid4(acc[ai][bj][m][1] + b1)); }
        }
    }
};
template <int MODE> struct EpiBranch {
    static constexpr bool AFTER_DRAIN = false;
    bf16_t* G1; bf16_t* G2;
    __device__ __forceinline__ void operator()(const Acc& acc, const Unit& u, int wr, int wc, int fr, int fq) const {
#pragma unroll
        EPI_ROWS {
            const int row = u.pm * 256 + ai * 128 + wr * 64 + m * 16 + fr;
#pragma unroll
            for (int bj = 0; bj < 2; ++bj) { const size_t off = (size_t)row * DM + u.pn * 256 + bj * 128 + wc * 32 + 8 * fq;
                f32x4 a0, a1; unpack8(*(const u32x4*)(G1 + off), a0, a1);
                if (MODE == 0) { *(u32x4*)(G1 + off) = pack8(a0 * acc[ai][bj][m][0], a1 * acc[ai][bj][m][1]); }
                else { f32x4 g0, g1; unpack8(*(const u32x4*)(G2 + off), g0, g1); *(u32x4*)(G2 + off) = pack8(a0 + g0 * acc[ai][bj][m][0], a1 + g1 * acc[ai][bj][m][1]); } }
        }
    }
};

struct WJob { const float* s0; const float* s1; const float* gain; bf16_t* dst; int K, ld, ndst, mode; };
__device__ __forceinline__ WJob get_job(ArgsP a, int j) {
    unsigned char* ws = a->ws; WJob J;
    switch (j) {
    case 0: J = WJob{a->in[2], a->in[3], a->in[1], (bf16_t*)(ws + WS_W1GU), 1024, 2816, 5632, 1}; break;
    case 1: J = WJob{a->in[4], a->in[4], nullptr, (bf16_t*)(ws + WS_W1D), 2816, 1024, 1024, 0}; break;
    case 2: J = WJob{a->in[6], a->in[6], a->in[5], (bf16_t*)(ws + WS_WIN), 1024, 4096, 4096, 2}; break;
    case 3: J = WJob{a->in[15], a->in[15], nullptr, (bf16_t*)(ws + WS_WGLU), 512, 512, 512, 0}; break;
    case 4: J = WJob{a->in[17], a->in[17], nullptr, (bf16_t*)(ws + WS_WBS), 512, 1024, 1024, 0}; break;
    case 5: J = WJob{a->in[18], a->in[18], nullptr, (bf16_t*)(ws + WS_WBA), 512, 1024, 1024, 0}; break;
    case 6: J = WJob{a->in[19], a->in[19], nullptr, (bf16_t*)(ws + WS_WOUT), 1024, 1024, 1024, 0}; break;
    case 7: J = WJob{a->in[21], a->in[22], a->in[20], (bf16_t*)(ws + WS_W2GU), 1024, 2816, 5632, 1}; break;
    default: J = WJob{a->in[23], a->in[23], nullptr, (bf16_t*)(ws + WS_W2D), 2816, 1024, 1024, 0}; break;
    }
    return J;
}
__device__ __forceinline__ void wconv_item(const WJob& J, int item) {
    const int nkb = J.K >> 6, kb = item % nkb, nb = item / nkb;
    const int tid = tidx(), lane = tid & 63, wave = tid >> 6;
    const int n = nb * 256 + lane * 4, k0 = kb * 64 + wave * 8;
    const float* src = J.s0; int sc = n;
    if (J.mode == 1) { const int tl = n >> 8, wi = n & 255; if (wi >= 128) src = J.s1; sc = tl * 128 + (wi & 127); }
    else if (J.mode == 2) { if (n >= 512 && n < 1536) { const int t_ = n & 255, bj = t_ >> 7, wc = (t_ >> 5) & 3, fq = (t_ >> 3) & 3, n2 = (t_ >> 2) & 1;
            sc = (n & ~255) + 64 * (2 * bj + (wc >> 1)) + (wc & 1) * 16 + 4 * fq + 32 * n2; } }
    f32x4 v[8];
#pragma unroll
    for (int e = 0; e < 8; ++e) v[e] = *(const f32x4*)(src + (size_t)(k0 + e) * J.ld + sc);
    if (J.gain) {
#pragma unroll
        for (int e = 0; e < 8; ++e) v[e] = v[e] * J.gain[k0 + e]; }
#pragma unroll
    for (int j = 0; j < 4; ++j) { u32x4 w; w.x = cvt_pk_bf16(v[0][j], v[1][j]); w.y = cvt_pk_bf16(v[2][j], v[3][j]); w.z = cvt_pk_bf16(v[4][j], v[5][j]); w.w = cvt_pk_bf16(v[6][j], v[7][j]);
        *(u32x4*)(J.dst + (size_t)(n + j) * J.K + k0) = w; }
}

__device__ __forceinline__ void ssm_precompute(LAS unsigned char* lds, ArgsP a, int g, int hsel) {
    LAS float* pwr = (LAS float*)lds; LAS float* pwi = pwr + 33 * 64; LAS float* Bbr = pwi + 33 * 64; LAS float* Bbi = Bbr + 1024;
    LAS float* Cr = Bbi + 1024; LAS float* Ci = Cr + 1024; LAS float* Kt = Ci + 1024;
    const float* a_re = a->in[7]; const float* a_im = a->in[8]; const float* b_re = a->in[9]; const float* b_im = a->in[10];
    const float* c_re = a->in[11]; const float* c_im = a->in[12]; const float* dsk = a->in[13]; const float* log_dt = a->in[14];
    bf16_t* BTY = (bf16_t*)(a->ws + WS_BTY); bf16_t* BTS = (bf16_t*)(a->ws + WS_BTS); float* aT = (float*)(a->ws + WS_AT);
    const int tid = tidx();
    const double dt = exp_d((double)log_dt[g]);
    for (int it = tid; it < 33 * 64; it += 512) { const int tau = it >> 6, p = it & 63; const double ar = a_re[g * 64 + p], ai = a_im[g * 64 + p];
        const double mag = exp_d(tau * ar * dt); double sn, cs; sincos_d(tau * ai * dt, sn, cs); pwr[it] = (float)(mag * cs); pwi[it] = (float)(mag * sn);
        if (tau == 32 && hsel == 0) { aT[(g * 64 + p) * 2] = (float)(mag * cs); aT[(g * 64 + p) * 2 + 1] = (float)(mag * sn); } }
    for (int it = tid; it < 1024; it += 512) { const int p = it >> 4, hh = it & 15; const double ar = a_re[g * 64 + p], ai = a_im[g * 64 + p];
        const double mag = exp_d(ar * dt); double sn, cs; sincos_d(ai * dt, sn, cs); const double nr = mag * cs - 1.0, ni = mag * sn, den = ar * ar + ai * ai;
        const double fr = (nr * ar + ni * ai) / den, fi = (ni * ar - nr * ai) / den; const double br = b_re[(g * 64 + p) * 16 + hh], bi = b_im[(g * 64 + p) * 16 + hh];
        Bbr[it] = (float)(fr * br - fi * bi); Bbi[it] = (float)(fr * bi + fi * br); }
    for (int it = tid; it < 1024; it += 512) { const int h_ = it >> 6, p_ = it & 63; Cr[p_ * 16 + h_] = c_re[g * 1024 + it]; Ci[p_ * 16 + h_] = c_im[g * 1024 + it]; }
    __syncthreads();
    { const int h = tid & 15, tau = tid >> 4;
      float kacc[16];
#pragma unroll
      for (int e = 0; e < 16; ++e) kacc[e] = 0.f;
      for (int p = 0; p < 64; ++p) { const float cr = Cr[p * 16 + h], ci = Ci[p * 16 + h], pr = pwr[tau * 64 + p], pi = pwi[tau * 64 + p];
          const float wre = cr * pr - ci * pi, wim = cr * pi + ci * pr;
#pragma unroll
          for (int q4 = 0; q4 < 4; ++q4) { const f32x4 br = *(const LAS f32x4*)(Bbr + p * 16 + 4 * q4), bi = *(const LAS f32x4*)(Bbi + p * 16 + 4 * q4);
#pragma unroll
              for (int e = 0; e < 4; ++e) kacc[4 * q4 + e] += wre * br[e] - wim * bi[e]; } }
#pragma unroll
      for (int hp = 0; hp < 16; ++hp) { float v = kacc[hp]; if (tau == 0 && h == hp) v += dsk[g * 16 + h]; Kt[(tau * 16 + h) * 16 + hp] = v; } }
    __syncthreads();
    for (int it = tid; it < 256 * 80; it += 512) { const int nl = it / 80, o = it - nl * 80, n = hsel * 256 + nl, t = n >> 4, h = n & 15, k0 = o * 8; f32x4 v0, v1;
        if (k0 < 512) { const int s = k0 >> 4, hp0 = k0 & 15;
#pragma unroll
            for (int e = 0; e < 4; ++e) { v0[e] = (s <= t) ? Kt[((t - s) * 16 + h) * 16 + hp0 + e] : 0.f; v1[e] = (s <= t) ? Kt[((t - s) * 16 + h) * 16 + hp0 + 4 + e] : 0.f; } }
        else { const bool im = k0 >= 576; const int p0 = k0 - (im ? 576 : 512);
#pragma unroll
            for (int e = 0; e < 8; ++e) { const int p = p0 + e; const float cr = Cr[p * 16 + h], ci = Ci[p * 16 + h], pr = pwr[(t + 1) * 64 + p], pi = pwi[(t + 1) * 64 + p];
                const float v = im ? -(cr * pi + ci * pr) : (cr * pr - ci * pi); if (e < 4) v0[e] = v; else v1[e - 4] = v; } }
        *(u32x4*)(BTY + ((size_t)(g * 512 + n)) * AK + k0) = pack8(v0, v1); }
    for (int it = tid; it < 128 * 64; it += 512) { const int n = hsel * 128 + (it >> 6), o = it & 63, k0 = o * 8, s = k0 >> 4, hp0 = k0 & 15; f32x4 v0 = {0.f, 0.f, 0.f, 0.f}, v1 = v0;
        if (n < 128) { const int p = n & 63, tau = 31 - s; const float pr = pwr[tau * 64 + p], pi = pwi[tau * 64 + p];
#pragma unroll
            for (int e = 0; e < 8; ++e) { const float br = Bbr[p * 16 + hp0 + e], bi = Bbi[p * 16 + hp0 + e]; const float v = (n < 64) ? (pr * br - pi * bi) : (pr * bi + pi * br);
                if (e < 4) v0[e] = v; else v1[e - 4] = v; } }
        *(u32x4*)(BTS + ((size_t)(g * 256 + n)) * 512 + k0) = pack8(v0, v1); }
    __syncthreads();
}

__device__ __forceinline__ void p0_prologue(LAS unsigned char* lds, ArgsP a) {
    const int tid = tidx(), lane = tid & 63, wave = tid >> 6, G = gridDim.x, bx = blockIdx.x;
    unsigned char* ws = a->ws;
    const bool split = G >= 128;
    if (!split || bx < 64) for (int u = bx; u < 64; u += G) ssm_precompute(lds, a, u >> 1, u & 1);
    if (split && bx < 64) return;
    const int nw = split ? G - 64 : G, wk = split ? bx - 64 : bx;
    { float* z1 = (float*)(ws + WS_RS1); for (int i = wk * 512 + tid; i < 3 * 16384; i += nw * 512) z1[i] = 0.f;
      float* z2 = (float*)(ws + WS_KMEAN); for (int i = wk * 512 + tid; i < 32768; i += nw * 512) z2[i] = 0.f;
      unsigned* z3 = (unsigned*)(ws + WS_PCNT); for (int i = wk * 512 + tid; i < 64 * 64 + 128; i += nw * 512) z3[i] = 0u; }
    { int gi = wk, base = 0; const int jend = (G == 256) ? 2 : 9;
      for (int j = 0; j < jend; ++j) { const WJob J = get_job(a, j); const int cnt = (J.K >> 6) * (J.ndst >> 8);
          while (gi < base + cnt) { wconv_item(J, gi - base); gi += nw; } base += cnt; } }
    { const float* x = a->in[0]; bf16_t* xb = (bf16_t*)(ws + WS_XB); float* rs0 = (float*)(ws + WS_RS0);
      for (int row = (wk * 8 + wave) * 2; row < M; row += nw * 16) { const f32x4* xr = (const f32x4*)(x + (size_t)row * DM); float ss0 = 0.f, ss1 = 0.f; f32x4 v[8];
#pragma unroll
          for (int i = 0; i < 8; ++i) v[i] = xr[lane + 64 * i];
#pragma unroll
          for (int i = 0; i < 8; ++i) { const float q = v[i][0] * v[i][0] + v[i][1] * v[i][1] + v[i][2] * v[i][2] + v[i][3] * v[i][3]; if (i < 4) ss0 += q; else ss1 += q;
              u32x2 w; w.x = cvt_pk_bf16(v[i][0], v[i][1]); w.y = cvt_pk_bf16(v[i][2], v[i][3]); *(u32x2*)(xb + (size_t)row * DM + (lane + 64 * i) * 4) = w; }
#pragma unroll
          for (int o = 32; o > 0; o >>= 1) { ss0 += __shfl_xor(ss0, o); ss1 += __shfl_xor(ss1, o); }
          if (lane == 0) { rs0[row] = ss0; rs0[row + 1] = ss1; } } }
    { float* rope = (float*)(ws + WS_ROPE);
      for (int i = wk * 512 + tid; i < SEQ * 32; i += nw * 512) { const int pos = i >> 5, fi = i & 31;
          const double invf = exp_d(-9.210340371976184 * (double)fi * (1.0 / 32.0)); double sn, cs; sincos_d((double)pos * invf, sn, cs);
          rope[i] = (float)cs; rope[SEQ * 32 + i] = (float)sn; } }
}

#define MFMA32(a, b, c) __builtin_amdgcn_mfma_f32_32x32x16_bf16((a), (b), (c), 0, 0, 0)

__device__ __forceinline__ void moba_assign(const LAS unsigned* mk, int r, int& ql, bool& valid, int& ntile) {
    unsigned tot = 0, word = 0, base = 0; int wsel = 0; bool found = false;
#pragma unroll
    for (int ww = 0; ww < 8; ++ww) { const unsigned m = mk[ww]; const unsigned pc = __popc(m); if (!found && (unsigned)r < tot + pc) { word = m; base = tot; wsel = ww; found = true; } tot += pc; }
    valid = found; ntile = (int)((tot + 31u) >> 5);
    int k = found ? r - (int)base : 0, pos = 0;
#pragma unroll
    for (int sft = 16; sft >= 1; sft >>= 1) { const int c = __popc(word & (((1u << sft) - 1u) << pos)); if (k >= c) { k -= c; pos += sft; } }
    ql = found ? wsel * 32 + (pos & 31) : 0;
}
__device__ __forceinline__ void attn_unit_h(LAS unsigned char* lds, const bf16_t* Q, const bf16_t* Kb, const bf16_t* VT, const float* kmean, bf16_t* O, int b, int h, int qb) {
    const int tid = tidx(), w = tid >> 6, lane = tid & 63, qi = lane & 31, hf = lane >> 5;
    LAS bf16_t* Kt = (LAS bf16_t*)lds;
    LAS bf16_t* Vt = (LAS bf16_t*)(lds + 36864);
    LAS float* km = (LAS float*)(lds + 70656);
    LAS unsigned* msk = (LAS unsigned*)(lds + 78592);
    LAS float* stt = (LAS float*)(lds + 79616);
    const int cur = qb;
    for (int i = tid; i < cur * 64; i += 512) km[i] = kmean[(size_t)((b * 8 + h) * 32) * 64 + i];
    const int row0 = b * SEQ + qb * 256, qown = 32 * w + qi;
    bf16x8 qf[4];
#pragma unroll
    for (int st = 0; st < 4; ++st) qf[st] = *(const bf16x8*)(Q + (size_t)(row0 + qown) * 512 + h * 64 + 16 * st + 8 * hf);
    const int sr = tid >> 3, sc = (tid & 7) * 8;
    const bf16_t* kg = Kb + ((size_t)(b * 8 + h) * SEQ + sr) * 64 + sc;
    const bf16_t* vg = VT + ((size_t)((b * 8 + h) * 32) * 64 + sr) * 256 + sc;
    u32x4 kreg[4], vreg[4];
    { const int kb0 = qb * 256;
#pragma unroll
      for (int p = 0; p < 4; ++p) { kreg[p] = *(const u32x4*)(kg + (size_t)(kb0 + 64 * p) * 64); vreg[p] = *(const u32x4*)(vg + (size_t)(kb0 >> 8) * 16384 + 64 * p); } }
    __syncthreads();
    int i0 = 0, i1 = 1, i2 = 2;
    if (cur > 3) {
        float qv[32];
#pragma unroll
        for (int st = 0; st < 4; ++st)
#pragma unroll
            for (int e = 0; e < 8; ++e) qv[st * 8 + e] = __uint_as_float(((unsigned)(unsigned short)qf[st][e]) << 16);
        float b0 = -3e38f, b1 = -3e38f, b2 = -3e38f;
        for (int j = 0; j < cur; ++j) { float g = 0.f;
#pragma unroll
            for (int st = 0; st < 4; ++st) { const f32x4 k0 = *(const LAS f32x4*)(km + j * 64 + 16 * st + 8 * hf), k1 = *(const LAS f32x4*)(km + j * 64 + 16 * st + 8 * hf + 4);
#pragma unroll
                for (int e = 0; e < 4; ++e) { g += qv[st * 8 + e] * k0[e]; g += qv[st * 8 + 4 + e] * k1[e]; } }
            g += __shfl_xor(g, 32);
            if (g > b0) { b2 = b1; i2 = i1; b1 = b0; i1 = i0; b0 = g; i0 = j; } else if (g > b1) { b2 = b1; i2 = i1; b1 = g; i1 = j; } else if (g > b2) { b2 = g; i2 = j; } }
    }
    for (int j = 0; j < cur; ++j) { const bool sj = (cur <= 3) || j == i0 || j == i1 || j == i2; const unsigned long long bal = __ballot(sj); if (lane == 0) msk[j * 8 + w] = (unsigned)bal; }
#pragma unroll
    for (int p = 0; p < 4; ++p) { *(LAS u32x4*)(Kt + (sr + 64 * p) * 72 + sc) = kreg[p]; *(LAS u32x4*)(Vt + sr * 264 + sc + 64 * p) = vreg[p]; }
    __syncthreads();
    f32x16 o0, o1;
#pragma unroll
    for (int e = 0; e < 16; ++e) { o0[e] = 0.f; o1[e] = 0.f; }
    float mrun = NEGBIG, lrun = 0.f;
    const int krow = (qi & 19) | ((qi & 4) << 1) | ((qi & 8) >> 1);
    int qln = 0, ntn = 0; bool validn = false; bf16x8 gqA[4], gqB[4];
    if (cur > 0) { moba_assign(msk, 32 * w + qi, qln, validn, ntn); if (ntn <= 4) moba_assign(msk, 32 * (w >> 1) + qi, qln, validn, ntn);
#pragma unroll
        for (int st = 0; st < 4; ++st) gqA[st] = *(const bf16x8*)(Q + (size_t)(row0 + qln) * 512 + h * 64 + 16 * st + 8 * hf); }
    int qlc = qown, ntc = 8; bool validc = true; bool pairm = false, second = false; int tq = w;
    { const int blk0 = 0;
    {
        const bool own = true;
        if (blk0 < cur) { const int kb1 = blk0 * 256;
#pragma unroll
            for (int p = 0; p < 4; ++p) { kreg[p] = *(const u32x4*)(kg + (size_t)(kb1 + 64 * p) * 64); vreg[p] = *(const u32x4*)(vg + (size_t)(kb1 >> 8) * 16384 + 64 * p); } }
        if (!own) {
            qlc = qln; ntc = ntn; validc = validn;
            if (blk0 < cur) { moba_assign(msk + blk0 * 8, 32 * w + qi, qln, validn, ntn); if (ntn <= 4) moba_assign(msk + blk0 * 8, 32 * (w >> 1) + qi, qln, validn, ntn);
#pragma unroll
                for (int st = 0; st < 4; ++st) gqA[st] = *(const bf16x8*)(Q + (size_t)(row0 + qln) * 512 + h * 64 + 16 * st + 8 * hf); }
            pairm = ntc <= 4; tq = pairm ? (w >> 1) : w; second = pairm && (w & 1);
            if (second) {
#pragma unroll
                for (int e = 0; e < 16; ++e) { o0[e] = 0.f; o1[e] = 0.f; }
                mrun = NEGBIG; lrun = 0.f;
            } else if (tq < ntc) { const LAS float* sp = stt + qlc * 68;
#pragma unroll
                for (int g4 = 0; g4 < 4; ++g4) { const f32x4 a = *(const LAS f32x4*)(sp + 8 * g4 + 4 * hf), c = *(const LAS f32x4*)(sp + 32 + 8 * g4 + 4 * hf);
#pragma unroll
                    for (int e = 0; e < 4; ++e) { o0[4 * g4 + e] = a[e]; o1[4 * g4 + e] = c[e]; } }
                mrun = sp[64]; lrun = hf == 0 ? sp[65] : 0.f; }
        }
        const bool allowed = own || validc;
        const int tlo = (!own && second) ? 2 : 0, thi = (!own && pairm && !second) ? 2 : 4;
        for (int ti = tlo; ti < thi; ++ti) {
            bool active, partial = false;
            if (own) { const int klo = 64 * ti, qlo = 32 * w; active = !(klo > qlo + 31); partial = (klo + 63 > qlo); }
            else active = (tq < ntc);
            if (active) {
                f32x16 s0, s1;
#pragma unroll
                for (int e = 0; e < 16; ++e) { s0[e] = 0.f; s1[e] = 0.f; }
                const LAS bf16_t* kt = Kt + (64 * ti) * 72;
#pragma unroll
                for (int st = 0; st < 4; ++st) { const bf16x8 a0 = *(const LAS bf16x8*)(kt + krow * 72 + 16 * st + 8 * hf), a1 = *(const LAS bf16x8*)(kt + (32 + krow) * 72 + 16 * st + 8 * hf);
                    s0 = MFMA32(a0, qf[st], s0); s1 = MFMA32(a1, qf[st], s1); }
                if (partial) { const int qrel = 32 * w + qi - 64 * ti;
#pragma unroll
                    for (int e = 0; e < 16; ++e) { const int ko = 16 * (e >> 3) + 8 * hf + (e & 7); if (ko > qrel) s0[e] = NEGBIG; if (ko + 32 > qrel) s1[e] = NEGBIG; } }
                float mx = s0[0];
#pragma unroll
                for (int e = 1; e < 16; ++e) mx = fmaxf(mx, s0[e]);
#pragma unroll
                for (int e = 0; e < 16; ++e) mx = fmaxf(mx, s1[e]);
                if (!allowed) mx = NEGBIG;
                mx = fmaxf(mx, __shfl_xor(mx, 32));
                const bool need = mx > mrun + 40.f;
                if (__ballot(need) != 0ull) {
                    const float mn = need ? mx : mrun, alpha = __builtin_amdgcn_exp2f(mrun - mn); mrun = mn; lrun *= alpha;
#pragma unroll
                    for (int e = 0; e < 16; ++e) { o0[e] *= alpha; o1[e] *= alpha; }
                }
                const float msub = allowed ? mrun : 1e30f;
                f32x2 ps2 = {0.f, 0.f};
#pragma unroll
                for (int e = 0; e < 16; e += 2) { f32x2 d0 = {s0[e], s0[e + 1]}, d1 = {s1[e], s1[e + 1]}; d0 = d0 - msub; d1 = d1 - msub;
                    s0[e] = __builtin_amdgcn_exp2f(d0.x); s0[e + 1] = __builtin_amdgcn_exp2f(d0.y); s1[e] = __builtin_amdgcn_exp2f(d1.x); s1[e + 1] = __builtin_amdgcn_exp2f(d1.y);
                    ps2 = ps2 + (f32x2){s0[e], s0[e + 1]}; ps2 = ps2 + (f32x2){s1[e], s1[e + 1]}; }
                lrun += ps2.x + ps2.y;
                const LAS bf16_t* vt = Vt + 64 * ti;
#pragma unroll
                for (int kh = 0; kh < 2; ++kh)
#pragma unroll
                    for (int s = 0; s < 2; ++s) {
                        union { u32x4 u; bf16x8 v; } pf;
                        if (kh == 0) { pf.u.x = cvt_pk_bf16(s0[8 * s], s0[8 * s + 1]); pf.u.y = cvt_pk_bf16(s0[8 * s + 2], s0[8 * s + 3]); pf.u.z = cvt_pk_bf16(s0[8 * s + 4], s0[8 * s + 5]); pf.u.w = cvt_pk_bf16(s0[8 * s + 6], s0[8 * s + 7]); }
                        else { pf.u.x = cvt_pk_bf16(s1[8 * s], s1[8 * s + 1]); pf.u.y = cvt_pk_bf16(s1[8 * s + 2], s1[8 * s + 3]); pf.u.z = cvt_pk_bf16(s1[8 * s + 4], s1[8 * s + 5]); pf.u.w = cvt_pk_bf16(s1[8 * s + 6], s1[8 * s + 7]); }
                        const bf16x8 v0 = *(const LAS bf16x8*)(vt + qi * 264 + 32 * kh + 16 * s + 8 * hf), v1 = *(const LAS bf16x8*)(vt + (32 + qi) * 264 + 32 * kh + 16 * s + 8 * hf);
                        o0 = MFMA32(v0, pf.v, o0); o1 = MFMA32(v1, pf.v, o1);
                    }
            }
        }
        if (own || (!second && tq < ntc && validc)) {
            const float lt = lrun + __shfl_xor(lrun, 32);
            LAS float* sp = stt + qlc * 68;
#pragma unroll
            for (int g4 = 0; g4 < 4; ++g4) { f32x4 a, c;
#pragma unroll
                for (int e = 0; e < 4; ++e) { a[e] = o0[4 * g4 + e]; c[e] = o1[4 * g4 + e]; }
                *(LAS f32x4*)(sp + 8 * g4 + 4 * hf) = a; *(LAS f32x4*)(sp + 32 + 8 * g4 + 4 * hf) = c; }
            if (hf == 0) { sp[64] = mrun; sp[65] = lt; }
        }
        __syncthreads();
        if (!own && second && tq < ntc && validc) {
            const float lB = lrun + __shfl_xor(lrun, 32);
            LAS float* sp = stt + qlc * 68;
            const float mA = sp[64], lA = sp[65], mM = fmaxf(mA, mrun), ca = __builtin_amdgcn_exp2f(mA - mM), cb = __builtin_amdgcn_exp2f(mrun - mM);
#pragma unroll
            for (int g4 = 0; g4 < 4; ++g4) { f32x4 x = *(const LAS f32x4*)(sp + 8 * g4 + 4 * hf), y = *(const LAS f32x4*)(sp + 32 + 8 * g4 + 4 * hf);
#pragma unroll
                for (int e = 0; e < 4; ++e) { x[e] = x[e] * ca + o0[4 * g4 + e] * cb; y[e] = y[e] * ca + o1[4 * g4 + e] * cb; }
                *(LAS f32x4*)(sp + 8 * g4 + 4 * hf) = x; *(LAS f32x4*)(sp + 32 + 8 * g4 + 4 * hf) = y; }
            if (hf == 0) { sp[64] = mM; sp[65] = lA * ca + lB * cb; }
        }
        if (blk0 < cur) {
#pragma unroll
            for (int p = 0; p < 4; ++p) { *(LAS u32x4*)(Kt + (sr + 64 * p) * 72 + sc) = kreg[p]; *(LAS u32x4*)(Vt + sr * 264 + sc + 64 * p) = vreg[p]; }
            __syncthreads();
        }
        }
    }
    for (int blk = 1; blk <= cur; blk += 2) {
    {
        const bool own = false;
        if (blk < cur) { const int kb1 = blk * 256;
#pragma unroll
            for (int p = 0; p < 4; ++p) { kreg[p] = *(const u32x4*)(kg + (size_t)(kb1 + 64 * p) * 64); vreg[p] = *(const u32x4*)(vg + (size_t)(kb1 >> 8) * 16384 + 64 * p); } }
        if (!own) {
            qlc = qln; ntc = ntn; validc = validn;
            if (blk < cur) { moba_assign(msk + blk * 8, 32 * w + qi, qln, validn, ntn); if (ntn <= 4) moba_assign(msk + blk * 8, 32 * (w >> 1) + qi, qln, validn, ntn);
#pragma unroll
                for (int st = 0; st < 4; ++st) gqB[st] = *(const bf16x8*)(Q + (size_t)(row0 + qln) * 512 + h * 64 + 16 * st + 8 * hf); }
            pairm = ntc <= 4; tq = pairm ? (w >> 1) : w; second = pairm && (w & 1);
            if (second) {
#pragma unroll
                for (int e = 0; e < 16; ++e) { o0[e] = 0.f; o1[e] = 0.f; }
                mrun = NEGBIG; lrun = 0.f;
            } else if (tq < ntc) { const LAS float* sp = stt + qlc * 68;
#pragma unroll
                for (int g4 = 0; g4 < 4; ++g4) { const f32x4 a = *(const LAS f32x4*)(sp + 8 * g4 + 4 * hf), c = *(const LAS f32x4*)(sp + 32 + 8 * g4 + 4 * hf);
#pragma unroll
                    for (int e = 0; e < 4; ++e) { o0[4 * g4 + e] = a[e]; o1[4 * g4 + e] = c[e]; } }
                mrun = sp[64]; lrun = hf == 0 ? sp[65] : 0.f; }
        }
        const bool allowed = own || validc;
        const int tlo = (!own && second) ? 2 : 0, thi = (!own && pairm && !second) ? 2 : 4;
        for (int ti = tlo; ti < thi; ++ti) {
            bool active, partial = false;
            if (own) { const int klo = 64 * ti, qlo = 32 * w; active = !(klo > qlo + 31); partial = (klo + 63 > qlo); }
            else active = (tq < ntc);
            if (active) {
                f32x16 s0, s1;
#pragma unroll
                for (int e = 0; e < 16; ++e) { s0[e] = 0.f; s1[e] = 0.f; }
                const LAS bf16_t* kt = Kt + (64 * ti) * 72;
#pragma unroll
                for (int st = 0; st < 4; ++st) { const bf16x8 a0 = *(const LAS bf16x8*)(kt + krow * 72 + 16 * st + 8 * hf), a1 = *(const LAS bf16x8*)(kt + (32 + krow) * 72 + 16 * st + 8 * hf);
                    s0 = MFMA32(a0, gqA[st], s0); s1 = MFMA32(a1, gqA[st], s1); }
                if (partial) { const int qrel = 32 * w + qi - 64 * ti;
#pragma unroll
                    for (int e = 0; e < 16; ++e) { const int ko = 16 * (e >> 3) + 8 * hf + (e & 7); if (ko > qrel) s0[e] = NEGBIG; if (ko + 32 > qrel) s1[e] = NEGBIG; } }
                float mx = s0[0];
#pragma unroll
                for (int e = 1; e < 16; ++e) mx = fmaxf(mx, s0[e]);
#pragma unroll
                for (int e = 0; e < 16; ++e) mx = fmaxf(mx, s1[e]);
                if (!allowed) mx = NEGBIG;
                mx = fmaxf(mx, __shfl_xor(mx, 32));
                const bool need = mx > mrun + 40.f;
                if (__ballot(need) != 0ull) {
                    const float mn = need ? mx : mrun, alpha = __builtin_amdgcn_exp2f(mrun - mn); mrun = mn; lrun *= alpha;
#pragma unroll
                    for (int e = 0; e < 16; ++e) { o0[e] *= alpha; o1[e] *= alpha; }
                }
                const float msub = allowed ? mrun : 1e30f;
                f32x2 ps2 = {0.f, 0.f};
#pragma unroll
                for (int e = 0; e < 16; e += 2) { f32x2 d0 = {s0[e], s0[e + 1]}, d1 = {s1[e], s1[e + 1]}; d0 = d0 - msub; d1 = d1 - msub;
                    s0[e] = __builtin_amdgcn_exp2f(d0.x); s0[e + 1] = __builtin_amdgcn_exp2f(d0.y); s1[e] = __builtin_amdgcn_exp2f(d1.x); s1[e + 1] = __builtin_amdgcn_exp2f(d1.y);
                    ps2 = ps2 + (f32x2){s0[e], s0[e + 1]}; ps2 = ps2 + (f32x2){s1[e], s1[e + 1]}; }
                lrun += ps2.x + ps2.y;
                const LAS bf16_t* vt = Vt + 64 * ti;
#pragma unroll
                for (int kh = 0; kh < 2; ++kh)
#pragma unroll
                    for (int s = 0; s < 2; ++s) {
                        union { u32x4 u; bf16x8 v; } pf;
                        if (kh == 0) { pf.u.x = cvt_pk_bf16(s0[8 * s], s0[8 * s + 1]); pf.u.y = cvt_pk_bf16(s0[8 * s + 2], s0[8 * s + 3]); pf.u.z = cvt_pk_bf16(s0[8 * s + 4], s0[8 * s + 5]); pf.u.w = cvt_pk_bf16(s0[8 * s + 6], s0[8 * s + 7]); }
                        else { pf.u.x = cvt_pk_bf16(s1[8 * s], s1[8 * s + 1]); pf.u.y = cvt_pk_bf16(s1[8 * s + 2], s1[8 * s + 3]); pf.u.z = cvt_pk_bf16(s1[8 * s + 4], s1[8 * s + 5]); pf.u.w = cvt_pk_bf16(s1[8 * s + 6], s1[8 * s + 7]); }
                        const bf16x8 v0 = *(const LAS bf16x8*)(vt + qi * 264 + 32 * kh + 16 * s + 8 * hf), v1 = *(const LAS bf16x8*)(vt + (32 + qi) * 264 + 32 * kh + 16 * s + 8 * hf);
                        o0 = MFMA32(v0, pf.v, o0); o1 = MFMA32(v1, pf.v, o1);
                    }
            }
        }
        if (own || (!second && tq < ntc && validc)) {
            const float lt = lrun + __shfl_xor(lrun, 32);
            LAS float* sp = stt + qlc * 68;
#pragma unroll
            for (int g4 = 0; g4 < 4; ++g4) { f32x4 a, c;
#pragma unroll
                for (int e = 0; e < 4; ++e) { a[e] = o0[4 * g4 + e]; c[e] = o1[4 * g4 + e]; }
                *(LAS f32x4*)(sp + 8 * g4 + 4 * hf) = a; *(LAS f32x4*)(sp + 32 + 8 * g4 + 4 * hf) = c; }
            if (hf == 0) { sp[64] = mrun; sp[65] = lt; }
        }
        __syncthreads();
        if (!own && second && tq < ntc && validc) {
            const float lB = lrun + __shfl_xor(lrun, 32);
            LAS float* sp = stt + qlc * 68;
            const float mA = sp[64], lA = sp[65], mM = fmaxf(mA, mrun), ca = __builtin_amdgcn_exp2f(mA - mM), cb = __builtin_amdgcn_exp2f(mrun - mM);
#pragma unroll
            for (int g4 = 0; g4 < 4; ++g4) { f32x4 x = *(const LAS f32x4*)(sp + 8 * g4 + 4 * hf), y = *(const LAS f32x4*)(sp + 32 + 8 * g4 + 4 * hf);
#pragma unroll
                for (int e = 0; e < 4; ++e) { x[e] = x[e] * ca + o0[4 * g4 + e] * cb; y[e] = y[e] * ca + o1[4 * g4 + e] * cb; }
                *(LAS f32x4*)(sp + 8 * g4 + 4 * hf) = x; *(LAS f32x4*)(sp + 32 + 8 * g4 + 4 * hf) = y; }
            if (hf == 0) { sp[64] = mM; sp[65] = lA * ca + lB * cb; }
        }
        if (blk < cur) {
#pragma unroll
            for (int p = 0; p < 4; ++p) { *(LAS u32x4*)(Kt + (sr + 64 * p) * 72 + sc) = kreg[p]; *(LAS u32x4*)(Vt + sr * 264 + sc + 64 * p) = vreg[p]; }
            __syncthreads();
        }
        }
        if (blk + 1 <= cur) { const int blkb = blk + 1;
    {
        const bool own = false;
        if (blkb < cur) { const int kb1 = blkb * 256;
#pragma unroll
            for (int p = 0; p < 4; ++p) { kreg[p] = *(const u32x4*)(kg + (size_t)(kb1 + 64 * p) * 64); vreg[p] = *(const u32x4*)(vg + (size_t)(kb1 >> 8) * 16384 + 64 * p); } }
        if (!own) {
            qlc = qln; ntc = ntn; validc = validn;
            if (blkb < cur) { moba_assign(msk + blkb * 8, 32 * w + qi, qln, validn, ntn); if (ntn <= 4) moba_assign(msk + blkb * 8, 32 * (w >> 1) + qi, qln, validn, ntn);
#pragma unroll
                for (int st = 0; st < 4; ++st) gqA[st] = *(const bf16x8*)(Q + (size_t)(row0 + qln) * 512 + h * 64 + 16 * st + 8 * hf); }
            pairm = ntc <= 4; tq = pairm ? (w >> 1) : w; second = pairm && (w & 1);
            if (second) {
#pragma unroll
                for (int e = 0; e < 16; ++e) { o0[e] = 0.f; o1[e] = 0.f; }
                mrun = NEGBIG; lrun = 0.f;
            } else if (tq < ntc) { const LAS float* sp = stt + qlc * 68;
#pragma unroll
                for (int g4 = 0; g4 < 4; ++g4) { const f32x4 a = *(const LAS f32x4*)(sp + 8 * g4 + 4 * hf), c = *(const LAS f32x4*)(sp + 32 + 8 * g4 + 4 * hf);
#pragma unroll
                    for (int e = 0; e < 4; ++e) { o0[4 * g4 + e] = a[e]; o1[4 * g4 + e] = c[e]; } }
                mrun = sp[64]; lrun = hf == 0 ? sp[65] : 0.f; }
        }
        const bool allowed = own || validc;
        const int tlo = (!own && second) ? 2 : 0, thi = (!own && pairm && !second) ? 2 : 4;
        for (int ti = tlo; ti < thi; ++ti) {
            bool active, partial = false;
            if (own) { const int klo = 64 * ti, qlo = 32 * w; active = !(klo > qlo + 31); partial = (klo + 63 > qlo); }
            else active = (tq < ntc);
            if (active) {
                f32x16 s0, s1;
#pragma unroll
                for (int e = 0; e < 16; ++e) { s0[e] = 0.f; s1[e] = 0.f; }
                const LAS bf16_t* kt = Kt + (64 * ti) * 72;
#pragma unroll
                for (int st = 0; st < 4; ++st) { const bf16x8 a0 = *(const LAS bf16x8*)(kt + krow * 72 + 16 * st + 8 * hf), a1 = *(const LAS bf16x8*)(kt + (32 + krow) * 72 + 16 * st + 8 * hf);
                    s0 = MFMA32(a0, gqB[st], s0); s1 = MFMA32(a1, gqB[st], s1); }
                if (partial) { const int qrel = 32 * w + qi - 64 * ti;
#pragma unroll
                    for (int e = 0; e < 16; ++e) { const int ko = 16 * (e >> 3) + 8 * hf + (e & 7); if (ko > qrel) s0[e] = NEGBIG; if (ko + 32 > qrel) s1[e] = NEGBIG; } }
                float mx = s0[0];
#pragma unroll
                for (int e = 1; e < 16; ++e) mx = fmaxf(mx, s0[e]);
#pragma unroll
                for (int e = 0; e < 16; ++e) mx = fmaxf(mx, s1[e]);
                if (!allowed) mx = NEGBIG;
                mx = fmaxf(mx, __shfl_xor(mx, 32));
                const bool need = mx > mrun + 40.f;
                if (__ballot(need) != 0ull) {
                    const float mn = need ? mx : mrun, alpha = __builtin_amdgcn_exp2f(mrun - mn); mrun = mn; lrun *= alpha;
#pragma unroll
                    for (int e = 0; e < 16; ++e) { o0[e] *= alpha; o1[e] *= alpha; }
                }
                const float msub = allowed ? mrun : 1e30f;
                f32x2 ps2 = {0.f, 0.f};
#pragma unroll
                for (int e = 0; e < 16; e += 2) { f32x2 d0 = {s0[e], s0[e + 1]}, d1 = {s1[e], s1[e + 1]}; d0 = d0 - msub; d1 = d1 - msub;
                    s0[e] = __builtin_amdgcn_exp2f(d0.x); s0[e + 1] = __builtin_amdgcn_exp2f(d0.y); s1[e] = __builtin_amdgcn_exp2f(d1.x); s1[e + 1] = __builtin_amdgcn_exp2f(d1.y);
                    ps2 = ps2 + (f32x2){s0[e], s0[e + 1]}; ps2 = ps2 + (f32x2){s1[e], s1[e + 1]}; }
                lrun += ps2.x + ps2.y;
                const LAS bf16_t* vt = Vt + 64 * ti;
#pragma unroll
                for (int kh = 0; kh < 2; ++kh)
#pragma unroll
                    for (int s = 0; s < 2; ++s) {
                        union { u32x4 u; bf16x8 v; } pf;
                        if (kh == 0) { pf.u.x = cvt_pk_bf16(s0[8 * s], s0[8 * s + 1]); pf.u.y = cvt_pk_bf16(s0[8 * s + 2], s0[8 * s + 3]); pf.u.z = cvt_pk_bf16(s0[8 * s + 4], s0[8 * s + 5]); pf.u.w = cvt_pk_bf16(s0[8 * s + 6], s0[8 * s + 7]); }
                        else { pf.u.x = cvt_pk_bf16(s1[8 * s], s1[8 * s + 1]); pf.u.y = cvt_pk_bf16(s1[8 * s + 2], s1[8 * s + 3]); pf.u.z = cvt_pk_bf16(s1[8 * s + 4], s1[8 * s + 5]); pf.u.w = cvt_pk_bf16(s1[8 * s + 6], s1[8 * s + 7]); }
                        const bf16x8 v0 = *(const LAS bf16x8*)(vt + qi * 264 + 32 * kh + 16 * s + 8 * hf), v1 = *(const LAS bf16x8*)(vt + (32 + qi) * 264 + 32 * kh + 16 * s + 8 * hf);
                        o0 = MFMA32(v0, pf.v, o0); o1 = MFMA32(v1, pf.v, o1);
                    }
            }
        }
        if (own || (!second && tq < ntc && validc)) {
            const float lt = lrun + __shfl_xor(lrun, 32);
            LAS float* sp = stt + qlc * 68;
#pragma unroll
            for (int g4 = 0; g4 < 4; ++g4) { f32x4 a, c;
#pragma unroll
                for (int e = 0; e < 4; ++e) { a[e] = o0[4 * g4 + e]; c[e] = o1[4 * g4 + e]; }
                *(LAS f32x4*)(sp + 8 * g4 + 4 * hf) = a; *(LAS f32x4*)(sp + 32 + 8 * g4 + 4 * hf) = c; }
            if (hf == 0) { sp[64] = mrun; sp[65] = lt; }
        }
        __syncthreads();
        if (!own && second && tq < ntc && validc) {
            const float lB = lrun + __shfl_xor(lrun, 32);
            LAS float* sp = stt + qlc * 68;
            const float mA = sp[64], lA = sp[65], mM = fmaxf(mA, mrun), ca = __builtin_amdgcn_exp2f(mA - mM), cb = __builtin_amdgcn_exp2f(mrun - mM);
#pragma unroll
            for (int g4 = 0; g4 < 4; ++g4) { f32x4 x = *(const LAS f32x4*)(sp + 8 * g4 + 4 * hf), y = *(const LAS f32x4*)(sp + 32 + 8 * g4 + 4 * hf);
#pragma unroll
                for (int e = 0; e < 4; ++e) { x[e] = x[e] * ca + o0[4 * g4 + e] * cb; y[e] = y[e] * ca + o1[4 * g4 + e] * cb; }
                *(LAS f32x4*)(sp + 8 * g4 + 4 * hf) = x; *(LAS f32x4*)(sp + 32 + 8 * g4 + 4 * hf) = y; }
            if (hf == 0) { sp[64] = mM; sp[65] = lA * ca + lB * cb; }
        }
        if (blkb < cur) {
#pragma unroll
            for (int p = 0; p < 4; ++p) { *(LAS u32x4*)(Kt + (sr + 64 * p) * 72 + sc) = kreg[p]; *(LAS u32x4*)(Vt + sr * 264 + sc + 64 * p) = vreg[p]; }
            __syncthreads();
        }
        }
        }
    }
    __syncthreads();
    {
        const LAS float* sp = stt + qown * 68; const float il = 1.f / sp[65];
        bf16_t* op = O + (size_t)(row0 + qown) * 512 + h * 64 + 4 * hf;
#pragma unroll
        for (int g4 = 0; g4 < 4; ++g4) { const f32x4 a = *(const LAS f32x4*)(sp + 8 * g4 + 4 * hf), c = *(const LAS f32x4*)(sp + 32 + 8 * g4 + 4 * hf); u32x2 w0, w1;
            w0.x = cvt_pk_bf16(a[0] * il, a[1] * il); w0.y = cvt_pk_bf16(a[2] * il, a[3] * il); w1.x = cvt_pk_bf16(c[0] * il, c[1] * il); w1.y = cvt_pk_bf16(c[2] * il, c[3] * il);
            *(u32x2*)(op + 8 * g4) = w0; *(u32x2*)(op + 32 + 8 * g4) = w1; }
    }
    __syncthreads();
}

__device__ __forceinline__ void ssm_scan_pairs(LAS unsigned char* lds, unsigned char* ws, int pr0, int prstep) {
    const int tid = tidx();
        LAS float* Es = (LAS float*)lds;
        for (int pr = pr0; pr < 64; pr += prstep) { const int g = pr >> 1, b = pr & 1, p = tid & 63, seg = tid >> 6; const int row0 = g * 512 + b * 256 + seg * 32;
            const float* aT = (const float*)(ws + WS_AT); const float ar = aT[(g * 64 + p) * 2], ai = aT[(g * 64 + p) * 2 + 1];
            const float* S = (const float*)(ws + WS_SOUT) + (size_t)row0 * 128; bf16_t* AP = (bf16_t*)(ws + WS_AP) + (size_t)row0 * AK + 512;
            float sr_[32], si_[32];
#pragma unroll
            for (int e = 0; e < 32; ++e) { sr_[e] = S[(size_t)e * 128 + p]; si_[e] = S[(size_t)e * 128 + 64 + p]; }
            float hr = 0.f, hi_ = 0.f;
#pragma unroll
            for (int e = 0; e < 32; ++e) { const float nr = ar * hr - ai * hi_ + sr_[e], ni = ar * hi_ + ai * hr + si_[e]; hr = nr; hi_ = ni; }
            Es[(seg * 64 + p) * 2] = hr; Es[(seg * 64 + p) * 2 + 1] = hi_;
            float a32r = ar, a32i = ai;
#pragma unroll
            for (int q = 0; q < 5; ++q) { const float nr = a32r * a32r - a32i * a32i, ni = 2.f * a32r * a32i; a32r = nr; a32i = ni; }
            __syncthreads();
            hr = 0.f; hi_ = 0.f;
            for (int j = 0; j < seg; ++j) { const float er = Es[(j * 64 + p) * 2], ei = Es[(j * 64 + p) * 2 + 1]; const float nr = a32r * hr - a32i * hi_ + er, ni = a32r * hi_ + a32i * hr + ei; hr = nr; hi_ = ni; }
#pragma unroll
            for (int e = 0; e < 32; ++e) { bf16_t* o = AP + (size_t)e * AK; o[p] = (bf16_t)(cvt_pk_bf16(hr, 0.f) & 0xffffu); o[64 + p] = (bf16_t)(cvt_pk_bf16(hi_, 0.f) & 0xffffu);
                const float nr = ar * hr - ai * hi_ + sr_[e], ni = ar * hi_ + ai * hr + si_[e]; hr = nr; hi_ = ni; }
            __syncthreads(); }
}

#define XB_TMO      128
#define XB_XCNT(j)  (256  + 64 * (j))
#define XB_XSUB(j)  (1280 + 64 * (j))
#define XB_XGEN(j)  (2304 + 64 * (j))
#define XB_TOP      3328
#define XB_TOPGEN   3392
#define XCD_BAR_WORDS 3456
#define XB_SPIN_CAP (1u << 18)
__device__ __forceinline__ unsigned xb_ld(unsigned* p)              { return __hip_atomic_load(p, __ATOMIC_RELAXED, __HIP_MEMORY_SCOPE_AGENT); }
__device__ __forceinline__ unsigned xb_add(unsigned* p, unsigned v) { return __hip_atomic_fetch_add(p, v, __ATOMIC_RELAXED, __HIP_MEMORY_SCOPE_AGENT); }
__device__ __forceinline__ unsigned xb_xcc_id() { return (unsigned)__builtin_amdgcn_s_getreg((3 << 11) | 20) & 0xFu; }
#define XB_SPIN(cond, bar) do { unsigned _sp = 0; while (cond) { __builtin_amdgcn_s_sleep(1); \
    if ((++_sp & 255u) == 0u) { if (xb_ld(&(bar)[XB_TMO])) break; if (_sp > XB_SPIN_CAP) { atomicAdd(&(bar)[XB_TMO], 1u); break; } } } } while (0)
struct XcdBarrier { unsigned* bar; unsigned x; volatile LAS unsigned* st; };
__device__ __forceinline__ XcdBarrier xcd_barrier_post(unsigned* bar, volatile LAS unsigned* st) {
    XcdBarrier b; b.bar = bar; b.x = xb_xcc_id(); b.st = st;
    if (tidx() == 0) (void)xb_add(&bar[XB_XCNT(b.x)], 1u);
    return b;
}
__device__ __forceinline__ void xcd_barrier_complete(unsigned* bar, unsigned x, unsigned& nloc, unsigned& nx) {
    const unsigned G = gridDim.x * gridDim.y * gridDim.z;
    unsigned sum, cnt, mine, sp = 0u;
    for (;;) {
        sum = 0u; cnt = 0u; mine = 0u;
#pragma unroll
        for (unsigned j = 0; j < 16; ++j) { const unsigned c = xb_ld(&bar[XB_XCNT(j)]); sum += c; cnt += (c > 0u) ? 1u : 0u; mine = (j == x) ? c : mine; }
        if (sum == G) break;
        __builtin_amdgcn_s_sleep(1);
        if ((++sp & 255u) == 0u) { if (xb_ld(&bar[XB_TMO])) break; if (sp > XB_SPIN_CAP) { atomicAdd(&bar[XB_TMO], 1u); break; } }
    }
    nloc = mine > 0u ? mine : 1u; nx = cnt > 0u ? cnt : 1u;
}
__device__ __forceinline__ void xcd_barrier(const XcdBarrier& b) {
    asm volatile("s_waitcnt vmcnt(0)" ::: "memory");
    __syncthreads();
    if (tidx() == 0) {
        unsigned* bar = b.bar;
        __builtin_amdgcn_s_waitcnt(0);
        unsigned nloc = b.st[0], nx = b.st[1];
        if (nloc == 0u) { xcd_barrier_complete(bar, b.x, nloc, nx); b.st[0] = nloc; b.st[1] = nx; }
        const unsigned old = xb_add(&bar[XB_XSUB(b.x)], 1u);
        const unsigned gen = old / nloc;
        if (old + 1u == (gen + 1u) * nloc) {
            __builtin_amdgcn_fence(__ATOMIC_RELEASE, "agent");
            asm volatile("s_waitcnt vmcnt(0)" ::: "memory");
            const unsigned og = xb_add(&bar[XB_TOP], 1u);
            const unsigned tg = og / nx;
            if (og + 1u == (tg + 1u) * nx) xb_add(&bar[XB_TOPGEN], 1u);
            else XB_SPIN(xb_ld(&bar[XB_TOPGEN]) == tg, bar);
            __builtin_amdgcn_fence(__ATOMIC_ACQUIRE, "agent");
            xb_add(&bar[XB_XGEN(b.x)], 1u);
            asm volatile("s_waitcnt vmcnt(0)" ::: "memory");
        } else {
            XB_SPIN(xb_ld(&bar[XB_XGEN(b.x)]) == gen, bar);
            __builtin_amdgcn_fence(__ATOMIC_ACQUIRE, "agent");
            asm volatile("s_waitcnt vmcnt(0)" ::: "memory");
        }
    }
    __syncthreads();
}

__global__ void __launch_bounds__(512, 2) fwd_kernel(Args a_unused) {
    const ArgsP ap = (ArgsP)__builtin_amdgcn_kernarg_segment_ptr();
    extern __shared__ __attribute__((aligned(16))) unsigned char lds_raw[];
    LAS unsigned char* lds = (LAS unsigned char*)lds_raw;
    cg::grid_group grid = cg::this_grid();
    const int G = gridDim.x, bx = blockIdx.x, tid = tidx();
    const int lo = ap->lo, hi = ap->hi;
    unsigned char* const ws0 = ap->ws;
    XcdBarrier xbar; xbar.bar = (unsigned*)(ws0 + WS_BAR); xbar.x = 0; xbar.st = (volatile LAS unsigned*)(lds + LDS_CTL);
    if (hi - lo > 1) { if (tid < 2) xbar.st[tid] = 0u; __syncthreads(); xbar = xcd_barrier_post((unsigned*)(ws0 + WS_BAR), (volatile LAS unsigned*)(lds + LDS_CTL)); }
    if (lo < 0) grid.sync();
#ifndef PH_MASK
#define PH_MASK 0xffff
#endif
#ifndef DUP_MASK
#define DUP_MASK 0
#endif
#ifndef EXTRA_SYNCS
#define EXTRA_SYNCS 0
#endif
#define REP(k) for (int rep_ = 0; rep_ < 1 + ((DUP_MASK >> (k)) & 1); ++rep_, ((DUP_MASK >> (k)) & 1) ? GSYNC() : (void)0)
#define IN(k) (((PH_MASK >> (k)) & 1) && lo <= (k) && (k) < hi)
#define GSYNC() xcd_barrier(xbar)
#define SEAM(k) do { if (IN(k) && IN((k) + 1)) GSYNC(); } while (0)
#define PHASE_VARS ArgsP a = ap; asm volatile("" : "+s"(a)); unsigned char* ws = a->ws; float* RS0 = (float*)(ws + WS_RS0); float* RS1 = (float*)(ws + WS_RS1); float* RS2 = (float*)(ws + WS_RS2); float* RS3 = (float*)(ws + WS_RS3); \
    bf16_t* XB = (bf16_t*)(ws + WS_XB); bf16_t* ACT = (bf16_t*)(ws + WS_ACT); (void)RS0; (void)RS1; (void)RS2; (void)RS3; (void)XB; (void)ACT;

    REP(0) if (IN(0)) { PHASE_VARS p0_prologue(lds, a); }
    SEAM(0);
    REP(1) if (IN(1)) { PHASE_VARS pg8::Gemm g{XB, (const bf16_t*)(ws + WS_W1GU), 1024, 1024, 1024}; pg8::StaticOrder S; S.init(M, 5632, G, bx);
        EpiGateUp E{ACT, RS0}; pg8::gemm_phase<EpiGateUp, pg8::StaticOrder, true>(lds, g, S, E);
        if (G == 256 && bx >= 128) {
            int gi = bx - 128, base = 0;
            for (int j = 2; j < 9; ++j) { const WJob J = get_job(a, j); const int cnt = (J.K >> 6) * (J.ndst >> 8);
                while (gi < base + cnt) { wconv_item(J, gi - base); gi += 128; } base += cnt; } } }
    SEAM(1);
    if (IN(2)) { PHASE_VARS pg8::Gemm g{ACT, (const bf16_t*)(ws + WS_W1D), FF, FF, FF}; pg8::StaticOrder S; S.init(M, 1024, G, bx);
        EpiResB<true> E{XB, (bf16_t*)a->out, RS1, 0.5f}; pg8::gemm_phase<EpiResB<true>, pg8::StaticOrder, true>(lds, g, S, E); }
    SEAM(2);
    REP(3) if (IN(3)) { PHASE_VARS pg8::Gemm g{(const bf16_t*)a->out, (const bf16_t*)(ws + WS_WIN), 1024, 1024, 1024}; pg8::StaticOrder S; S.init(M, INW, G, bx);
        EpiWin E{RS1, (bf16_t*)(ws + WS_AP), (bf16_t*)(ws + WS_Q), (bf16_t*)(ws + WS_K), (bf16_t*)(ws + WS_VT), (bf16_t*)(ws + WS_GS), (bf16_t*)(ws + WS_GA), (const float*)(ws + WS_ROPE), (float*)(ws + WS_KMEAN)};
        pg8::gemm_phase<EpiWin, pg8::StaticOrder, true>(lds, g, S, E); }
    SEAM(3);
    const bool merged = (G >= 64);
    if (IN(4)) { PHASE_VARS
        if (merged) {
            if (bx < 64) {
                { pg8::Gemm g{(const bf16_t*)(ws + WS_AP), (const bf16_t*)(ws + WS_BTS), 512, AK, 512}; pg8::RangeOrder S{2, 1, bx, 1};
                  EpiS E{(float*)(ws + WS_SOUT)}; pg8::gemm_phase<EpiS, pg8::RangeOrder, true>(lds, g, S, E); }
                asm volatile("s_waitcnt vmcnt(0)" ::: "memory"); __syncthreads();
                ssm_scan_pairs(lds, ws, bx, 64);
                asm volatile("s_waitcnt vmcnt(0)" ::: "memory"); __syncthreads();
                { pg8::Gemm g{(const bf16_t*)(ws + WS_AP), (const bf16_t*)(ws + WS_BTY), AK, AK, AK}; pg8::RangeOrder S{2, 2, 2 * bx, 2};
                  EpiY E{(bf16_t*)(ws + WS_Y)}; pg8::gemm_phase<EpiY, pg8::RangeOrder, true>(lds, g, S, E); }
                asm volatile("s_waitcnt vmcnt(0)" ::: "memory"); __syncthreads();
                if (tid == 0) { __builtin_amdgcn_fence(__ATOMIC_RELEASE, "agent"); asm volatile("s_waitcnt vmcnt(0)" ::: "memory");
                    __hip_atomic_fetch_add((unsigned*)(ws + WS_ATTQ) + 64, 1u, __ATOMIC_RELAXED, __HIP_MEMORY_SCOPE_AGENT); }
                __syncthreads();
            }
            volatile LAS unsigned* qw = (volatile LAS unsigned*)(lds + LDS_CTL + 16);
            for (;;) {
                if (tid == 0) qw[0] = __hip_atomic_fetch_add((unsigned*)(ws + WS_ATTQ), 1u, __ATOMIC_RELAXED, __HIP_MEMORY_SCOPE_AGENT);
                __syncthreads();
                const unsigned u = qw[0];
                __syncthreads();
                if (u >= 640u) break;
                if (u >= 512u) {
                    if (tid == 0) { unsigned sp = 0; while (__hip_atomic_load((unsigned*)(ws + WS_ATTQ) + 64, __ATOMIC_RELAXED, __HIP_MEMORY_SCOPE_AGENT) < 64u) { __builtin_amdgcn_s_sleep(2); if (++sp > (1u << 22)) break; }
                        __builtin_amdgcn_fence(__ATOMIC_ACQUIRE, "agent"); asm volatile("s_waitcnt vmcnt(0)" ::: "memory"); }
                    __syncthreads();
                    pg8::Gemm g{(const bf16_t*)(ws + WS_Y), (const bf16_t*)(ws + WS_WGLU), 512, 512, 512}; pg8::RangeOrder S{64, 2, (int)u - 512, 1};
                    EpiGlu E{(const bf16_t*)(ws + WS_Y), a->in[16], (bf16_t*)(ws + WS_GT)}; pg8::gemm_phase<EpiGlu, pg8::RangeOrder, true>(lds, g, S, E);
                    __syncthreads();
                    continue;
                }
                const int qb = 31 - (int)(u >> 4), bh = (int)(u & 15);
                attn_unit_h(lds, (const bf16_t*)(ws + WS_Q), (const bf16_t*)(ws + WS_K), (const bf16_t*)(ws + WS_VT), (const float*)(ws + WS_KMEAN), (bf16_t*)(ws + WS_ATT), bh >> 3, bh & 7, qb);
            }
        } else {
            { pg8::Gemm g{(const bf16_t*)(ws + WS_AP), (const bf16_t*)(ws + WS_BTS), 512, AK, 512}; pg8::GroupOrder S{2, 1, 64, G, bx};
              EpiS E{(float*)(ws + WS_SOUT)}; pg8::gemm_phase<EpiS, pg8::GroupOrder, true>(lds, g, S, E); }
            __syncthreads();
            for (int pi = bx; pi < 256; pi += G) { const int b = pi >> 7, h = (pi >> 4) & 7, x = pi & 15;
                attn_unit_h(lds, (const bf16_t*)(ws + WS_Q), (const bf16_t*)(ws + WS_K), (const bf16_t*)(ws + WS_VT), (const float*)(ws + WS_KMEAN), (bf16_t*)(ws + WS_ATT), b, h, 31 - x);
                attn_unit_h(lds, (const bf16_t*)(ws + WS_Q), (const bf16_t*)(ws + WS_K), (const bf16_t*)(ws + WS_VT), (const float*)(ws + WS_KMEAN), (bf16_t*)(ws + WS_ATT), b, h, x); }
        }
    }
    SEAM(4);
    if (!merged) {
    if (IN(5)) { PHASE_VARS ssm_scan_pairs(lds, ws, bx, G); }
    SEAM(5);
    if (IN(6)) { PHASE_VARS pg8::Gemm g{(const bf16_t*)(ws + WS_AP), (const bf16_t*)(ws + WS_BTY), AK, AK, AK}; pg8::GroupOrder S{2, 2, 128, G, bx};
        EpiY E{(bf16_t*)(ws + WS_Y)}; pg8::gemm_phase<EpiY, pg8::GroupOrder, true>(lds, g, S, E); }
    }
    if (!merged) SEAM(6);
    if (!merged) if (IN(7)) { PHASE_VARS pg8::Gemm g{(const bf16_t*)(ws + WS_Y), (const bf16_t*)(ws + WS_WGLU), 512, 512, 512}; pg8::StaticOrder S; S.init(M, 512, G, bx);
        EpiGlu E{(const bf16_t*)(ws + WS_Y), a->in[16], (bf16_t*)(ws + WS_GT)}; pg8::gemm_phase<EpiGlu, pg8::StaticOrder, true>(lds, g, S, E); }
    if (!merged) SEAM(7);
    if (IN(8)) { PHASE_VARS
        { pg8::Gemm g{(const bf16_t*)(ws + WS_GT), (const bf16_t*)(ws + WS_WBS), 512, 512, 512}; pg8::StaticOrder S; S.init(M, 1024, G, bx);
          EpiBranch<0> E{(bf16_t*)(ws + WS_GS), (bf16_t*)(ws + WS_GA)}; pg8::gemm_phase<EpiBranch<0>, pg8::StaticOrder, true>(lds, g, S, E); }
        __syncthreads();
        { pg8::Gemm g{(const bf16_t*)(ws + WS_ATT), (const bf16_t*)(ws + WS_WBA), 512, 512, 512}; pg8::StaticOrder S; S.init(M, 1024, G, bx);
          EpiBranch<1> E{(bf16_t*)(ws + WS_GS), (bf16_t*)(ws + WS_GA)}; pg8::gemm_phase<EpiBranch<1>, pg8::StaticOrder, true>(lds, g, S, E); }
    }
    SEAM(8);
    if (IN(9)) { PHASE_VARS pg8::Gemm g{(const bf16_t*)(ws + WS_GA), (const bf16_t*)(ws + WS_WOUT), 1024, 1024, 1024}; pg8::StaticOrder S; S.init(M, 1024, G, bx);
        EpiResB<true> E{(const bf16_t*)a->out, XB, RS2, 1.0f}; pg8::gemm_phase<EpiResB<true>, pg8::StaticOrder, true>(lds, g, S, E); }
    SEAM(9);
    if (IN(10)) { PHASE_VARS pg8::Gemm g{XB, (const bf16_t*)(ws + WS_W2GU), 1024, 1024, 1024}; pg8::StaticOrder S; S.init(M, 5632, G, bx);
        EpiGateUp E{ACT, RS2}; pg8::gemm_phase<EpiGateUp, pg8::StaticOrder, true>(lds, g, S, E); }
    SEAM(10);
    const bool fuse_norm = (G == 256);
    if (IN(11)) { PHASE_VARS pg8::Gemm g{ACT, (const bf16_t*)(ws + WS_W2D), FF, FF, FF}; pg8::StaticOrder S; S.init(M, 1024, G, bx);
        if (fuse_norm) { EpiResNorm E{XB, a->out, RS3, (unsigned*)(ws + WS_PCNT), a->in[24], 0.5f}; pg8::gemm_phase<EpiResNorm, pg8::StaticOrder, true>(lds, g, S, E); }
        else { EpiResF E{XB, a->out, RS3, 0.5f}; pg8::gemm_phase<EpiResF, pg8::StaticOrder, true>(lds, g, S, E); } }
    if (!fuse_norm) {
    SEAM(11);
    for (int es_ = 0; es_ < EXTRA_SYNCS; ++es_) GSYNC();
    if (IN(12)) { PHASE_VARS const float* gain = a->in[24]; const int lane = tid & 63, wave = tid >> 6;
        for (int row = bx * 8 + wave; row < M; row += G * 8) { const float s = inv_rms(RS3[row]); f32x4* xr = (f32x4*)(a->out + (size_t)row * DM);
#pragma unroll
            for (int i = 0; i < 4; ++i) { const f32x4 gv = *(const f32x4*)(gain + (lane + 64 * i) * 4); xr[lane + 64 * i] = xr[lane + 64 * i] * s * gv; } } }
    }
#undef IN
#undef SEAM
}

extern "C" void kernel_launch(void* const* d_in, const int* in_sizes, int n_in, void* d_out, int out_size, void* d_ws, size_t ws_size, hipStream_t stream) {
    static int grid = 0;
    if (grid == 0) {
        if (n_in != 25 || out_size != M * DM || ws_size < WS_END) { fprintf(stderr, "kernel_launch: unexpected problem (n_in %d out %d ws %zu need %zu)\n", n_in, out_size, ws_size, (size_t)WS_END); grid = -1; return; }
        int dev = 0, cus = 0, per_cu = 0;
        hipGetDevice(&dev); hipDeviceGetAttribute(&cus, hipDeviceAttributeMultiprocessorCount, dev);
        if (hipFuncSetAttribute((const void*)fwd_kernel, hipFuncAttributeMaxDynamicSharedMemorySize, LDS_BYTES) != hipSuccess) { fprintf(stderr, "kernel_launch: hipFuncSetAttribute failed\n"); grid = -1; return; }
        if (hipOccupancyMaxActiveBlocksPerMultiprocessor(&per_cu, (const void*)fwd_kernel, 512, LDS_BYTES) != hipSuccess || per_cu < 1) { fprintf(stderr, "kernel_launch: occupancy query says %d\n", per_cu); per_cu = 1; }
        (void)hipGetLastError();
        grid = cus * 1;
        if (grid > 256) grid = 256;
    }
    if (grid < 0) return;
    Args a{};
    for (int i = 0; i < 25; ++i) a.in[i] = (const float*)d_in[i];
    a.out = (float*)d_out; a.ws = (unsigned char*)d_ws;
#if MULTI_LAUNCH
    for (int p = 0; p < NPHASE; ++p) { a.lo = p; a.hi = p + 1; hipLaunchKernelGGL(fwd_kernel, dim3(grid), dim3(512), LDS_BYTES, stream, a); }
#else
    a.lo = 0; a.hi = NPHASE;
    (void)hipMemsetAsync((char*)d_ws + WS_BAR, 0, XCD_BAR_WORDS * 4, stream);
    void* args[] = {&a};
    hipError_t e = hipLaunchCooperativeKernel((const void*)fwd_kernel, dim3(grid), dim3(512), args, LDS_BYTES, stream);
    if (e != hipSuccess) fprintf(stderr, "kernel_launch: cooperative launch failed: %s (grid %d)\n", hipGetErrorString(e), grid);
#endif
}
```

```cpp
#include <hip/hip_runtime.h>
#include <hip/hip_cooperative_groups.h>
#include <cstdio>
#include <cstdint>
namespace cg = cooperative_groups;

#ifndef MULTI_LAUNCH
#define MULTI_LAUNCH 0
#endif

#define LAS __attribute__((address_space(3)))
typedef unsigned short bf16_t;
typedef short bf16x8 __attribute__((ext_vector_type(8)));
typedef float f32x4 __attribute__((ext_vector_type(4)));
typedef float f32x16 __attribute__((ext_vector_type(16)));
typedef unsigned u32x4 __attribute__((ext_vector_type(4)));
typedef unsigned u32x2 __attribute__((ext_vector_type(2)));
typedef float f32x2 __attribute__((ext_vector_type(2)));

constexpr int M = 16384, DM = 1024, FF = 2816, SEQ = 8192, NH = 8, INW = 4096;
constexpr int TCH = 32, AK = 640;
constexpr float EPS = 1e-6f;
constexpr float QSCALE = 0.125f * 1.4426950408889634f;
constexpr float NEGBIG = -1e30f;
constexpr int LDS_CTL = 149504;
constexpr int LDS_BYTES = LDS_CTL + 64;
constexpr int NPHASE = 13;

constexpr size_t WS_RS0 = 0, WS_RS1 = 65536, WS_RS2 = 131072, WS_RS3 = 196608, WS_KMEAN = 262144, WS_AT = 393216;
constexpr size_t WS_PCNT = 425984;
constexpr size_t WS_ATTQ = 442368;
constexpr size_t WS_BAR = 409600;
constexpr size_t WS_ROPE = 524288;
constexpr size_t WS_W1GU = WS_ROPE + 2097152;
constexpr size_t WS_W1D = WS_W1GU + (size_t)5632 * 1024 * 2;
constexpr size_t WS_W2GU = WS_W1D + (size_t)1024 * 2816 * 2;
constexpr size_t WS_W2D = WS_W2GU + (size_t)5632 * 1024 * 2;
constexpr size_t WS_WIN = WS_W2D + (size_t)1024 * 2816 * 2;
constexpr size_t WS_WGLU = WS_WIN + (size_t)4096 * 1024 * 2;
constexpr size_t WS_WBS = WS_WGLU + (size_t)512 * 512 * 2;
constexpr size_t WS_WBA = WS_WBS + (size_t)1024 * 512 * 2;
constexpr size_t WS_WOUT = WS_WBA + (size_t)1024 * 512 * 2;
constexpr size_t WS_BTY = WS_WOUT + (size_t)1024 * 1024 * 2;
constexpr size_t WS_BTS = WS_BTY + (size_t)32 * 512 * AK * 2;
constexpr size_t WS_XB = WS_BTS + (size_t)32 * 256 * 512 * 2;
constexpr size_t WS_MIX = WS_XB + (size_t)M * 1024 * 2;
constexpr size_t WS_AP = WS_MIX;
constexpr size_t WS_SOUT = WS_AP + (size_t)M * AK * 2;
constexpr size_t WS_Q = WS_SOUT + (size_t)M * 128 * 4;
constexpr size_t WS_K = WS_Q + (size_t)M * 512 * 2;
constexpr size_t WS_VT = WS_K + (size_t)M * 512 * 2;
constexpr size_t WS_GS = WS_VT + (size_t)M * 512 * 2;
constexpr size_t WS_GA = WS_GS + (size_t)M * 1024 * 2;
constexpr size_t WS_END = WS_GA + (size_t)M * 1024 * 2;
constexpr size_t WS_ACT = WS_MIX;
constexpr size_t WS_Y = WS_W1GU;
static_assert(WS_W1D == WS_W1GU + (size_t)5632 * 1024 * 2 && WS_W2GU - WS_W1GU >= (size_t)M * 512 * 2, "y_ssm overlay");
constexpr size_t WS_ATT = WS_XB;
constexpr size_t WS_GT = WS_XB + (size_t)M * 512 * 2;
static_assert(WS_ACT + (size_t)M * FF * 2 <= WS_END, "act overlay");
static_assert(WS_END <= (size_t)256 * 1024 * 1024, "workspace");

struct Args {
    const float* in[25];
    float* out;
    unsigned char* ws;
    int lo, hi;
};
typedef const __attribute__((address_space(4))) Args* ArgsP;

__device__ __forceinline__ int tidx() { int t = (int)threadIdx.x; asm volatile("" : "+v"(t)); return t; }
__device__ __forceinline__ unsigned cvt_pk_bf16(float lo, float hi) { unsigned r; asm("v_cvt_pk_bf16_f32 %0, %1, %2" : "=v"(r) : "v"(lo), "v"(hi)); return r; }
__device__ __forceinline__ u32x4 pack8(f32x4 a, f32x4 b) { u32x4 w; w.x = cvt_pk_bf16(a[0], a[1]); w.y = cvt_pk_bf16(a[2], a[3]); w.z = cvt_pk_bf16(b[0], b[1]); w.w = cvt_pk_bf16(b[2], b[3]); return w; }
__device__ __forceinline__ void unpack8(u32x4 w, f32x4& a, f32x4& b) {
    a[0] = __uint_as_float(w.x << 16); a[1] = __uint_as_float(w.x & 0xffff0000u); a[2] = __uint_as_float(w.y << 16); a[3] = __uint_as_float(w.y & 0xffff0000u);
    b[0] = __uint_as_float(w.z << 16); b[1] = __uint_as_float(w.z & 0xffff0000u); b[2] = __uint_as_float(w.w << 16); b[3] = __uint_as_float(w.w & 0xffff0000u);
}
__device__ __forceinline__ float fast_sigmoid(float x) { return __builtin_amdgcn_rcpf(1.f + __expf(-x)); }
__device__ __forceinline__ f32x4 sigmoid4(f32x4 v) { f32x4 r; r[0] = fast_sigmoid(v[0]); r[1] = fast_sigmoid(v[1]); r[2] = fast_sigmoid(v[2]); r[3] = fast_sigmoid(v[3]); return r; }
__device__ __forceinline__ float gelu_tanh(float x) { const float u = 1.5957691216057308f * (x + 0.044715f * x * x * x); return x * fast_sigmoid(u); }
__device__ __forceinline__ float inv_rms(float ss) { return rsqrtf(ss * (1.f / 1024.f) + EPS); }

__device__ __forceinline__ double exp_d(double x) {
    const double kf = rint(x * 1.4426950408889634);
    const double r = fma(-kf, 1.9082149292705877e-10, fma(-kf, 0.6931471803691238, x));
    double t = 1.0, s = 1.0;
#pragma unroll
    for (int i = 1; i <= 14; ++i) { t *= r * (1.0 / i); s += t; }
    const long long bits = (long long)(1023 + (int)kf) << 52;
    return s * __longlong_as_double(bits);
}
__device__ __forceinline__ void sincos_d(double x, double& sn, double& cs) {
    const double kf = rint(x * 0.6366197723675814);
    double r = fma(-kf, 1.5707963267948966, x); r = fma(-kf, 6.123233995736766e-17, r);
    const double r2 = r * r;
    double ts = r, ss = r, tc = 1.0, sc = 1.0;
#pragma unroll
    for (int i = 1; i <= 8; ++i) { ts *= -r2 * (1.0 / ((2 * i) * (2 * i + 1))); ss += ts; tc *= -r2 * (1.0 / ((2 * i - 1) * (2 * i))); sc += tc; }
    const int q = (int)((long long)kf & 3);
    sn = (q == 0) ? ss : (q == 1) ? sc : (q == 2) ? -ss : -sc;
    cs = (q == 0) ? sc : (q == 1) ? -ss : (q == 2) ? -sc : ss;
}

namespace pg8 {
constexpr int BM = 256, BK = 64, HALF = 128, HTB = HALF * BK * 2, STAGE_BYTES = 8 * HTB, NXCD = 8, WGM = 8;
__host__ __device__ __forceinline__ int lds_byte(int r, int c) { const int st = (r >> 4) * 2 + (c >> 5), rr = r & 15, cc = c & 31, ob = rr * 64 + cc * 2; return st * 1024 + (ob ^ (((ob >> 9) & 1) << 5)); }
__host__ __device__ __forceinline__ void stage_rc(int b, int& R, int& C) { const int st = b / 1024, sb = b % 1024, swz = sb ^ (((sb >> 9) & 1) << 5); R = (st >> 1) * 16 + swz / 64; C = (st & 1) * 32 + (swz % 64) / 2; }
__host__ __device__ __forceinline__ int perm32(int rho) { const int n = rho >> 4, i = rho & 15; return 8 * (i >> 2) + 4 * n + (i & 3); }

struct Unit { int pm, pn; };
struct Gemm { const bf16_t* A; const bf16_t* Bt; int K, lda, ldb; };

struct StaticOrder {
    int nM, nN, nwg, G, c;
    __device__ void init(int Mr, int N, int G_, int c_) { nM = Mr / BM; nN = N / BM; nwg = nM * nN; G = G_; c = c_; }
    __device__ bool next(int i, Unit& u) const {
        const long L = (long)i * G + c; if (L >= nwg) return false;
        int wgid = (int)L; { const int q = nwg / NXCD, r = nwg % NXCD, xcd = wgid % NXCD, off = wgid / NXCD; wgid = (xcd < r ? xcd * (q + 1) : r * (q + 1) + (xcd - r) * q) + off; }
        const int nig = WGM * nN, gid = wgid / nig, fm = gid * WGM, gsz = (nM - fm) < WGM ? (nM - fm) : WGM;
        u.pm = fm + ((wgid % nig) % gsz); u.pn = (wgid % nig) / gsz; return true;
    }
};
struct GroupOrder {
    int ntm, ntn, nwg, G, c;
    __device__ bool next(int i, Unit& u) const {
        const long L = (long)i * G + c; if (L >= nwg) return false;
        const int per = ntm * ntn, g = (int)L / per, r = (int)L % per; u.pm = g * ntm + r / ntn; u.pn = g * ntn + r % ntn; return true;
    }
};

struct RangeOrder {
    int ntm, ntn, first, count;
    __device__ bool next(int i, Unit& u) const {
        if (i >= count) return false; const int L = first + i, per = ntm * ntn, g = L / per, r = L % per; u.pm = g * ntm + r / ntn; u.pn = g * ntn + r % ntn; return true;
    }
};
template <class Epi, class Sched, bool ALIGN_EPI>
__device__ __forceinline__ void gemm_phase(LAS unsigned char* lds, const Gemm g, const Sched& S, const Epi& E) {
    const int tid = tidx(), wid = __builtin_amdgcn_readfirstlane(tid >> 6), lane = tid & 63, wr = wid >> 2, wc = wid & 3, fr = lane & 15, fq = lane >> 4;
    const int K = g.K, nt = K / BK;
    unsigned voffA[2], voffB[2];
#pragma unroll
    for (int i = 0; i < 2; ++i) { int R, C; stage_rc(tid * 16 + i * 8192, R, C); const int Rb = (R & ~31) + perm32(R & 31);
        voffA[i] = (unsigned)(R * g.lda + C) * 2u; voffB[i] = (unsigned)(Rb * g.ldb + C) * 2u; }
    const size_t kstep = (size_t)(BK * 2);
    const size_t hstepA = (size_t)HALF * g.lda * 2, hstepB = (size_t)HALF * g.ldb * 2;
    const size_t tstepA = 2 * hstepA, tstepB = 2 * hstepB;
    const unsigned ldsw = (unsigned)wid * 1024u;
    const int aoff = lds_byte(wr * 64 + fr, fq * 8), boff = lds_byte(wc * 32 + fr, fq * 8);
#define PG8_SA(b, h) (((b) * 2 + (h)) * HTB)
#define PG8_SB(b, h) ((4 + (b) * 2 + (h)) * HTB)
#define PG8_STAGE(bufoff, gbase, voff) do { _Pragma("unroll") for (int _i = 0; _i < 2; ++_i) \
        __builtin_amdgcn_global_load_lds((const unsigned*)((const char*)(gbase) + (voff)[_i]), (LAS unsigned*)(lds + (bufoff) + ldsw + _i * 8192), 16, 0, 0); } while (0)
#define PG8_LDA(dst, b, h) do { _Pragma("unroll") for (int m = 0; m < 4; ++m) _Pragma("unroll") for (int k = 0; k < 2; ++k) dst[m][k] = *(const LAS bf16x8*)(lds + PG8_SA(b, h) + aoff + m * 2048 + k * 1024); } while (0)
#define PG8_LDB(dst, b, h) do { _Pragma("unroll") for (int n = 0; n < 2; ++n) _Pragma("unroll") for (int k = 0; k < 2; ++k) dst[n][k] = *(const LAS bf16x8*)(lds + PG8_SB(b, h) + boff + n * 2048 + k * 1024); } while (0)
#define PG8_MMA(ai, bj, At, Bt) do { __builtin_amdgcn_s_setprio(1); _Pragma("unroll") for (int m = 0; m < 4; ++m) _Pragma("unroll") for (int n = 0; n < 2; ++n) _Pragma("unroll") for (int k = 0; k < 2; ++k) \
        acc[ai][bj][m][n] = __builtin_amdgcn_mfma_f32_16x16x32_bf16(Bt[n][k], At[m][k], acc[ai][bj][m][n], 0, 0, 0); __builtin_amdgcn_s_setprio(0); } while (0)
#define PG8_WAIT_V(n) asm volatile("s_waitcnt vmcnt(" #n ")" ::: "memory")
#define PG8_WAIT_L(n) asm volatile("s_waitcnt lgkmcnt(" #n ")" ::: "memory")
#define PG8_BAR __builtin_amdgcn_s_barrier()
#define PG8_SCHED __builtin_amdgcn_sched_barrier(0)
    Unit cur, nxt; int ui = 0;
    if (!S.next(0, cur)) return;
    f32x4 acc[2][2][4][2];
#pragma unroll
    for (int a = 0; a < 2; ++a)
#pragma unroll
        for (int b = 0; b < 2; ++b)
#pragma unroll
            for (int m = 0; m < 4; ++m)
#pragma unroll
                for (int n = 0; n < 2; ++n) acc[a][b][m][n] = (f32x4){0.f, 0.f, 0.f, 0.f};
    bf16x8 At[4][2], B0[2][2], B1[2][2];
    const char* cA = (const char*)g.A + (size_t)cur.pm * tstepA; const char* cB = (const char*)g.Bt + (size_t)cur.pn * tstepB;
    PG8_STAGE(PG8_SB(0, 0), cB, voffB); PG8_STAGE(PG8_SB(0, 1), cB + hstepB, voffB); PG8_STAGE(PG8_SA(0, 0), cA, voffA); PG8_STAGE(PG8_SA(0, 1), cA + hstepA, voffA);
    if (wr == 1) PG8_BAR;
    PG8_WAIT_V(2); PG8_BAR;
    PG8_STAGE(PG8_SB(1, 0), cB + kstep, voffB); PG8_STAGE(PG8_SA(1, 0), cA + kstep, voffA); PG8_STAGE(PG8_SB(1, 1), cB + hstepB + kstep, voffB);
    PG8_WAIT_V(6); PG8_BAR;
    for (;;) {
        const bool has_next = S.next(ui + 1, nxt);
        const char* nA = has_next ? (const char*)g.A + (size_t)nxt.pm * tstepA : cA; const char* nB = has_next ? (const char*)g.Bt + (size_t)nxt.pn * tstepB : cB;
        for (int t = 0; t < nt; t += 2) {
            const bool last = (t == nt - 2);
            const char* a1 = cA + (size_t)(t + 1) * kstep;
            const char* a2 = last ? nA : cA + (size_t)(t + 2) * kstep; const char* b2 = last ? nB : cB + (size_t)(t + 2) * kstep;
            const char* a3 = a2 + kstep; const char* b3 = b2 + kstep;
            PG8_LDB(B0, 0, 0); PG8_LDB(B1, 0, 1); PG8_SCHED; PG8_LDA(At, 0, 0); PG8_STAGE(PG8_SA(1, 1), a1 + hstepA, voffA);
            PG8_WAIT_V(8); PG8_WAIT_L(0); PG8_BAR; PG8_MMA(0, 0, At, B0); PG8_MMA(0, 1, At, B1); PG8_BAR; PG8_SCHED;
            PG8_LDA(At, 0, 1); PG8_STAGE(PG8_SB(0, 0), b2, voffB); PG8_STAGE(PG8_SB(0, 1), b2 + hstepB, voffB); PG8_STAGE(PG8_SA(0, 0), a2, voffA);
            PG8_WAIT_V(8); PG8_WAIT_L(0); PG8_BAR; PG8_MMA(1, 0, At, B0); PG8_MMA(1, 1, At, B1); PG8_BAR; PG8_SCHED;
            PG8_LDB(B0, 1, 0); PG8_LDB(B1, 1, 1); PG8_SCHED; PG8_LDA(At, 1, 0); PG8_STAGE(PG8_SA(0, 1), a2 + hstepA, voffA);
            PG8_WAIT_V(8); PG8_WAIT_L(0); PG8_BAR; PG8_MMA(0, 0, At, B0); PG8_MMA(0, 1, At, B1); PG8_BAR; PG8_SCHED;
            PG8_LDA(At, 1, 1); PG8_STAGE(PG8_SB(1, 0), b3, voffB); PG8_STAGE(PG8_SB(1, 1), b3 + hstepB, voffB); PG8_STAGE(PG8_SA(1, 0), a3, voffA);
            PG8_WAIT_V(8); PG8_WAIT_L(0); PG8_BAR; PG8_MMA(1, 0, At, B0); PG8_MMA(1, 1, At, B1); PG8_BAR; PG8_SCHED;
        }
        if constexpr (ALIGN_EPI) { if (wr == 0) PG8_BAR; }
        { int fr_ = fr, fq_ = fq; asm volatile("" : "+v"(fr_), "+v"(fq_)); if constexpr (!Epi::AFTER_DRAIN) E(acc, cur, wr, wc, fr_, fq_); }
        if (!has_next) break;
#pragma unroll
        for (int a = 0; a < 2; ++a)
#pragma unroll
            for (int b = 0; b < 2; ++b)
#pragma unroll
                for (int m = 0; m < 4; ++m)
#pragma unroll
                    for (int n = 0; n < 2; ++n) acc[a][b][m][n] = (f32x4){0.f, 0.f, 0.f, 0.f};
        cur = nxt; cA = nA; cB = nB; ++ui;
        if constexpr (ALIGN_EPI) { if (wr == 1) PG8_BAR; }
    }
    PG8_WAIT_V(0);
    if constexpr (!ALIGN_EPI) { if (wr == 0) PG8_BAR; }
    PG8_BAR;
    if constexpr (Epi::AFTER_DRAIN) { int fr_ = fr, fq_ = fq; asm volatile("" : "+v"(fr_), "+v"(fq_)); E.fused(acc, cur, wr, wc, fr_, fq_); }
#undef PG8_SA
#undef PG8_SB
#undef PG8_STAGE
#undef PG8_LDA
#undef PG8_LDB
#undef PG8_MMA
#undef PG8_WAIT_V
#undef PG8_WAIT_L
#undef PG8_BAR
#undef PG8_SCHED
}
}
using pg8::Unit;
typedef f32x4 Acc[2][2][4][2];

#define EPI_ROWS for (int ai = 0; ai < 2; ++ai) _Pragma("unroll") for (int m = 0; m < 4; ++m)

struct EpiGateUp {
    static constexpr bool AFTER_DRAIN = false;
    bf16_t* O; const float* ss;
    __device__ __forceinline__ void operator()(const Acc& acc, const Unit& u, int wr, int wc, int fr, int fq) const {
#pragma unroll
        EPI_ROWS {
            const int row = u.pm * 256 + ai * 128 + wr * 64 + m * 16 + fr;
            const float s = inv_rms(ss[row]);
            f32x4 o[2];
#pragma unroll
            for (int n = 0; n < 2; ++n) { const f32x4 g = acc[ai][0][m][n] * s, up = acc[ai][1][m][n] * s;
#pragma unroll
                for (int j = 0; j < 4; ++j) o[n][j] = g[j] * fast_sigmoid(g[j]) * up[j]; }
            *(u32x4*)(O + (size_t)row * FF + u.pn * 128 + wc * 32 + 8 * fq) = pack8(o[0], o[1]);
        }
    }
};

template <bool WB> struct EpiRes {
    static constexpr bool AFTER_DRAIN = false;
    const float* Xin; float* Xout; bf16_t* Xb; float* rowss; float coef;
    __device__ __forceinline__ void operator()(const Acc& acc, const Unit& u, int wr, int wc, int fr, int fq) const {
#pragma unroll
        EPI_ROWS {
            const int row = u.pm * 256 + ai * 128 + wr * 64 + m * 16 + fr;
            const size_t off = (size_t)row * DM + u.pn * 256 + wc * 32 + 8 * fq;
            float ss = 0.f;
#pragma unroll
            for (int bj = 0; bj < 2; ++bj) {
                const f32x4 x0 = *(const f32x4*)(Xin + off + bj * 128), x1 = *(const f32x4*)(Xin + off + bj * 128 + 4);
                const f32x4 o0 = x0 + acc[ai][bj][m][0] * coef, o1 = x1 + acc[ai][bj][m][1] * coef;
                *(f32x4*)(Xout + off + bj * 128) = o0; *(f32x4*)(Xout + off + bj * 128 + 4) = o1;
                ss += o0[0] * o0[0] + o0[1] * o0[1] + o0[2] * o0[2] + o0[3] * o0[3] + o1[0] * o1[0] + o1[1] * o1[1] + o1[2] * o1[2] + o1[3] * o1[3];
                if (WB) *(u32x4*)(Xb + off + bj * 128) = pack8(o0, o1);
            }
            ss += __shfl_xor(ss, 16); ss += __shfl_xor(ss, 32);
            if (fq == 0) atomicAdd(rowss + row, ss);
        }
    }
};

struct EpiWin {
    static constexpr bool AFTER_DRAIN = false;
    const float* ss; bf16_t* AP; bf16_t* Q; bf16_t* Kb; bf16_t* VT; bf16_t* GS; bf16_t* GA; const float* rope; float* kmean;
    __device__ __forceinline__ void operator()(const Acc& acc, const Unit& u, int wr, int wc, int fr, int fq) const {
        const int pn = u.pn;
        if (pn < 2) {
            int pm_ = u.pm; asm volatile("" : "+s"(pm_));
#pragma unroll
            EPI_ROWS {
                const int row = pm_ * 256 + ai * 128 + wr * 64 + m * 16 + fr; const float s = inv_rms(ss[row]);
                const int b = row >> 13, tok = row & 8191, c = tok >> 5, sidx = tok & 31;
#pragma unroll
                for (int bj = 0; bj < 2; ++bj) { const int col = pn * 256 + bj * 128 + wc * 32 + 8 * fq; const int g = col >> 4, hh = col & 15;
                    *(u32x4*)(AP + (size_t)(g * 512 + b * 256 + c) * AK + sidx * 16 + hh) = pack8(acc[ai][bj][m][0] * s, acc[ai][bj][m][1] * s); }
            }
        } else if (pn < 6) {
            int pm_ = u.pm; asm volatile("" : "+s"(pm_));
            const bool isq = pn < 4;
            bf16_t* dst = isq ? Q : Kb; const float osc = isq ? QSCALE : 1.f;
            float ks[2][8];
#pragma unroll
            for (int bj = 0; bj < 2; ++bj)
#pragma unroll
                for (int e = 0; e < 8; ++e) ks[bj][e] = 0.f;
#pragma unroll
            EPI_ROWS {
                const int row = pm_ * 256 + ai * 128 + wr * 64 + m * 16 + fr; const float s = inv_rms(ss[row]) * osc;
                const int tok = row & 8191; const int i0 = (wc & 1) * 16 + 4 * fq;
                const f32x4 cs = *(const f32x4*)(rope + (size_t)tok * 32 + i0), sn = *(const f32x4*)(rope + (size_t)SEQ * 32 + (size_t)tok * 32 + i0);
#pragma unroll
                for (int bj = 0; bj < 2; ++bj) { const int head = (pn & 1) * 4 + 2 * bj + (wc >> 1);
                    const f32x4 x1 = acc[ai][bj][m][0] * s, x2 = acc[ai][bj][m][1] * s;
                    const f32x4 o1 = x1 * cs - x2 * sn, o2 = x2 * cs + x1 * sn;
                    u32x2 w1, w2; w1.x = cvt_pk_bf16(o1[0], o1[1]); w1.y = cvt_pk_bf16(o1[2], o1[3]); w2.x = cvt_pk_bf16(o2[0], o2[1]); w2.y = cvt_pk_bf16(o2[2], o2[3]);
                    bf16_t* p = isq ? dst + (size_t)row * 512 + head * 64 + i0 : dst + ((size_t)(((row >> 13) * 8 + head)) * SEQ + tok) * 64 + i0;
                    *(u32x2*)p = w1; *(u32x2*)(p + 32) = w2;
#pragma unroll
                    for (int e = 0; e < 4; ++e) { ks[bj][e] += o1[e]; ks[bj][4 + e] += o2[e]; asm volatile("" : "+v"(ks[bj][e]), "+v"(ks[bj][4 + e])); } }
                asm volatile("" ::: "memory");
            }
            if (!isq) {
                const int b = (pm_ * 256) >> 13, blk = pm_ & 31; const int i0 = (wc & 1) * 16 + 4 * fq;
#pragma unroll
                for (int bj = 0; bj < 2; ++bj) { const int head = (pn & 1) * 4 + 2 * bj + (wc >> 1);
#pragma unroll
                    for (int e = 0; e < 8; ++e) { float v = ks[bj][e]; v += __shfl_xor(v, 1); v += __shfl_xor(v, 2); v += __shfl_xor(v, 4); v += __shfl_xor(v, 8);
                        if (fr == 0) atomicAdd(kmean + (size_t)((b * 8 + head) * 32 + blk) * 64 + i0 + (e & 3) + 32 * (e >> 2), v); } }
            }
        } else if (pn < 8) {
            int pm_ = u.pm; asm volatile("" : "+s"(pm_));
#pragma unroll
            EPI_ROWS {
                const int row = pm_ * 256 + ai * 128 + wr * 64 + m * 16 + fr; const float s = inv_rms(ss[row]);
                const int b = row >> 13, tok = row & 8191;
#pragma unroll
                for (int bj = 0; bj < 2; ++bj) { const int col = (pn - 6) * 256 + bj * 128 + wc * 32 + 8 * fq; const int head = col >> 6, d0 = col & 63;
                    bf16_t* p = VT + ((size_t)(((b * 8 + head) * 32 + (tok >> 8)) * 64 + d0)) * 256 + (tok & 255);
                    const f32x4 v0 = acc[ai][bj][m][0] * s, v1 = acc[ai][bj][m][1] * s;
#pragma unroll
                    for (int e = 0; e < 4; ++e) { p[e * 256] = (bf16_t)(cvt_pk_bf16(v0[e], 0.f) & 0xffffu); p[(4 + e) * 256] = (bf16_t)(cvt_pk_bf16(v1[e], 0.f) & 0xffffu); } }
                asm volatile("" ::: "memory");
            }
        } else {
            int pm_ = u.pm; asm volatile("" : "+s"(pm_));
            bf16_t* dst = pn < 12 ? GS : GA; const int cb = ((pn - 8) & 3) * 256;
#pragma unroll
            EPI_ROWS {
                const int row = pm_ * 256 + ai * 128 + wr * 64 + m * 16 + fr; const float s = inv_rms(ss[row]);
#pragma unroll
                for (int bj = 0; bj < 2; ++bj) { const int col = cb + bj * 128 + wc * 32 + 8 * fq;
                    *(u32x4*)(dst + (size_t)row * DM + col) = pack8(sigmoid4(acc[ai][bj][m][0] * s), sigmoid4(acc[ai][bj][m][1] * s)); }
            }
        }
    }
};


template <bool IN_BF16> struct EpiResB {
    static constexpr bool AFTER_DRAIN = false;
    const void* Xin; bf16_t* Xb; float* rowss; float coef;
    __device__ __forceinline__ void operator()(const Acc& acc, const Unit& u, int wr, int wc, int fr, int fq) const {
#pragma unroll
        EPI_ROWS {
            const int row = u.pm * 256 + ai * 128 + wr * 64 + m * 16 + fr;
            const size_t off = (size_t)row * DM + u.pn * 256 + wc * 32 + 8 * fq;
            float ss = 0.f;
#pragma unroll
            for (int bj = 0; bj < 2; ++bj) {
                f32x4 x0, x1;
                if (IN_BF16) unpack8(*(const u32x4*)((const bf16_t*)Xin + off + bj * 128), x0, x1);
                else { x0 = *(const f32x4*)((const float*)Xin + off + bj * 128); x1 = *(const f32x4*)((const float*)Xin + off + bj * 128 + 4); }
                const f32x4 o0 = x0 + acc[ai][bj][m][0] * coef, o1 = x1 + acc[ai][bj][m][1] * coef;
                ss += o0[0] * o0[0] + o0[1] * o0[1] + o0[2] * o0[2] + o0[3] * o0[3] + o1[0] * o1[0] + o1[1] * o1[1] + o1[2] * o1[2] + o1[3] * o1[3];
                *(u32x4*)(Xb + off + bj * 128) = pack8(o0, o1);
            }
            ss += __shfl_xor(ss, 16); ss += __shfl_xor(ss, 32);
            if (fq == 0) atomicAdd(rowss + row, ss);
        }
    }
};

struct EpiResF {
    static constexpr bool AFTER_DRAIN = false;
    const bf16_t* Xin; float* Xout; float* rowss; float coef;
    __device__ __forceinline__ void operator()(const Acc& acc, const Unit& u, int wr, int wc, int fr, int fq) const {
#pragma unroll
        EPI_ROWS {
            const int row = u.pm * 256 + ai * 128 + wr * 64 + m * 16 + fr;
            const size_t off = (size_t)row * DM + u.pn * 256 + wc * 32 + 8 * fq;
            float ss = 0.f;
#pragma unroll
            for (int bj = 0; bj < 2; ++bj) {
                f32x4 x0, x1; unpack8(*(const u32x4*)(Xin + off + bj * 128), x0, x1);
                const f32x4 o0 = x0 + acc[ai][bj][m][0] * coef, o1 = x1 + acc[ai][bj][m][1] * coef;
                *(f32x4*)(Xout + off + bj * 128) = o0; *(f32x4*)(Xout + off + bj * 128 + 4) = o1;
                ss += o0[0] * o0[0] + o0[1] * o0[1] + o0[2] * o0[2] + o0[3] * o0[3] + o1[0] * o1[0] + o1[1] * o1[1] + o1[2] * o1[2] + o1[3] * o1[3];
            }
            ss += __shfl_xor(ss, 16); ss += __shfl_xor(ss, 32);
            if (fq == 0) atomicAdd(rowss + row, ss);
        }
    }
};

struct EpiResNorm {
    static constexpr bool AFTER_DRAIN = true;
    const bf16_t* Xin; float* Xout; float* rowss; unsigned* pcnt; const float* gain; float coef;
    __device__ __forceinline__ void operator()(Acc&, const Unit&, int, int, int, int) const {}
    __device__ __forceinline__ void fused(Acc& acc, const Unit& u, int wr, int wc, int fr, int fq) const {
#pragma unroll
        EPI_ROWS {
            const int row = u.pm * 256 + ai * 128 + wr * 64 + m * 16 + fr;
            const size_t off = (size_t)row * DM + u.pn * 256 + wc * 32 + 8 * fq;
            float ss = 0.f;
#pragma unroll
            for (int bj = 0; bj < 2; ++bj) {
                f32x4 x0, x1; unpack8(*(const u32x4*)(Xin + off + bj * 128), x0, x1);
                const f32x4 o0 = x0 + acc[ai][bj][m][0] * coef, o1 = x1 + acc[ai][bj][m][1] * coef;
                acc[ai][bj][m][0] = o0; acc[ai][bj][m][1] = o1;
                ss += o0[0] * o0[0] + o0[1] * o0[1] + o0[2] * o0[2] + o0[3] * o0[3] + o1[0] * o1[0] + o1[1] * o1[1] + o1[2] * o1[2] + o1[3] * o1[3];
            }
            ss += __shfl_xor(ss, 16); ss += __shfl_xor(ss, 32);
            if (fq == 0) atomicAdd(rowss + row, ss);
        }
        asm volatile("s_waitcnt vmcnt(0)" ::: "memory");
        __syncthreads();
        if (tidx() == 0) {
            __builtin_amdgcn_fence(__ATOMIC_RELEASE, "agent");
            asm volatile("s_waitcnt vmcnt(0)" ::: "memory");
            __hip_atomic_fetch_add(pcnt + u.pm * 64, 1u, __ATOMIC_RELAXED, __HIP_MEMORY_SCOPE_AGENT);
            unsigned sp = 0;
            while (__hip_atomic_load(pcnt + u.pm * 64, __ATOMIC_RELAXED, __HIP_MEMORY_SCOPE_AGENT) < 4u) { __builtin_amdgcn_s_sleep(1); if (++sp > (1u << 22)) break; }
            __builtin_amdgcn_fence(__ATOMIC_ACQUIRE, "agent");
            asm volatile("s_waitcnt vmcnt(0)" ::: "memory");
        }
        __syncthreads();
#pragma unroll
        EPI_ROWS {
            const int row = u.pm * 256 + ai * 128 + wr * 64 + m * 16 + fr;
            const size_t off = (size_t)row * DM + u.pn * 256 + wc * 32 + 8 * fq;
            const float s = inv_rms(__hip_atomic_load(rowss + row, __ATOMIC_RELAXED, __HIP_MEMORY_SCOPE_AGENT));
#pragma unroll
            for (int bj = 0; bj < 2; ++bj) { const int col = u.pn * 256 + bj * 128 + wc * 32 + 8 * fq;
                const f32x4 g0 = *(const f32x4*)(gain + col), g1 = *(const f32x4*)(gain + col + 4);
                *(f32x4*)(Xout + off + bj * 128) = acc[ai][bj][m][0] * s * g0; *(f32x4*)(Xout + off + bj * 128 + 4) = acc[ai][bj][m][1] * s * g1; }
        }
    }
};

struct EpiS {
    static constexpr bool AFTER_DRAIN = false;
    float* S;
    __device__ __forceinline__ void operator()(const Acc& acc, const Unit& u, int wr, int wc, int fr, int fq) const {
#pragma unroll
        EPI_ROWS {
            const int row = u.pm * 256 + ai * 128 + wr * 64 + m * 16 + fr;
            float* p = S + (size_t)row * 128 + wc * 32 + 8 * fq; *(f32x4*)p = acc[ai][0][m][0]; *(f32x4*)(p + 4) = acc[ai][0][m][1];
        }
    }
};
struct EpiY {
    static constexpr bool AFTER_DRAIN = false;
    bf16_t* Y;
    __device__ __forceinline__ void operator()(const Acc& acc, const Unit& u, int wr, int wc, int fr, int fq) const {
#pragma unroll
        EPI_ROWS {
            const int row = u.pm * 256 + ai * 128 + wr * 64 + m * 16 + fr; const int g = row >> 9, b = (row >> 8) & 1, c = row & 255;
#pragma unroll
            for (int bj = 0; bj < 2; ++bj) { const int n = (u.pn & 1) * 256 + bj * 128 + wc * 32 + 8 * fq; const int t = n >> 4, hh = n & 15;
                f32x4 o0, o1;
#pragma unroll
                for (int e = 0; e < 4; ++e) { o0[e] = gelu_tanh(acc[ai][bj][m][0][e]); o1[e] = gelu_tanh(acc[ai][bj][m][1][e]); }
                *(u32x4*)(Y + (size_t)(b * SEQ + c * TCH + t) * 512 + g * 16 + hh) = pack8(o0, o1); }
        }
    }
};
struct EpiGlu {
    static constexpr bool AFTER_DRAIN = false;
    const bf16_t* Y; const float* bias; bf16_t* O;
    __device__ __forceinline__ void operator()(const Acc& acc, const Unit& u, int wr, int wc, int fr, int fq) const {
#pragma unroll
        EPI_ROWS {
            const int row = u.pm * 256 + ai * 128 + wr * 64 + m * 16 + fr;
#pragma unroll
            for (int bj = 0; bj < 2; ++bj) { const int col = u.pn * 256 + bj * 128 + wc * 32 + 8 * fq;
                const f32x4 b0 = *(const f32x4*)(bias + col), b1 = *(const f32x4*)(bias + col + 4);
                f32x4 y0, y1; unpack8(*(const u32x4*)(Y + (size_t)row * 512 + col), y0, y1);
                *(u32x4*)(O + (size_t)row * 512 + col) = pack8(y0 * sigmoid4(acc[ai][bj][m][0] + b0), y1 * sigmoid4(acc[ai][bj][m][1] + b1)); }
        }
    }
};
template <int MODE> struct EpiBranch {
    static constexpr bool AFTER_DRAIN = false;
    bf16_t* G1; bf16_t* G2;
    __device__ __forceinline__ void operator()(const Acc& acc, const Unit& u, int wr, int wc, int fr, int fq) const {
#pragma unroll
        EPI_ROWS {
            const int row = u.pm * 256 + ai * 128 + wr * 64 + m * 16 + fr;
#pragma unroll
            for (int bj = 0; bj < 2; ++bj) { const size_t off = (size_t)row * DM + u.pn * 256 + bj * 128 + wc * 32 + 8 * fq;
                f32x4 a0, a1; unpack8(*(const u32x4*)(G1 + off), a0, a1);
                if (MODE == 0) { *(u32x4*)(G1 + off) = pack8(a0 * acc[ai][bj][m][0], a1 * acc[ai][bj][m][1]); }
                else { f32x4 g0, g1; unpack8(*(const u32x4*)(G2 + off), g0, g1); *(u32x4*)(G2 + off) = pack8(a0 + g0 * acc[ai][bj][m][0], a1 + g1 * acc[ai][bj][m][1]); } }
        }
    }
};

struct WJob { const float* s0; const float* s1; const float* gain; bf16_t* dst; int K, ld, ndst, mode; };
__device__ __forceinline__ WJob get_job(ArgsP a, int j) {
    unsigned char* ws = a->ws; WJob J;
    switch (j) {
    case 0: J = WJob{a->in[2], a->in[3], a->in[1], (bf16_t*)(ws + WS_W1GU), 1024, 2816, 5632, 1}; break;
    case 1: J = WJob{a->in[4], a->in[4], nullptr, (bf16_t*)(ws + WS_W1D), 2816, 1024, 1024, 0}; break;
    case 2: J = WJob{a->in[6], a->in[6], a->in[5], (bf16_t*)(ws + WS_WIN), 1024, 4096, 4096, 2}; break;
    case 3: J = WJob{a->in[15], a->in[15], nullptr, (bf16_t*)(ws + WS_WGLU), 512, 512, 512, 0}; break;
    case 4: J = WJob{a->in[17], a->in[17], nullptr, (bf16_t*)(ws + WS_WBS), 512, 1024, 1024, 0}; break;
    case 5: J = WJob{a->in[18], a->in[18], nullptr, (bf16_t*)(ws + WS_WBA), 512, 1024, 1024, 0}; break;
    case 6: J = WJob{a->in[19], a->in[19], nullptr, (bf16_t*)(ws + WS_WOUT), 1024, 1024, 1024, 0}; break;
    case 7: J = WJob{a->in[21], a->in[22], a->in[20], (bf16_t*)(ws + WS_W2GU), 1024, 2816, 5632, 1}; break;
    default: J = WJob{a->in[23], a->in[23], nullptr, (bf16_t*)(ws + WS_W2D), 2816, 1024, 1024, 0}; break;
    }
    return J;
}
__device__ __forceinline__ void wconv_item(const WJob& J, int item) {
    const int nkb = J.K >> 6, kb = item % nkb, nb = item / nkb;
    const int tid = tidx(), lane = tid & 63, wave = tid >> 6;
    const int n = nb * 256 + lane * 4, k0 = kb * 64 + wave * 8;
    const float* src = J.s0; int sc = n;
    if (J.mode == 1) { const int tl = n >> 8, wi = n & 255; if (wi >= 128) src = J.s1; sc = tl * 128 + (wi & 127); }
    else if (J.mode == 2) { if (n >= 512 && n < 1536) { const int t_ = n & 255, bj = t_ >> 7, wc = (t_ >> 5) & 3, fq = (t_ >> 3) & 3, n2 = (t_ >> 2) & 1;
            sc = (n & ~255) + 64 * (2 * bj + (wc >> 1)) + (wc & 1) * 16 + 4 * fq + 32 * n2; } }
    f32x4 v[8];
#pragma unroll
    for (int e = 0; e < 8; ++e) v[e] = *(const f32x4*)(src + (size_t)(k0 + e) * J.ld + sc);
    if (J.gain) {
#pragma unroll
        for (int e = 0; e < 8; ++e) v[e] = v[e] * J.gain[k0 + e]; }
#pragma unroll
    for (int j = 0; j < 4; ++j) { u32x4 w; w.x = cvt_pk_bf16(v[0][j], v[1][j]); w.y = cvt_pk_bf16(v[2][j], v[3][j]); w.z = cvt_pk_bf16(v[4][j], v[5][j]); w.w = cvt_pk_bf16(v[6][j], v[7][j]);
        *(u32x4*)(J.dst + (size_t)(n + j) * J.K + k0) = w; }
}

__device__ __forceinline__ void ssm_precompute(LAS unsigned char* lds, ArgsP a, int g, int hsel) {
    LAS float* pwr = (LAS float*)lds; LAS float* pwi = pwr + 33 * 64; LAS float* Bbr = pwi + 33 * 64; LAS float* Bbi = Bbr + 1024;
    LAS float* Cr = Bbi + 1024; LAS float* Ci = Cr + 1024; LAS float* Kt = Ci + 1024;
    const float* a_re = a->in[7]; const float* a_im = a->in[8]; const float* b_re = a->in[9]; const float* b_im = a->in[10];
    const float* c_re = a->in[11]; const float* c_im = a->in[12]; const float* dsk = a->in[13]; const float* log_dt = a->in[14];
    bf16_t* BTY = (bf16_t*)(a->ws + WS_BTY); bf16_t* BTS = (bf16_t*)(a->ws + WS_BTS); float* aT = (float*)(a->ws + WS_AT);
    const int tid = tidx();
    const double dt = exp_d((double)log_dt[g]);
    for (int it = tid; it < 33 * 64; it += 512) { const int tau = it >> 6, p = it & 63; const double ar = a_re[g * 64 + p], ai = a_im[g * 64 + p];
        const double mag = exp_d(tau * ar * dt); double sn, cs; sincos_d(tau * ai * dt, sn, cs); pwr[it] = (float)(mag * cs); pwi[it] = (float)(mag * sn);
        if (tau == 32 && hsel == 0) { aT[(g * 64 + p) * 2] = (float)(mag * cs); aT[(g * 64 + p) * 2 + 1] = (float)(mag * sn); } }
    for (int it = tid; it < 1024; it += 512) { const int p = it >> 4, hh = it & 15; const double ar = a_re[g * 64 + p], ai = a_im[g * 64 + p];
        const double mag = exp_d(ar * dt); double sn, cs; sincos_d(ai * dt, sn, cs); const double nr = mag * cs - 1.0, ni = mag * sn, den = ar * ar + ai * ai;
        const double fr = (nr * ar + ni * ai) / den, fi = (ni * ar - nr * ai) / den; const double br = b_re[(g * 64 + p) * 16 + hh], bi = b_im[(g * 64 + p) * 16 + hh];
        Bbr[it] = (float)(fr * br - fi * bi); Bbi[it] = (float)(fr * bi + fi * br); }
    for (int it = tid; it < 1024; it += 512) { Cr[it] = c_re[g * 1024 + it]; Ci[it] = c_im[g * 1024 + it]; }
    __syncthreads();
    { const int hp = tid & 15, tau = tid >> 4;
      float kacc[16];
#pragma unroll
      for (int h = 0; h < 16; ++h) kacc[h] = 0.f;
      for (int p = 0; p < 64; ++p) { const float pr = pwr[tau * 64 + p], pi = pwi[tau * 64 + p], br = Bbr[p * 16 + hp], bi = Bbi[p * 16 + hp];
          const float er = pr * br - pi * bi, ei = pr * bi + pi * br;
#pragma unroll
          for (int h = 0; h < 16; ++h) kacc[h] += Cr[h * 64 + p] * er - Ci[h * 64 + p] * ei; }
#pragma unroll
      for (int h = 0; h < 16; ++h) { float v = kacc[h]; if (tau == 0 && h == hp) v += dsk[g * 16 + h]; Kt[(tau * 16 + h) * 16 + hp] = v; } }
    __syncthreads();
    for (int it = tid; it < 256 * 80; it += 512) { const int nl = it / 80, o = it - nl * 80, n = hsel * 256 + nl, t = n >> 4, h = n & 15, k0 = o * 8; f32x4 v0, v1;
        if (k0 < 512) { const int s = k0 >> 4, hp0 = k0 & 15;
#pragma unroll
            for (int e = 0; e < 4; ++e) { v0[e] = (s <= t) ? Kt[((t - s) * 16 + h) * 16 + hp0 + e] : 0.f; v1[e] = (s <= t) ? Kt[((t - s) * 16 + h) * 16 + hp0 + 4 + e] : 0.f; } }
        else { const bool im = k0 >= 576; const int p0 = k0 - (im ? 576 : 512);
#pragma unroll
            for (int e = 0; e < 8; ++e) { const int p = p0 + e; const float cr = Cr[h * 64 + p], ci = Ci[h * 64 + p], pr = pwr[(t + 1) * 64 + p], pi = pwi[(t + 1) * 64 + p];
                const float v = im ? -(cr * pi + ci * pr) : (cr * pr - ci * pi); if (e < 4) v0[e] = v; else v1[e - 4] = v; } }
        *(u32x4*)(BTY + ((size_t)(g * 512 + n)) * AK + k0) = pack8(v0, v1); }
    for (int it = tid; it < 128 * 64; it += 512) { const int n = hsel * 128 + (it >> 6), o = it & 63, k0 = o * 8, s = k0 >> 4, hp0 = k0 & 15; f32x4 v0 = {0.f, 0.f, 0.f, 0.f}, v1 = v0;
        if (n < 128) { const int p = n & 63, tau = 31 - s; const float pr = pwr[tau * 64 + p], pi = pwi[tau * 64 + p];
#pragma unroll
            for (int e = 0; e < 8; ++e) { const float br = Bbr[p * 16 + hp0 + e], bi = Bbi[p * 16 + hp0 + e]; const float v = (n < 64) ? (pr * br - pi * bi) : (pr * bi + pi * br);
                if (e < 4) v0[e] = v; else v1[e - 4] = v; } }
        *(u32x4*)(BTS + ((size_t)(g * 256 + n)) * 512 + k0) = pack8(v0, v1); }
    __syncthreads();
}

__device__ __forceinline__ void p0_prologue(LAS unsigned char* lds, ArgsP a) {
    const int tid = tidx(), lane = tid & 63, wave = tid >> 6, G = gridDim.x, bx = blockIdx.x;
    unsigned char* ws = a->ws;
    const bool split = G >= 128;
    if (!split || bx < 64) for (int u = bx; u < 64; u += G) ssm_precompute(lds, a, u >> 1, u & 1);
    if (split && bx < 64) return;
    const int nw = split ? G - 64 : G, wk = split ? bx - 64 : bx;
    { float* z1 = (float*)(ws + WS_RS1); for (int i = wk * 512 + tid; i < 3 * 16384; i += nw * 512) z1[i] = 0.f;
      float* z2 = (float*)(ws + WS_KMEAN); for (int i = wk * 512 + tid; i < 32768; i += nw * 512) z2[i] = 0.f;
      unsigned* z3 = (unsigned*)(ws + WS_PCNT); for (int i = wk * 512 + tid; i < 64 * 64 + 128; i += nw * 512) z3[i] = 0u; }
    { int gi = wk, base = 0; const int jend = (G == 256) ? 2 : 9;
      for (int j = 0; j < jend; ++j) { const WJob J = get_job(a, j); const int cnt = (J.K >> 6) * (J.ndst >> 8);
          while (gi < base + cnt) { wconv_item(J, gi - base); gi += nw; } base += cnt; } }
    { const float* x = a->in[0]; bf16_t* xb = (bf16_t*)(ws + WS_XB); float* rs0 = (float*)(ws + WS_RS0);
      for (int row = (wk * 8 + wave) * 2; row < M; row += nw * 16) { const f32x4* xr = (const f32x4*)(x + (size_t)row * DM); float ss0 = 0.f, ss1 = 0.f; f32x4 v[8];
#pragma unroll
          for (int i = 0; i < 8; ++i) v[i] = xr[lane + 64 * i];
#pragma unroll
          for (int i = 0; i < 8; ++i) { const float q = v[i][0] * v[i][0] + v[i][1] * v[i][1] + v[i][2] * v[i][2] + v[i][3] * v[i][3]; if (i < 4) ss0 += q; else ss1 += q;
              u32x2 w; w.x = cvt_pk_bf16(v[i][0], v[i][1]); w.y = cvt_pk_bf16(v[i][2], v[i][3]); *(u32x2*)(xb + (size_t)row * DM + (lane + 64 * i) * 4) = w; }
#pragma unroll
          for (int o = 32; o > 0; o >>= 1) { ss0 += __shfl_xor(ss0, o); ss1 += __shfl_xor(ss1, o); }
          if (lane == 0) { rs0[row] = ss0; rs0[row + 1] = ss1; } } }
    { float* rope = (float*)(ws + WS_ROPE);
      for (int i = wk * 512 + tid; i < SEQ * 32; i += nw * 512) { const int pos = i >> 5, fi = i & 31;
          const double invf = exp_d(-9.210340371976184 * (double)fi * (1.0 / 32.0)); double sn, cs; sincos_d((double)pos * invf, sn, cs);
          rope[i] = (float)cs; rope[SEQ * 32 + i] = (float)sn; } }
}

#define MFMA32(a, b, c) __builtin_amdgcn_mfma_f32_32x32x16_bf16((a), (b), (c), 0, 0, 0)

__device__ __forceinline__ void moba_assign(const LAS unsigned* mk, int r, int& ql, bool& valid, int& ntile) {
    unsigned tot = 0, word = 0, base = 0; int wsel = 0; bool found = false;
#pragma unroll
    for (int ww = 0; ww < 8; ++ww) { const unsigned m = mk[ww]; const unsigned pc = __popc(m); if (!found && (unsigned)r < tot + pc) { word = m; base = tot; wsel = ww; found = true; } tot += pc; }
    valid = found; ntile = (int)((tot + 31u) >> 5);
    int k = found ? r - (int)base : 0, pos = 0;
#pragma unroll
    for (int sft = 16; sft >= 1; sft >>= 1) { const int c = __popc(word & (((1u << sft) - 1u) << pos)); if (k >= c) { k -= c; pos += sft; } }
    ql = found ? wsel * 32 + (pos & 31) : 0;
}
__device__ __forceinline__ void attn_unit_h(LAS unsigned char* lds, const bf16_t* Q, const bf16_t* Kb, const bf16_t* VT, const float* kmean, bf16_t* O, int b, int h, int qb) {
    const int tid = tidx(), w = tid >> 6, lane = tid & 63, qi = lane & 31, hf = lane >> 5;
    LAS bf16_t* Kt = (LAS bf16_t*)lds;
    LAS bf16_t* Vt = (LAS bf16_t*)(lds + 36864);
    LAS float* km = (LAS float*)(lds + 70656);
    LAS unsigned* msk = (LAS unsigned*)(lds + 78592);
    LAS float* stt = (LAS float*)(lds + 79616);
    const int cur = qb;
    for (int i = tid; i < cur * 64; i += 512) km[i] = kmean[(size_t)((b * 8 + h) * 32) * 64 + i];
    const int row0 = b * SEQ + qb * 256, qown = 32 * w + qi;
    bf16x8 qf[4];
#pragma unroll
    for (int st = 0; st < 4; ++st) qf[st] = *(const bf16x8*)(Q + (size_t)(row0 + qown) * 512 + h * 64 + 16 * st + 8 * hf);
    const int sr = tid >> 3, sc = (tid & 7) * 8;
    const bf16_t* kg = Kb + ((size_t)(b * 8 + h) * SEQ + sr) * 64 + sc;
    const bf16_t* vg = VT + ((size_t)((b * 8 + h) * 32) * 64 + sr) * 256 + sc;
    u32x4 kreg[4], vreg[4];
    { const int kb0 = qb * 256;
#pragma unroll
      for (int p = 0; p < 4; ++p) { kreg[p] = *(const u32x4*)(kg + (size_t)(kb0 + 64 * p) * 64); vreg[p] = *(const u32x4*)(vg + (size_t)(kb0 >> 8) * 16384 + 64 * p); } }
    __syncthreads();
    int i0 = 0, i1 = 1, i2 = 2;
    if (cur > 3) {
        float qv[32];
#pragma unroll
        for (int st = 0; st < 4; ++st)
#pragma unroll
            for (int e = 0; e < 8; ++e) qv[st * 8 + e] = __uint_as_float(((unsigned)(unsigned short)qf[st][e]) << 16);
        float b0 = -3e38f, b1 = -3e38f, b2 = -3e38f;
        for (int j = 0; j < cur; ++j) { float g = 0.f;
#pragma unroll
            for (int st = 0; st < 4; ++st) { const f32x4 k0 = *(const LAS f32x4*)(km + j * 64 + 16 * st + 8 * hf), k1 = *(const LAS f32x4*)(km + j * 64 + 16 * st + 8 * hf + 4);
#pragma unroll
                for (int e = 0; e < 4; ++e) { g += qv[st * 8 + e] * k0[e]; g += qv[st * 8 + 4 + e] * k1[e]; } }
            g += __shfl_xor(g, 32);
            if (g > b0) { b2 = b1; i2 = i1; b1 = b0; i1 = i0; b0 = g; i0 = j; } else if (g > b1) { b2 = b1; i2 = i1; b1 = g; i1 = j; } else if (g > b2) { b2 = g; i2 = j; } }
    }
    for (int j = 0; j < cur; ++j) { const bool sj = (cur <= 3) || j == i0 || j == i1 || j == i2; const unsigned long long bal = __ballot(sj); if (lane == 0) msk[j * 8 + w] = (unsigned)bal; }
#pragma unroll
    for (int p = 0; p < 4; ++p) { *(LAS u32x4*)(Kt + (sr + 64 * p) * 72 + sc) = kreg[p]; *(LAS u32x4*)(Vt + sr * 264 + sc + 64 * p) = vreg[p]; }
    __syncthreads();
    f32x16 o0, o1;
#pragma unroll
    for (int e = 0; e < 16; ++e) { o0[e] = 0.f; o1[e] = 0.f; }
    float mrun = NEGBIG, lrun = 0.f;
    const int krow = (qi & 19) | ((qi & 4) << 1) | ((qi & 8) >> 1);
    int qln = 0, ntn = 0; bool validn = false; bf16x8 gqA[4], gqB[4];
    if (cur > 0) { moba_assign(msk, 32 * w + qi, qln, validn, ntn); if (ntn <= 4) moba_assign(msk, 32 * (w >> 1) + qi, qln, validn, ntn);
#pragma unroll
        for (int st = 0; st < 4; ++st) gqA[st] = *(const bf16x8*)(Q + (size_t)(row0 + qln) * 512 + h * 64 + 16 * st + 8 * hf); }
    int qlc = qown, ntc = 8; bool validc = true; bool pairm = false, second = false; int tq = w;
    { const int blk0 = 0;
    {
        const bool own = true;
        if (blk0 < cur) { const int kb1 = blk0 * 256;
#pragma unroll
            for (int p = 0; p < 4; ++p) { kreg[p] = *(const u32x4*)(kg + (size_t)(kb1 + 64 * p) * 64); vreg[p] = *(const u32x4*)(vg + (size_t)(kb1 >> 8) * 16384 + 64 * p); } }
        if (!own) {
            qlc = qln; ntc = ntn; validc = validn;
            if (blk0 < cur) { moba_assign(msk + blk0 * 8, 32 * w + qi, qln, validn, ntn); if (ntn <= 4) moba_assign(msk + blk0 * 8, 32 * (w >> 1) + qi, qln, validn, ntn);
#pragma unroll
                for (int st = 0; st < 4; ++st) gqA[st] = *(const bf16x8*)(Q + (size_t)(row0 + qln) * 512 + h * 64 + 16 * st + 8 * hf); }
            pairm = ntc <= 4; tq = pairm ? (w >> 1) : w; second = pairm && (w & 1);
            if (second) {
#pragma unroll
                for (int e = 0; e < 16; ++e) { o0[e] = 0.f; o1[e] = 0.f; }
                mrun = NEGBIG; lrun = 0.f;
            } else if (tq < ntc) { const LAS float* sp = stt + qlc * 68;
#pragma unroll
                for (int g4 = 0; g4 < 4; ++g4) { const f32x4 a = *(const LAS f32x4*)(sp + 8 * g4 + 4 * hf), c = *(const LAS f32x4*)(sp + 32 + 8 * g4 + 4 * hf);
#pragma unroll
                    for (int e = 0; e < 4; ++e) { o0[4 * g4 + e] = a[e]; o1[4 * g4 + e] = c[e]; } }
                mrun = sp[64]; lrun = hf == 0 ? sp[65] : 0.f; }
        }
        const bool allowed = own || validc;
        const int tlo = (!own && second) ? 2 : 0, thi = (!own && pairm && !second) ? 2 : 4;
        for (int ti = tlo; ti < thi; ++ti) {
            bool active, partial = false;
            if (own) { const int klo = 64 * ti, qlo = 32 * w; active = !(klo > qlo + 31); partial = (klo + 63 > qlo); }
            else active = (tq < ntc);
            if (active) {
                f32x16 s0, s1;
#pragma unroll
                for (int e = 0; e < 16; ++e) { s0[e] = 0.f; s1[e] = 0.f; }
                const LAS bf16_t* kt = Kt + (64 * ti) * 72;
#pragma unroll
                for (int st = 0; st < 4; ++st) { const bf16x8 a0 = *(const LAS bf16x8*)(kt + krow * 72 + 16 * st + 8 * hf), a1 = *(const LAS bf16x8*)(kt + (32 + krow) * 72 + 16 * st + 8 * hf);
                    s0 = MFMA32(a0, qf[st], s0); s1 = MFMA32(a1, qf[st], s1); }
                if (partial) { const int qrel = 32 * w + qi - 64 * ti;
#pragma unroll
                    for (int e = 0; e < 16; ++e) { const int ko = 16 * (e >> 3) + 8 * hf + (e & 7); if (ko > qrel) s0[e] = NEGBIG; if (ko + 32 > qrel) s1[e] = NEGBIG; } }
                float mx = s0[0];
#pragma unroll
                for (int e = 1; e < 16; ++e) mx = fmaxf(mx, s0[e]);
#pragma unroll
                for (int e = 0; e < 16; ++e) mx = fmaxf(mx, s1[e]);
                if (!allowed) mx = NEGBIG;
                mx = fmaxf(mx, __shfl_xor(mx, 32));
                const bool need = mx > mrun + 40.f;
                if (__ballot(need) != 0ull) {
                    const float mn = need ? mx : mrun, alpha = __builtin_amdgcn_exp2f(mrun - mn); mrun = mn; lrun *= alpha;
#pragma unroll
                    for (int e = 0; e < 16; ++e) { o0[e] *= alpha; o1[e] *= alpha; }
                }
                const float msub = allowed ? mrun : 1e30f;
                f32x2 ps2 = {0.f, 0.f};
#pragma unroll
                for (int e = 0; e < 16; e += 2) { f32x2 d0 = {s0[e], s0[e + 1]}, d1 = {s1[e], s1[e + 1]}; d0 = d0 - msub; d1 = d1 - msub;
                    s0[e] = __builtin_amdgcn_exp2f(d0.x); s0[e + 1] = __builtin_amdgcn_exp2f(d0.y); s1[e] = __builtin_amdgcn_exp2f(d1.x); s1[e + 1] = __builtin_amdgcn_exp2f(d1.y);
                    ps2 = ps2 + (f32x2){s0[e], s0[e + 1]}; ps2 = ps2 + (f32x2){s1[e], s1[e + 1]}; }
                lrun += ps2.x + ps2.y;
                const LAS bf16_t* vt = Vt + 64 * ti;
#pragma unroll
                for (int kh = 0; kh < 2; ++kh)
#pragma unroll
                    for (int s = 0; s < 2; ++s) {
                        union { u32x4 u; bf16x8 v; } pf;
                        if (kh == 0) { pf.u.x = cvt_pk_bf16(s0[8 * s], s0[8 * s + 1]); pf.u.y = cvt_pk_bf16(s0[8 * s + 2], s0[8 * s + 3]); pf.u.z = cvt_pk_bf16(s0[8 * s + 4], s0[8 * s + 5]); pf.u.w = cvt_pk_bf16(s0[8 * s + 6], s0[8 * s + 7]); }
                        else { pf.u.x = cvt_pk_bf16(s1[8 * s], s1[8 * s + 1]); pf.u.y = cvt_pk_bf16(s1[8 * s + 2], s1[8 * s + 3]); pf.u.z = cvt_pk_bf16(s1[8 * s + 4], s1[8 * s + 5]); pf.u.w = cvt_pk_bf16(s1[8 * s + 6], s1[8 * s + 7]); }
                        const bf16x8 v0 = *(const LAS bf16x8*)(vt + qi * 264 + 32 * kh + 16 * s + 8 * hf), v1 = *(const LAS bf16x8*)(vt + (32 + qi) * 264 + 32 * kh + 16 * s + 8 * hf);
                        o0 = MFMA32(v0, pf.v, o0); o1 = MFMA32(v1, pf.v, o1);
                    }
            }
        }
        if (own || (!second && tq < ntc && validc)) {
            const float lt = lrun + __shfl_xor(lrun, 32);
            LAS float* sp = stt + qlc * 68;
#pragma unroll
            for (int g4 = 0; g4 < 4; ++g4) { f32x4 a, c;
#pragma unroll
                for (int e = 0; e < 4; ++e) { a[e] = o0[4 * g4 + e]; c[e] = o1[4 * g4 + e]; }
                *(LAS f32x4*)(sp + 8 * g4 + 4 * hf) = a; *(LAS f32x4*)(sp + 32 + 8 * g4 + 4 * hf) = c; }
            if (hf == 0) { sp[64] = mrun; sp[65] = lt; }
        }
        __syncthreads();
        if (!own && second && tq < ntc && validc) {
            const float lB = lrun + __shfl_xor(lrun, 32);
            LAS float* sp = stt + qlc * 68;
            const float mA = sp[64], lA = sp[65], mM = fmaxf(mA, mrun), ca = __builtin_amdgcn_exp2f(mA - mM), cb = __builtin_amdgcn_exp2f(mrun - mM);
#pragma unroll
            for (int g4 = 0; g4 < 4; ++g4) { f32x4 x = *(const LAS f32x4*)(sp + 8 * g4 + 4 * hf), y = *(const LAS f32x4*)(sp + 32 + 8 * g4 + 4 * hf);
#pragma unroll
                for (int e = 0; e < 4; ++e) { x[e] = x[e] * ca + o0[4 * g4 + e] * cb; y[e] = y[e] * ca + o1[4 * g4 + e] * cb; }
                *(LAS f32x4*)(sp + 8 * g4 + 4 * hf) = x; *(LAS f32x4*)(sp + 32 + 8 * g4 + 4 * hf) = y; }
            if (hf == 0) { sp[64] = mM; sp[65] = lA * ca + lB * cb; }
        }
        if (blk0 < cur) {
#pragma unroll
            for (int p = 0; p < 4; ++p) { *(LAS u32x4*)(Kt + (sr + 64 * p) * 72 + sc) = kreg[p]; *(LAS u32x4*)(Vt + sr * 264 + sc + 64 * p) = vreg[p]; }
            __syncthreads();
        }
        }
    }
    for (int blk = 1; blk <= cur; blk += 2) {
    {
        const bool own = false;
        if (blk < cur) { const int kb1 = blk * 256;
#pragma unroll
            for (int p = 0; p < 4; ++p) { kreg[p] = *(const u32x4*)(kg + (size_t)(kb1 + 64 * p) * 64); vreg[p] = *(const u32x4*)(vg + (size_t)(kb1 >> 8) * 16384 + 64 * p); } }
        if (!own) {
            qlc = qln; ntc = ntn; validc = validn;
            if (blk < cur) { moba_assign(msk + blk * 8, 32 * w + qi, qln, validn, ntn); if (ntn <= 4) moba_assign(msk + blk * 8, 32 * (w >> 1) + qi, qln, validn, ntn);
#pragma unroll
                for (int st = 0; st < 4; ++st) gqB[st] = *(const bf16x8*)(Q + (size_t)(row0 + qln) * 512 + h * 64 + 16 * st + 8 * hf); }
            pairm = ntc <= 4; tq = pairm ? (w >> 1) : w; second = pairm && (w & 1);
            if (second) {
#pragma unroll
                for (int e = 0; e < 16; ++e) { o0[e] = 0.f; o1[e] = 0.f; }
                mrun = NEGBIG; lrun = 0.f;
            } else if (tq < ntc) { const LAS float* sp = stt + qlc * 68;
#pragma unroll
                for (int g4 = 0; g4 < 4; ++g4) { const f32x4 a = *(const LAS f32x4*)(sp + 8 * g4 + 4 * hf), c = *(const LAS f32x4*)(sp + 32 + 8 * g4 + 4 * hf);
#pragma unroll
                    for (int e = 0; e < 4; ++e) { o0[4 * g4 + e] = a[e]; o1[4 * g4 + e] = c[e]; } }
                mrun = sp[64]; lrun = hf == 0 ? sp[65] : 0.f; }
        }
        const bool allowed = own || validc;
        const int tlo = (!own && second) ? 2 : 0, thi = (!own && pairm && !second) ? 2 : 4;
        for (int ti = tlo; ti < thi; ++ti) {
            bool active, partial = false;
            if (own) { const int klo = 64 * ti, qlo = 32 * w; active = !(klo > qlo + 31); partial = (klo + 63 > qlo); }
            else active = (tq < ntc);
            if (active) {
                f32x16 s0, s1;
#pragma unroll
                for (int e = 0; e < 16; ++e) { s0[e] = 0.f; s1[e] = 0.f; }
                const LAS bf16_t* kt = Kt + (64 * ti) * 72;
#pragma unroll
                for (int st = 0; st < 4; ++st) { const bf16x8 a0 = *(const LAS bf16x8*)(kt + krow * 72 + 16 * st + 8 * hf), a1 = *(const LAS bf16x8*)(kt + (32 + krow) * 72 + 16 * st + 8 * hf);
                    s0 = MFMA32(a0, gqA[st], s0); s1 = MFMA32(a1, gqA[st], s1); }
                if (partial) { const int qrel = 32 * w + qi - 64 * ti;
#pragma unroll
                    for (int e = 0; e < 16; ++e) { const int ko = 16 * (e >> 3) + 8 * hf + (e & 7); if (ko > qrel) s0[e] = NEGBIG; if (ko + 32 > qrel) s1[e] = NEGBIG; } }
                float mx = s0[0];
#pragma unroll
                for (int e = 1; e < 16; ++e) mx = fmaxf(mx, s0[e]);
#pragma unroll
                for (int e = 0; e < 16; ++e) mx = fmaxf(mx, s1[e]);
                if (!allowed) mx = NEGBIG;
                mx = fmaxf(mx, __shfl_xor(mx, 32));
                const bool need = mx > mrun + 40.f;
                if (__ballot(need) != 0ull) {
                    const float mn = need ? mx : mrun, alpha = __builtin_amdgcn_exp2f(mrun - mn); mrun = mn; lrun *= alpha;
#pragma unroll
                    for (int e = 0; e < 16; ++e) { o0[e] *= alpha; o1[e] *= alpha; }
                }
                const float msub = allowed ? mrun : 1e30f;
                f32x2 ps2 = {0.f, 0.f};
#pragma unroll
                for (int e = 0; e < 16; e += 2) { f32x2 d0 = {s0[e], s0[e + 1]}, d1 = {s1[e], s1[e + 1]}; d0 = d0 - msub; d1 = d1 - msub;
                    s0[e] = __builtin_amdgcn_exp2f(d0.x); s0[e + 1] = __builtin_amdgcn_exp2f(d0.y); s1[e] = __builtin_amdgcn_exp2f(d1.x); s1[e + 1] = __builtin_amdgcn_exp2f(d1.y);
                    ps2 = ps2 + (f32x2){s0[e], s0[e + 1]}; ps2 = ps2 + (f32x2){s1[e], s1[e + 1]}; }
                lrun += ps2.x + ps2.y;
                const LAS bf16_t* vt = Vt + 64 * ti;
#pragma unroll
                for (int kh = 0; kh < 2; ++kh)
#pragma unroll
                    for (int s = 0; s < 2; ++s) {
                        union { u32x4 u; bf16x8 v; } pf;
                        if (kh == 0) { pf.u.x = cvt_pk_bf16(s0[8 * s], s0[8 * s + 1]); pf.u.y = cvt_pk_bf16(s0[8 * s + 2], s0[8 * s + 3]); pf.u.z = cvt_pk_bf16(s0[8 * s + 4], s0[8 * s + 5]); pf.u.w = cvt_pk_bf16(s0[8 * s + 6], s0[8 * s + 7]); }
                        else { pf.u.x = cvt_pk_bf16(s1[8 * s], s1[8 * s + 1]); pf.u.y = cvt_pk_bf16(s1[8 * s + 2], s1[8 * s + 3]); pf.u.z = cvt_pk_bf16(s1[8 * s + 4], s1[8 * s + 5]); pf.u.w = cvt_pk_bf16(s1[8 * s + 6], s1[8 * s + 7]); }
                        const bf16x8 v0 = *(const LAS bf16x8*)(vt + qi * 264 + 32 * kh + 16 * s + 8 * hf), v1 = *(const LAS bf16x8*)(vt + (32 + qi) * 264 + 32 * kh + 16 * s + 8 * hf);
                        o0 = MFMA32(v0, pf.v, o0); o1 = MFMA32(v1, pf.v, o1);
                    }
            }
        }
        if (own || (!second && tq < ntc && validc)) {
            const float lt = lrun + __shfl_xor(lrun, 32);
            LAS float* sp = stt + qlc * 68;
#pragma unroll
            for (int g4 = 0; g4 < 4; ++g4) { f32x4 a, c;
#pragma unroll
                for (int e = 0; e < 4; ++e) { a[e] = o0[4 * g4 + e]; c[e] = o1[4 * g4 + e]; }
                *(LAS f32x4*)(sp + 8 * g4 + 4 * hf) = a; *(LAS f32x4*)(sp + 32 + 8 * g4 + 4 * hf) = c; }
            if (hf == 0) { sp[64] = mrun; sp[65] = lt; }
        }
        __syncthreads();
        if (!own && second && tq < ntc && validc) {
            const float lB = lrun + __shfl_xor(lrun, 32);
            LAS float* sp = stt + qlc * 68;
            const float mA = sp[64], lA = sp[65], mM = fmaxf(mA, mrun), ca = __builtin_amdgcn_exp2f(mA - mM), cb = __builtin_amdgcn_exp2f(mrun - mM);
#pragma unroll
            for (int g4 = 0; g4 < 4; ++g4) { f32x4 x = *(const LAS f32x4*)(sp + 8 * g4 + 4 * hf), y = *(const LAS f32x4*)(sp + 32 + 8 * g4 + 4 * hf);
#pragma unroll
                for (int e = 0; e < 4; ++e) { x[e] = x[e] * ca + o0[4 * g4 + e] * cb; y[e] = y[e] * ca + o1[4 * g4 + e] * cb; }
                *(LAS f32x4*)(sp + 8 * g4 + 4 * hf) = x; *(LAS f32x4*)(sp + 32 + 8 * g4 + 4 * hf) = y; }
            if (hf == 0) { sp[64] = mM; sp[65] = lA * ca + lB * cb; }
        }
        if (blk < cur) {
#pragma unroll
            for (int p = 0; p < 4; ++p) { *(LAS u32x4*)(Kt + (sr + 64 * p) * 72 + sc) = kreg[p]; *(LAS u32x4*)(Vt + sr * 264 + sc + 64 * p) = vreg[p]; }
            __syncthreads();
        }
        }
        if (blk + 1 <= cur) { const int blkb = blk + 1;
    {
        const bool own = false;
        if (blkb < cur) { const int kb1 = blkb * 256;
#pragma unroll
            for (int p = 0; p < 4; ++p) { kreg[p] = *(const u32x4*)(kg + (size_t)(kb1 + 64 * p) * 64); vreg[p] = *(const u32x4*)(vg + (size_t)(kb1 >> 8) * 16384 + 64 * p); } }
        if (!own) {
            qlc = qln; ntc = ntn; validc = validn;
            if (blkb < cur) { moba_assign(msk + blkb * 8, 32 * w + qi, qln, validn, ntn); if (ntn <= 4) moba_assign(msk + blkb * 8, 32 * (w >> 1) + qi, qln, validn, ntn);
#pragma unroll
                for (int st = 0; st < 4; ++st) gqA[st] = *(const bf16x8*)(Q + (size_t)(row0 + qln) * 512 + h * 64 + 16 * st + 8 * hf); }
            pairm = ntc <= 4; tq = pairm ? (w >> 1) : w; second = pairm && (w & 1);
            if (second) {
#pragma unroll
                for (int e = 0; e < 16; ++e) { o0[e] = 0.f; o1[e] = 0.f; }
                mrun = NEGBIG; lrun = 0.f;
            } else if (tq < ntc) { const LAS float* sp = stt + qlc * 68;
#pragma unroll
                for (int g4 = 0; g4 < 4; ++g4) { const f32x4 a = *(const LAS f32x4*)(sp + 8 * g4 + 4 * hf), c = *(const LAS f32x4*)(sp + 32 + 8 * g4 + 4 * hf);
#pragma unroll
                    for (int e = 0; e < 4; ++e) { o0[4 * g4 + e] = a[e]; o1[4 * g4 + e] = c[e]; } }
                mrun = sp[64]; lrun = hf == 0 ? sp[65] : 0.f; }
        }
        const bool allowed = own || validc;
        const int tlo = (!own && second) ? 2 : 0, thi = (!own && pairm && !second) ? 2 : 4;
        for (int ti = tlo; ti < thi; ++ti) {
            bool active, partial = false;
            if (own) { const int klo = 64 * ti, qlo = 32 * w; active = !(klo > qlo + 31); partial = (klo + 63 > qlo); }
            else active = (tq < ntc);
            if (active) {
                f32x16 s0, s1;
#pragma unroll
                for (int e = 0; e < 16; ++e) { s0[e] = 0.f; s1[e] = 0.f; }
                const LAS bf16_t* kt = Kt + (64 * ti) * 72;
#pragma unroll
                for (int st = 0; st < 4; ++st) { const bf16x8 a0 = *(const LAS bf16x8*)(kt + krow * 72 + 16 * st + 8 * hf), a1 = *(const LAS bf16x8*)(kt + (32 + krow) * 72 + 16 * st + 8 * hf);
                    s0 = MFMA32(a0, gqB[st], s0); s1 = MFMA32(a1, gqB[st], s1); }
                if (partial) { const int qrel = 32 * w + qi - 64 * ti;
#pragma unroll
                    for (int e = 0; e < 16; ++e) { const int ko = 16 * (e >> 3) + 8 * hf + (e & 7); if (ko > qrel) s0[e] = NEGBIG; if (ko + 32 > qrel) s1[e] = NEGBIG; } }
                float mx = s0[0];
#pragma unroll
                for (int e = 1; e < 16; ++e) mx = fmaxf(mx, s0[e]);
#pragma unroll
                for (int e = 0; e < 16; ++e) mx = fmaxf(mx, s1[e]);
                if (!allowed) mx = NEGBIG;
                mx = fmaxf(mx, __shfl_xor(mx, 32));
                const bool need = mx > mrun + 40.f;
                if (__ballot(need) != 0ull) {
                    const float mn = need ? mx : mrun, alpha = __builtin_amdgcn_exp2f(mrun - mn); mrun = mn; lrun *= alpha;
#pragma unroll
                    for (int e = 0; e < 16; ++e) { o0[e] *= alpha; o1[e] *= alpha; }
                }
                const float msub = allowed ? mrun : 1e30f;
                f32x2 ps2 = {0.f, 0.f};
#pragma unroll
                for (int e = 0; e < 16; e += 2) { f32x2 d0 = {s0[e], s0[e + 1]}, d1 = {s1[e], s1[e + 1]}; d0 = d0 - msub; d1 = d1 - msub;
                    s0[e] = __builtin_amdgcn_exp2f(d0.x); s0[e + 1] = __builtin_amdgcn_exp2f(d0.y); s1[e] = __builtin_amdgcn_exp2f(d1.x); s1[e + 1] = __builtin_amdgcn_exp2f(d1.y);
                    ps2 = ps2 + (f32x2){s0[e], s0[e + 1]}; ps2 = ps2 + (f32x2){s1[e], s1[e + 1]}; }
                lrun += ps2.x + ps2.y;
                const LAS bf16_t* vt = Vt + 64 * ti;
#pragma unroll
                for (int kh = 0; kh < 2; ++kh)
#pragma unroll
                    for (int s = 0; s < 2; ++s) {
                        union { u32x4 u; bf16x8 v; } pf;
                        if (kh == 0) { pf.u.x = cvt_pk_bf16(s0[8 * s], s0[8 * s + 1]); pf.u.y = cvt_pk_bf16(s0[8 * s + 2], s0[8 * s + 3]); pf.u.z = cvt_pk_bf16(s0[8 * s + 4], s0[8 * s + 5]); pf.u.w = cvt_pk_bf16(s0[8 * s + 6], s0[8 * s + 7]); }
                        else { pf.u.x = cvt_pk_bf16(s1[8 * s], s1[8 * s + 1]); pf.u.y = cvt_pk_bf16(s1[8 * s + 2], s1[8 * s + 3]); pf.u.z = cvt_pk_bf16(s1[8 * s + 4], s1[8 * s + 5]); pf.u.w = cvt_pk_bf16(s1[8 * s + 6], s1[8 * s + 7]); }
                        const bf16x8 v0 = *(const LAS bf16x8*)(vt + qi * 264 + 32 * kh + 16 * s + 8 * hf), v1 = *(const LAS bf16x8*)(vt + (32 + qi) * 264 + 32 * kh + 16 * s + 8 * hf);
                        o0 = MFMA32(v0, pf.v, o0); o1 = MFMA32(v1, pf.v, o1);
                    }
            }
        }
        if (own || (!second && tq < ntc && validc)) {
            const float lt = lrun + __shfl_xor(lrun, 32);
            LAS float* sp = stt + qlc * 68;
#pragma unroll
            for (int g4 = 0; g4 < 4; ++g4) { f32x4 a, c;
#pragma unroll
                for (int e = 0; e < 4; ++e) { a[e] = o0[4 * g4 + e]; c[e] = o1[4 * g4 + e]; }
                *(LAS f32x4*)(sp + 8 * g4 + 4 * hf) = a; *(LAS f32x4*)(sp + 32 + 8 * g4 + 4 * hf) = c; }
            if (hf == 0) { sp[64] = mrun; sp[65] = lt; }
        }
        __syncthreads();
        if (!own && second && tq < ntc && validc) {
            const float lB = lrun + __shfl_xor(lrun, 32);
            LAS float* sp = stt + qlc * 68;
            const float mA = sp[64], lA = sp[65], mM = fmaxf(mA, mrun), ca = __builtin_amdgcn_exp2f(mA - mM), cb = __builtin_amdgcn_exp2f(mrun - mM);
#pragma unroll
            for (int g4 = 0; g4 < 4; ++g4) { f32x4 x = *(const LAS f32x4*)(sp + 8 * g4 + 4 * hf), y = *(const LAS f32x4*)(sp + 32 + 8 * g4 + 4 * hf);
#pragma unroll
                for (int e = 0; e < 4; ++e) { x[e] = x[e] * ca + o0[4 * g4 + e] * cb; y[e] = y[e] * ca + o1[4 * g4 + e] * cb; }
                *(LAS f32x4*)(sp + 8 * g4 + 4 * hf) = x; *(LAS f32x4*)(sp + 32 + 8 * g4 + 4 * hf) = y; }
            if (hf == 0) { sp[64] = mM; sp[65] = lA * ca + lB * cb; }
        }
        if (blkb < cur) {
#pragma unroll
            for (int p = 0; p < 4; ++p) { *(LAS u32x4*)(Kt + (sr + 64 * p) * 72 + sc) = kreg[p]; *(LAS u32x4*)(Vt + sr * 264 + sc + 64 * p) = vreg[p]; }
            __syncthreads();
        }
        }
        }
    }
    __syncthreads();
    {
        const LAS float* sp = stt + qown * 68; const float il = 1.f / sp[65];
        bf16_t* op = O + (size_t)(row0 + qown) * 512 + h * 64 + 4 * hf;
#pragma unroll
        for (int g4 = 0; g4 < 4; ++g4) { const f32x4 a = *(const LAS f32x4*)(sp + 8 * g4 + 4 * hf), c = *(const LAS f32x4*)(sp + 32 + 8 * g4 + 4 * hf); u32x2 w0, w1;
            w0.x = cvt_pk_bf16(a[0] * il, a[1] * il); w0.y = cvt_pk_bf16(a[2] * il, a[3] * il); w1.x = cvt_pk_bf16(c[0] * il, c[1] * il); w1.y = cvt_pk_bf16(c[2] * il, c[3] * il);
            *(u32x2*)(op + 8 * g4) = w0; *(u32x2*)(op + 32 + 8 * g4) = w1; }
    }
    __syncthreads();
}

__device__ __forceinline__ void ssm_scan_pairs(LAS unsigned char* lds, unsigned char* ws, int pr0, int prstep) {
    const int tid = tidx();
        LAS float* Es = (LAS float*)lds;
        for (int pr = pr0; pr < 64; pr += prstep) { const int g = pr >> 1, b = pr & 1, p = tid & 63, seg = tid >> 6; const int row0 = g * 512 + b * 256 + seg * 32;
            const float* aT = (const float*)(ws + WS_AT); const float ar = aT[(g * 64 + p) * 2], ai = aT[(g * 64 + p) * 2 + 1];
            const float* S = (const float*)(ws + WS_SOUT) + (size_t)row0 * 128; bf16_t* AP = (bf16_t*)(ws + WS_AP) + (size_t)row0 * AK + 512;
            float sr_[32], si_[32];
#pragma unroll
            for (int e = 0; e < 32; ++e) { sr_[e] = S[(size_t)e * 128 + p]; si_[e] = S[(size_t)e * 128 + 64 + p]; }
            float hr = 0.f, hi_ = 0.f;
#pragma unroll
            for (int e = 0; e < 32; ++e) { const float nr = ar * hr - ai * hi_ + sr_[e], ni = ar * hi_ + ai * hr + si_[e]; hr = nr; hi_ = ni; }
            Es[(seg * 64 + p) * 2] = hr; Es[(seg * 64 + p) * 2 + 1] = hi_;
            float a32r = ar, a32i = ai;
#pragma unroll
            for (int q = 0; q < 5; ++q) { const float nr = a32r * a32r - a32i * a32i, ni = 2.f * a32r * a32i; a32r = nr; a32i = ni; }
            __syncthreads();
            hr = 0.f; hi_ = 0.f;
            for (int j = 0; j < seg; ++j) { const float er = Es[(j * 64 + p) * 2], ei = Es[(j * 64 + p) * 2 + 1]; const float nr = a32r * hr - a32i * hi_ + er, ni = a32r * hi_ + a32i * hr + ei; hr = nr; hi_ = ni; }
#pragma unroll
            for (int e = 0; e < 32; ++e) { bf16_t* o = AP + (size_t)e * AK; o[p] = (bf16_t)(cvt_pk_bf16(hr, 0.f) & 0xffffu); o[64 + p] = (bf16_t)(cvt_pk_bf16(hi_, 0.f) & 0xffffu);
                const float nr = ar * hr - ai * hi_ + sr_[e], ni = ar * hi_ + ai * hr + si_[e]; hr = nr; hi_ = ni; }
            __syncthreads(); }
}

#define XB_TMO      128
#define XB_XCNT(j)  (256  + 64 * (j))
#define XB_XSUB(j)  (1280 + 64 * (j))
#define XB_XGEN(j)  (2304 + 64 * (j))
#define XB_TOP      3328
#define XB_TOPGEN   3392
#define XCD_BAR_WORDS 3456
#define XB_SPIN_CAP (1u << 18)
__device__ __forceinline__ unsigned xb_ld(unsigned* p)              { return __hip_atomic_load(p, __ATOMIC_RELAXED, __HIP_MEMORY_SCOPE_AGENT); }
__device__ __forceinline__ unsigned xb_add(unsigned* p, unsigned v) { return __hip_atomic_fetch_add(p, v, __ATOMIC_RELAXED, __HIP_MEMORY_SCOPE_AGENT); }
__device__ __forceinline__ unsigned xb_xcc_id() { return (unsigned)__builtin_amdgcn_s_getreg((3 << 11) | 20) & 0xFu; }
#define XB_SPIN(cond, bar) do { unsigned _sp = 0; while (cond) { __builtin_amdgcn_s_sleep(1); \
    if ((++_sp & 255u) == 0u) { if (xb_ld(&(bar)[XB_TMO])) break; if (_sp > XB_SPIN_CAP) { atomicAdd(&(bar)[XB_TMO], 1u); break; } } } } while (0)
struct XcdBarrier { unsigned* bar; unsigned x; volatile LAS unsigned* st; };
__device__ __forceinline__ XcdBarrier xcd_barrier_post(unsigned* bar, volatile LAS unsigned* st) {
    XcdBarrier b; b.bar = bar; b.x = xb_xcc_id(); b.st = st;
    if (tidx() == 0) (void)xb_add(&bar[XB_XCNT(b.x)], 1u);
    return b;
}
__device__ __forceinline__ void xcd_barrier_complete(unsigned* bar, unsigned x, unsigned& nloc, unsigned& nx) {
    const unsigned G = gridDim.x * gridDim.y * gridDim.z;
    unsigned sum, cnt, mine, sp = 0u;
    for (;;) {
        sum = 0u; cnt = 0u; mine = 0u;
#pragma unroll
        for (unsigned j = 0; j < 16; ++j) { const unsigned c = xb_ld(&bar[XB_XCNT(j)]); sum += c; cnt += (c > 0u) ? 1u : 0u; mine = (j == x) ? c : mine; }
        if (sum == G) break;
        __builtin_amdgcn_s_sleep(1);
        if ((++sp & 255u) == 0u) { if (xb_ld(&bar[XB_TMO])) break; if (sp > XB_SPIN_CAP) { atomicAdd(&bar[XB_TMO], 1u); break; } }
    }
    nloc = mine > 0u ? mine : 1u; nx = cnt > 0u ? cnt : 1u;
}
__device__ __forceinline__ void xcd_barrier(const XcdBarrier& b) {
    asm volatile("s_waitcnt vmcnt(0)" ::: "memory");
    __syncthreads();
    if (tidx() == 0) {
        unsigned* bar = b.bar;
        __builtin_amdgcn_s_waitcnt(0);
        unsigned nloc = b.st[0], nx = b.st[1];
        if (nloc == 0u) { xcd_barrier_complete(bar, b.x, nloc, nx); b.st[0] = nloc; b.st[1] = nx; }
        const unsigned old = xb_add(&bar[XB_XSUB(b.x)], 1u);
        const unsigned gen = old / nloc;
        if (old + 1u == (gen + 1u) * nloc) {
            __builtin_amdgcn_fence(__ATOMIC_RELEASE, "agent");
            asm volatile("s_waitcnt vmcnt(0)" ::: "memory");
            const unsigned og = xb_add(&bar[XB_TOP], 1u);
            const unsigned tg = og / nx;
            if (og + 1u == (tg + 1u) * nx) xb_add(&bar[XB_TOPGEN], 1u);
            else XB_SPIN(xb_ld(&bar[XB_TOPGEN]) == tg, bar);
            __builtin_amdgcn_fence(__ATOMIC_ACQUIRE, "agent");
            xb_add(&bar[XB_XGEN(b.x)], 1u);
            asm volatile("s_waitcnt vmcnt(0)" ::: "memory");
        } else {
            XB_SPIN(xb_ld(&bar[XB_XGEN(b.x)]) == gen, bar);
            __builtin_amdgcn_fence(__ATOMIC_ACQUIRE, "agent");
            asm volatile("s_waitcnt vmcnt(0)" ::: "memory");
        }
    }
    __syncthreads();
}

__global__ void __launch_bounds__(512, 2) fwd_kernel(Args a_unused) {
    const ArgsP ap = (ArgsP)__builtin_amdgcn_kernarg_segment_ptr();
    extern __shared__ __attribute__((aligned(16))) unsigned char lds_raw[];
    LAS unsigned char* lds = (LAS unsigned char*)lds_raw;
    cg::grid_group grid = cg::this_grid();
    const int G = gridDim.x, bx = blockIdx.x, tid = tidx();
    const int lo = ap->lo, hi = ap->hi;
    unsigned char* const ws0 = ap->ws;
    XcdBarrier xbar; xbar.bar = (unsigned*)(ws0 + WS_BAR); xbar.x = 0; xbar.st = (volatile LAS unsigned*)(lds + LDS_CTL);
    if (hi - lo > 1) { if (tid < 2) xbar.st[tid] = 0u; __syncthreads(); xbar = xcd_barrier_post((unsigned*)(ws0 + WS_BAR), (volatile LAS unsigned*)(lds + LDS_CTL)); }
    if (lo < 0) grid.sync();
#ifndef PH_MASK
#define PH_MASK 0xffff
#endif
#ifndef DUP_MASK
#define DUP_MASK 0
#endif
#ifndef EXTRA_SYNCS
#define EXTRA_SYNCS 0
#endif
#define REP(k) for (int rep_ = 0; rep_ < 1 + ((DUP_MASK >> (k)) & 1); ++rep_, ((DUP_MASK >> (k)) & 1) ? GSYNC() : (void)0)
#define IN(k) (((PH_MASK >> (k)) & 1) && lo <= (k) && (k) < hi)
#define GSYNC() xcd_barrier(xbar)
#define SEAM(k) do { if (IN(k) && IN((k) + 1)) GSYNC(); } while (0)
#define PHASE_VARS ArgsP a = ap; asm volatile("" : "+s"(a)); unsigned char* ws = a->ws; float* RS0 = (float*)(ws + WS_RS0); float* RS1 = (float*)(ws + WS_RS1); float* RS2 = (float*)(ws + WS_RS2); float* RS3 = (float*)(ws + WS_RS3); \
    bf16_t* XB = (bf16_t*)(ws + WS_XB); bf16_t* ACT = (bf16_t*)(ws + WS_ACT); (void)RS0; (void)RS1; (void)RS2; (void)RS3; (void)XB; (void)ACT;

    REP(0) if (IN(0)) { PHASE_VARS p0_prologue(lds, a); }
    SEAM(0);
    REP(1) if (IN(1)) { PHASE_VARS pg8::Gemm g{XB, (const bf16_t*)(ws + WS_W1GU), 1024, 1024, 1024}; pg8::StaticOrder S; S.init(M, 5632, G, bx);
        EpiGateUp E{ACT, RS0}; pg8::gemm_phase<EpiGateUp, pg8::StaticOrder, true>(lds, g, S, E);
        if (G == 256) {
            const int nmine = bx >= 128 ? 6 : (bx < 32 ? 2 : 1);
            for (int k = 0; k < nmine; ++k) { int gi = bx >= 128 ? (bx - 128) + 128 * k : 768 + bx + 128 * k, base = 0;
                for (int j = 2; j < 9; ++j) { const WJob J = get_job(a, j); const int cnt = (J.K >> 6) * (J.ndst >> 8);
                    if (gi >= base && gi < base + cnt) wconv_item(J, gi - base);
                    base += cnt; } } } }
    SEAM(1);
    if (IN(2)) { PHASE_VARS pg8::Gemm g{ACT, (const bf16_t*)(ws + WS_W1D), FF, FF, FF}; pg8::StaticOrder S; S.init(M, 1024, G, bx);
        EpiResB<true> E{XB, (bf16_t*)a->out, RS1, 0.5f}; pg8::gemm_phase<EpiResB<true>, pg8::StaticOrder, true>(lds, g, S, E); }
    SEAM(2);
    REP(3) if (IN(3)) { PHASE_VARS pg8::Gemm g{(const bf16_t*)a->out, (const bf16_t*)(ws + WS_WIN), 1024, 1024, 1024}; pg8::StaticOrder S; S.init(M, INW, G, bx);
        EpiWin E{RS1, (bf16_t*)(ws + WS_AP), (bf16_t*)(ws + WS_Q), (bf16_t*)(ws + WS_K), (bf16_t*)(ws + WS_VT), (bf16_t*)(ws + WS_GS), (bf16_t*)(ws + WS_GA), (const float*)(ws + WS_ROPE), (float*)(ws + WS_KMEAN)};
        pg8::gemm_phase<EpiWin, pg8::StaticOrder, true>(lds, g, S, E); }
    SEAM(3);
    const bool merged = (G >= 64);
    if (IN(4)) { PHASE_VARS
        if (merged) {
            if (bx < 64) {
                { pg8::Gemm g{(const bf16_t*)(ws + WS_AP), (const bf16_t*)(ws + WS_BTS), 512, AK, 512}; pg8::RangeOrder S{2, 1, bx, 1};
                  EpiS E{(float*)(ws + WS_SOUT)}; pg8::gemm_phase<EpiS, pg8::RangeOrder, true>(lds, g, S, E); }
                asm volatile("s_waitcnt vmcnt(0)" ::: "memory"); __syncthreads();
                ssm_scan_pairs(lds, ws, bx, 64);
                asm volatile("s_waitcnt vmcnt(0)" ::: "memory"); __syncthreads();
                { pg8::Gemm g{(const bf16_t*)(ws + WS_AP), (const bf16_t*)(ws + WS_BTY), AK, AK, AK}; pg8::RangeOrder S{2, 2, 2 * bx, 2};
                  EpiY E{(bf16_t*)(ws + WS_Y)}; pg8::gemm_phase<EpiY, pg8::RangeOrder, true>(lds, g, S, E); }
                asm volatile("s_waitcnt vmcnt(0)" ::: "memory"); __syncthreads();
                if (tid == 0) { __builtin_amdgcn_fence(__ATOMIC_RELEASE, "agent"); asm volatile("s_waitcnt vmcnt(0)" ::: "memory");
                    __hip_atomic_fetch_add((unsigned*)(ws + WS_ATTQ) + 64, 1u, __ATOMIC_RELAXED, __HIP_MEMORY_SCOPE_AGENT); }
                __syncthreads();
            }
            volatile LAS unsigned* qw = (volatile LAS unsigned*)(lds + LDS_CTL + 16);
            for (;;) {
                if (tid == 0) qw[0] = __hip_atomic_fetch_add((unsigned*)(ws + WS_ATTQ), 1u, __ATOMIC_RELAXED, __HIP_MEMORY_SCOPE_AGENT);
                __syncthreads();
                const unsigned u = qw[0];
                __syncthreads();
                if (u >= 640u) break;
                if (u >= 512u) {
                    if (tid == 0) { unsigned sp = 0; while (__hip_atomic_load((unsigned*)(ws + WS_ATTQ) + 64, __ATOMIC_RELAXED, __HIP_MEMORY_SCOPE_AGENT) < 64u) { __builtin_amdgcn_s_sleep(2); if (++sp > (1u << 22)) break; }
                        __builtin_amdgcn_fence(__ATOMIC_ACQUIRE, "agent"); asm volatile("s_waitcnt vmcnt(0)" ::: "memory"); }
                    __syncthreads();
                    pg8::Gemm g{(const bf16_t*)(ws + WS_Y), (const bf16_t*)(ws + WS_WGLU), 512, 512, 512}; pg8::RangeOrder S{64, 2, (int)u - 512, 1};
                    EpiGlu E{(const bf16_t*)(ws + WS_Y), a->in[16], (bf16_t*)(ws + WS_GT)}; pg8::gemm_phase<EpiGlu, pg8::RangeOrder, true>(lds, g, S, E);
                    __syncthreads();
                    continue;
                }
                const int qb = 31 - (int)(u >> 4), bh = (int)(u & 15);
                attn_unit_h(lds, (const bf16_t*)(ws + WS_Q), (const bf16_t*)(ws + WS_K), (const bf16_t*)(ws + WS_VT), (const float*)(ws + WS_KMEAN), (bf16_t*)(ws + WS_ATT), bh >> 3, bh & 7, qb);
            }
        } else {
            { pg8::Gemm g{(const bf16_t*)(ws + WS_AP), (const bf16_t*)(ws + WS_BTS), 512, AK, 512}; pg8::GroupOrder S{2, 1, 64, G, bx};
              EpiS E{(float*)(ws + WS_SOUT)}; pg8::gemm_phase<EpiS, pg8::GroupOrder, true>(lds, g, S, E); }
            __syncthreads();
            for (int pi = bx; pi < 256; pi += G) { const int b = pi >> 7, h = (pi >> 4) & 7, x = pi & 15;
                attn_unit_h(lds, (const bf16_t*)(ws + WS_Q), (const bf16_t*)(ws + WS_K), (const bf16_t*)(ws + WS_VT), (const float*)(ws + WS_KMEAN), (bf16_t*)(ws + WS_ATT), b, h, 31 - x);
                attn_unit_h(lds, (const bf16_t*)(ws + WS_Q), (const bf16_t*)(ws + WS_K), (const bf16_t*)(ws + WS_VT), (const float*)(ws + WS_KMEAN), (bf16_t*)(ws + WS_ATT), b, h, x); }
        }
    }
    SEAM(4);
    if (!merged) {
    if (IN(5)) { PHASE_VARS ssm_scan_pairs(lds, ws, bx, G); }
    SEAM(5);
    if (IN(6)) { PHASE_VARS pg8::Gemm g{(const bf16_t*)(ws + WS_AP), (const bf16_t*)(ws + WS_BTY), AK, AK, AK}; pg8::GroupOrder S{2, 2, 128, G, bx};
        EpiY E{(bf16_t*)(ws + WS_Y)}; pg8::gemm_phase<EpiY, pg8::GroupOrder, true>(lds, g, S, E); }
    }
    if (!merged) SEAM(6);
    if (!merged) if (IN(7)) { PHASE_VARS pg8::Gemm g{(const bf16_t*)(ws + WS_Y), (const bf16_t*)(ws + WS_WGLU), 512, 512, 512}; pg8::StaticOrder S; S.init(M, 512, G, bx);
        EpiGlu E{(const bf16_t*)(ws + WS_Y), a->in[16], (bf16_t*)(ws + WS_GT)}; pg8::gemm_phase<EpiGlu, pg8::StaticOrder, true>(lds, g, S, E); }
    if (!merged) SEAM(7);
    if (IN(8)) { PHASE_VARS
        { pg8::Gemm g{(const bf16_t*)(ws + WS_GT), (const bf16_t*)(ws + WS_WBS), 512, 512, 512}; pg8::StaticOrder S; S.init(M, 1024, G, bx);
          EpiBranch<0> E{(bf16_t*)(ws + WS_GS), (bf16_t*)(ws + WS_GA)}; pg8::gemm_phase<EpiBranch<0>, pg8::StaticOrder, true>(lds, g, S, E); }
        __syncthreads();
        { pg8::Gemm g{(const bf16_t*)(ws + WS_ATT), (const bf16_t*)(ws + WS_WBA), 512, 512, 512}; pg8::StaticOrder S; S.init(M, 1024, G, bx);
          EpiBranch<1> E{(bf16_t*)(ws + WS_GS), (bf16_t*)(ws + WS_GA)}; pg8::gemm_phase<EpiBranch<1>, pg8::StaticOrder, true>(lds, g, S, E); }
    }
    SEAM(8);
    if (IN(9)) { PHASE_VARS pg8::Gemm g{(const bf16_t*)(ws + WS_GA), (const bf16_t*)(ws + WS_WOUT), 1024, 1024, 1024}; pg8::StaticOrder S; S.init(M, 1024, G, bx);
        EpiResB<true> E{(const bf16_t*)a->out, XB, RS2, 1.0f}; pg8::gemm_phase<EpiResB<true>, pg8::StaticOrder, true>(lds, g, S, E); }
    SEAM(9);
    if (IN(10)) { PHASE_VARS pg8::Gemm g{XB, (const bf16_t*)(ws + WS_W2GU), 1024, 1024, 1024}; pg8::StaticOrder S; S.init(M, 5632, G, bx);
        EpiGateUp E{ACT, RS2}; pg8::gemm_phase<EpiGateUp, pg8::StaticOrder, true>(lds, g, S, E); }
    SEAM(10);
    const bool fuse_norm = (G == 256);
    if (IN(11)) { PHASE_VARS pg8::Gemm g{ACT, (const bf16_t*)(ws + WS_W2D), FF, FF, FF}; pg8::StaticOrder S; S.init(M, 1024, G, bx);
        if (fuse_norm) { EpiResNorm E{XB, a->out, RS3, (unsigned*)(ws + WS_PCNT), a->in[24], 0.5f}; pg8::gemm_phase<EpiResNorm, pg8::StaticOrder, true>(lds, g, S, E); }
        else { EpiResF E{XB, a->out, RS3, 0.5f}; pg8::gemm_phase<EpiResF, pg8::StaticOrder, true>(lds, g, S, E); } }
    if (!fuse_norm) {
    SEAM(11);
    for (int es_ = 0; es_ < EXTRA_SYNCS; ++es_) GSYNC();
    if (IN(12)) { PHASE_VARS const float* gain = a->in[24]; const int lane = tid & 63, wave = tid >> 6;
        for (int row = bx * 8 + wave; row < M; row += G * 8) { const float s = inv_rms(RS3[row]); f32x4* xr = (f32x4*)(a->out + (size_t)row * DM);
#pragma unroll
            for (int i = 0; i < 4; ++i) { const f32x4 gv = *(const f32x4*)(gain + (lane + 64 * i) * 4); xr[lane + 64 * i] = xr[lane + 64 * i] * s * gv; } } }
    }
#undef IN
#undef SEAM
}

extern "C" void kernel_launch(void* const* d_in, const int* in_sizes, int n_in, void* d_out, int out_size, void* d_ws, size_t ws_size, hipStream_t stream) {
    static int grid = 0;
    if (grid == 0) {
        if (n_in != 25 || out_size != M * DM || ws_size < WS_END) { fprintf(stderr, "kernel_launch: unexpected problem (n_in %d out %d ws %zu need %zu)\n", n_in, out_size, ws_size, (size_t)WS_END); grid = -1; return; }
        int dev = 0, cus = 0, per_cu = 0;
        hipGetDevice(&dev); hipDeviceGetAttribute(&cus, hipDeviceAttributeMultiprocessorCount, dev);
        if (hipFuncSetAttribute((const void*)fwd_kernel, hipFuncAttributeMaxDynamicSharedMemorySize, LDS_BYTES) != hipSuccess) { fprintf(stderr, "kernel_launch: hipFuncSetAttribute failed\n"); grid = -1; return; }
        if (hipOccupancyMaxActiveBlocksPerMultiprocessor(&per_cu, (const void*)fwd_kernel, 512, LDS_BYTES) != hipSuccess || per_cu < 1) { fprintf(stderr, "kernel_launch: occupancy query says %d\n", per_cu); per_cu = 1; }
        (void)hipGetLastError();
        grid = cus * 1;
        if (grid > 256) grid = 256;
    }
    if (grid < 0) return;
    Args a{};
    for (int i = 0; i < 25; ++i) a.in[i] = (const float*)d_in[i];
    a.out = (float*)d_out; a.ws = (unsigned char*)d_ws;
#if MULTI_LAUNCH
    for (int p = 0; p < NPHASE; ++p) { a.lo = p; a.hi = p + 1; hipLaunchKernelGGL(fwd_kernel, dim3(grid), dim3(512), LDS_BYTES, stream, a); }
#else
    a.lo = 0; a.hi = NPHASE;
    (void)hipMemsetAsync((char*)d_ws + WS_BAR, 0, XCD_BAR_WORDS * 4, stream);
    void* args[] = {&a};
    hipError_t e = hipLaunchCooperativeKernel((const void*)fwd_kernel, dim3(grid), dim3(512), args, LDS_BYTES, stream);
    if (e != hipSuccess) fprintf(stderr, "kernel_launch: cooperative launch failed: %s (grid %d)\n", hipGetErrorString(e), grid);
#endif
}
```

```cpp
#include <hip/hip_runtime.h>
#include <hip/hip_cooperative_groups.h>
#include <cstdio>
#include <cstdint>
namespace cg = cooperative_groups;

#ifndef MULTI_LAUNCH
#define MULTI_LAUNCH 0
#endif

#define LAS __attribute__((address_space(3)))
typedef unsigned short bf16_t;
typedef short bf16x8 __attribute__((ext_vector_type(8)));
typedef float f32x4 __attribute__((ext_vector_type(4)));
typedef float f32x16 __attribute__((ext_vector_type(16)));
typedef unsigned u32x4 __attribute__((ext_vector_type(4)));
typedef unsigned u32x2 __attribute__((ext_vector_type(2)));
typedef float f32x2 __attribute__((ext_vector_type(2)));

constexpr int M = 16384, DM = 1024, FF = 2816, SEQ = 8192, NH = 8, INW = 4096;
constexpr int TCH = 32, AK = 640;
constexpr float EPS = 1e-6f;
constexpr float QSCALE = 0.125f * 1.4426950408889634f;
constexpr float NEGBIG = -1e30f;
constexpr int LDS_CTL = 149504;
constexpr int LDS_BYTES = LDS_CTL + 64;
constexpr int NPHASE = 13;

constexpr size_t WS_RS0 = 0, WS_RS1 = 65536, WS_RS2 = 131072, WS_RS3 = 196608, WS_KMEAN = 262144, WS_AT = 393216;
constexpr size_t WS_PCNT = 425984;
constexpr size_t WS_ATTQ = 442368;
constexpr size_t WS_BAR = 409600;
constexpr size_t WS_ROPE = 524288;
constexpr size_t WS_W1GU = WS_ROPE + 2097152;
constexpr size_t WS_W1D = WS_W1GU + (size_t)5632 * 1024 * 2;
constexpr size_t WS_W2GU = WS_W1D + (size_t)1024 * 2816 * 2;
constexpr size_t WS_W2D = WS_W2GU + (size_t)5632 * 1024 * 2;
constexpr size_t WS_WIN = WS_W2D + (size_t)1024 * 2816 * 2;
constexpr size_t WS_WGLU = WS_WIN + (size_t)4096 * 1024 * 2;
constexpr size_t WS_WBS = WS_WGLU + (size_t)512 * 512 * 2;
constexpr size_t WS_WBA = WS_WBS + (size_t)1024 * 512 * 2;
constexpr size_t WS_WOUT = WS_WBA + (size_t)1024 * 512 * 2;
constexpr size_t WS_BTY = WS_WOUT + (size_t)1024 * 1024 * 2;
constexpr size_t WS_BTS = WS_BTY + (size_t)32 * 512 * AK * 2;
constexpr size_t WS_XB = WS_BTS + (size_t)32 * 256 * 512 * 2;
constexpr size_t WS_MIX = WS_XB + (size_t)M * 1024 * 2;
constexpr size_t WS_AP = WS_MIX;
constexpr size_t WS_SOUT = WS_AP + (size_t)M * AK * 2;
constexpr size_t WS_Q = WS_SOUT + (size_t)M * 128 * 4;
constexpr size_t WS_K = WS_Q + (size_t)M * 512 * 2;
constexpr size_t WS_VT = WS_K + (size_t)M * 512 * 2;
constexpr size_t WS_GS = WS_VT + (size_t)M * 512 * 2;
constexpr size_t WS_GA = WS_GS + (size_t)M * 1024 * 2;
constexpr size_t WS_END = WS_GA + (size_t)M * 1024 * 2;
constexpr size_t WS_ACT = WS_MIX;
constexpr size_t WS_Y = WS_W1GU;
static_assert(WS_W1D == WS_W1GU + (size_t)5632 * 1024 * 2 && WS_W2GU - WS_W1GU >= (size_t)M * 512 * 2, "y_ssm overlay");
constexpr size_t WS_ATT = WS_XB;
constexpr size_t WS_GT = WS_XB + (size_t)M * 512 * 2;
static_assert(WS_ACT + (size_t)M * FF * 2 <= WS_END, "act overlay");
static_assert(WS_END <= (size_t)256 * 1024 * 1024, "workspace");

struct Args {
    const float* in[25];
    float* out;
    unsigned char* ws;
    int lo, hi;
};
typedef const __attribute__((address_space(4))) Args* ArgsP;

__device__ __forceinline__ int tidx() { int t = (int)threadIdx.x; asm volatile("" : "+v"(t)); return t; }
__device__ __forceinline__ unsigned cvt_pk_bf16(float lo, float hi) { unsigned r; asm("v_cvt_pk_bf16_f32 %0, %1, %2" : "=v"(r) : "v"(lo), "v"(hi)); return r; }
__device__ __forceinline__ u32x4 pack8(f32x4 a, f32x4 b) { u32x4 w; w.x = cvt_pk_bf16(a[0], a[1]); w.y = cvt_pk_bf16(a[2], a[3]); w.z = cvt_pk_bf16(b[0], b[1]); w.w = cvt_pk_bf16(b[2], b[3]); return w; }
__device__ __forceinline__ void unpack8(u32x4 w, f32x4& a, f32x4& b) {
    a[0] = __uint_as_float(w.x << 16); a[1] = __uint_as_float(w.x & 0xffff0000u); a[2] = __uint_as_float(w.y << 16); a[3] = __uint_as_float(w.y & 0xffff0000u);
    b[0] = __uint_as_float(w.z << 16); b[1] = __uint_as_float(w.z & 0xffff0000u); b[2] = __uint_as_float(w.w << 16); b[3] = __uint_as_float(w.w & 0xffff0000u);
}
__device__ __forceinline__ float fast_sigmoid(float x) { return __builtin_amdgcn_rcpf(1.f + __expf(-x)); }
__device__ __forceinline__ f32x4 sigmoid4(f32x4 v) { f32x4 r; r[0] = fast_sigmoid(v[0]); r[1] = fast_sigmoid(v[1]); r[2] = fast_sigmoid(v[2]); r[3] = fast_sigmoid(v[3]); return r; }
__device__ __forceinline__ float gelu_tanh(float x) { const float u = 1.5957691216057308f * (x + 0.044715f * x * x * x); return x * fast_sigmoid(u); }
__device__ __forceinline__ float inv_rms(float ss) { return rsqrtf(ss * (1.f / 1024.f) + EPS); }

__device__ __forceinline__ double exp_d(double x) {
    const double kf = rint(x * 1.4426950408889634);
    const double r = fma(-kf, 1.9082149292705877e-10, fma(-kf, 0.6931471803691238, x));
    double t = 1.0, s = 1.0;
#pragma unroll
    for (int i = 1; i <= 14; ++i) { t *= r * (1.0 / i); s += t; }
    const long long bits = (long long)(1023 + (int)kf) << 52;
    return s * __longlong_as_double(bits);
}
__device__ __forceinline__ void sincos_d(double x, double& sn, double& cs) {
    const double kf = rint(x * 0.6366197723675814);
    double r = fma(-kf, 1.5707963267948966, x); r = fma(-kf, 6.123233995736766e-17, r);
    const double r2 = r * r;
    double ts = r, ss = r, tc = 1.0, sc = 1.0;
#pragma unroll
    for (int i = 1; i <= 8; ++i) { ts *= -r2 * (1.0 / ((2 * i) * (2 * i + 1))); ss += ts; tc *= -r2 * (1.0 / ((2 * i - 1) * (2 * i))); sc += tc; }
    const int q = (int)((long long)kf & 3);
    sn = (q == 0) ? ss : (q == 1) ? sc : (q == 2) ? -ss : -sc;
    cs = (q == 0) ? sc : (q == 1) ? -ss : (q == 2) ? -sc : ss;
}

namespace pg8 {
constexpr int BM = 256, BK = 64, HALF = 128, HTB = HALF * BK * 2, STAGE_BYTES = 8 * HTB, NXCD = 8, WGM = 8;
__host__ __device__ __forceinline__ int lds_byte(int r, int c) { const int st = (r >> 4) * 2 + (c >> 5), rr = r & 15, cc = c & 31, ob = rr * 64 + cc * 2; return st * 1024 + (ob ^ (((ob >> 9) & 1) << 5)); }
__host__ __device__ __forceinline__ void stage_rc(int b, int& R, int& C) { const int st = b / 1024, sb = b % 1024, swz = sb ^ (((sb >> 9) & 1) << 5); R = (st >> 1) * 16 + swz / 64; C = (st & 1) * 32 + (swz % 64) / 2; }
__host__ __device__ __forceinline__ int perm32(int rho) { const int n = rho >> 4, i = rho & 15; return 8 * (i >> 2) + 4 * n + (i & 3); }

struct Unit { int pm, pn; };
struct Gemm { const bf16_t* A; const bf16_t* Bt; int K, lda, ldb; };

struct StaticOrder {
    int nM, nN, nwg, G, c;
    __device__ void init(int Mr, int N, int G_, int c_) { nM = Mr / BM; nN = N / BM; nwg = nM * nN; G = G_; c = c_; }
    __device__ bool next(int i, Unit& u) const {
        const long L = (long)i * G + c; if (L >= nwg) return false;
        int wgid = (int)L; { const int q = nwg / NXCD, r = nwg % NXCD, xcd = wgid % NXCD, off = wgid / NXCD; wgid = (xcd < r ? xcd * (q + 1) : r * (q + 1) + (xcd - r) * q) + off; }
        const int nig = WGM * nN, gid = wgid / nig, fm = gid * WGM, gsz = (nM - fm) < WGM ? (nM - fm) : WGM;
        u.pm = fm + ((wgid % nig) % gsz); u.pn = (wgid % nig) / gsz; return true;
    }
};
struct GroupOrder {
    int ntm, ntn, nwg, G, c;
    __device__ bool next(int i, Unit& u) const {
        const long L = (long)i * G + c; if (L >= nwg) return false;
        const int per = ntm * ntn, g = (int)L / per, r = (int)L % per; u.pm = g * ntm + r / ntn; u.pn = g * ntn + r % ntn; return true;
    }
};

struct RangeOrder {
    int ntm, ntn, first, count;
    __device__ bool next(int i, Unit& u) const {
        if (i >= count) return false; const int L = first + i, per = ntm * ntn, g = L / per, r = L % per; u.pm = g * ntm + r / ntn; u.pn = g * ntn + r % ntn; return true;
    }
};
template <class Epi, class Sched, bool ALIGN_EPI>
__device__ __forceinline__ void gemm_phase(LAS unsigned char* lds, const Gemm g, const Sched& S, const Epi& E) {
    const int tid = tidx(), wid = __builtin_amdgcn_readfirstlane(tid >> 6), lane = tid & 63, wr = wid >> 2, wc = wid & 3, fr = lane & 15, fq = lane >> 4;
    const int K = g.K, nt = K / BK;
    unsigned voffA[2], voffB[2];
#pragma unroll
    for (int i = 0; i < 2; ++i) { int R, C; stage_rc(tid * 16 + i * 8192, R, C); const int Rb = (R & ~31) + perm32(R & 31);
        voffA[i] = (unsigned)(R * g.lda + C) * 2u; voffB[i] = (unsigned)(Rb * g.ldb + C) * 2u; }
    const size_t kstep = (size_t)(BK * 2);
    const size_t hstepA = (size_t)HALF * g.lda * 2, hstepB = (size_t)HALF * g.ldb * 2;
    const size_t tstepA = 2 * hstepA, tstepB = 2 * hstepB;
    const unsigned ldsw = (unsigned)wid * 1024u;
    const int aoff = lds_byte(wr * 64 + fr, fq * 8), boff = lds_byte(wc * 32 + fr, fq * 8);
#define PG8_SA(b, h) (((b) * 2 + (h)) * HTB)
#define PG8_SB(b, h) ((4 + (b) * 2 + (h)) * HTB)
#define PG8_STAGE(bufoff, gbase, voff) do { _Pragma("unroll") for (int _i = 0; _i < 2; ++_i) \
        __builtin_amdgcn_global_load_lds((const unsigned*)((const char*)(gbase) + (voff)[_i]), (LAS unsigned*)(lds + (bufoff) + ldsw + _i * 8192), 16, 0, 0); } while (0)
#define PG8_LDA(dst, b, h) do { _Pragma("unroll") for (int m = 0; m < 4; ++m) _Pragma("unroll") for (int k = 0; k < 2; ++k) dst[m][k] = *(const LAS bf16x8*)(lds + PG8_SA(b, h) + aoff + m * 2048 + k * 1024); } while (0)
#define PG8_LDB(dst, b, h) do { _Pragma("unroll") for (int n = 0; n < 2; ++n) _Pragma("unroll") for (int k = 0; k < 2; ++k) dst[n][k] = *(const LAS bf16x8*)(lds + PG8_SB(b, h) + boff + n * 2048 + k * 1024); } while (0)
#define PG8_MMA(ai, bj, At, Bt) do { __builtin_amdgcn_s_setprio(1); _Pragma("unroll") for (int m = 0; m < 4; ++m) _Pragma("unroll") for (int n = 0; n < 2; ++n) _Pragma("unroll") for (int k = 0; k < 2; ++k) \
        acc[ai][bj][m][n] = __builtin_amdgcn_mfma_f32_16x16x32_bf16(Bt[n][k], At[m][k], acc[ai][bj][m][n], 0, 0, 0); __builtin_amdgcn_s_setprio(0); } while (0)
#define PG8_WAIT_V(n) asm volatile("s_waitcnt vmcnt(" #n ")" ::: "memory")
#define PG8_WAIT_L(n) asm volatile("s_waitcnt lgkmcnt(" #n ")" ::: "memory")
#define PG8_BAR __builtin_amdgcn_s_barrier()
#define PG8_SCHED __builtin_amdgcn_sched_barrier(0)
    Unit cur, nxt; int ui = 0;
    if (!S.next(0, cur)) return;
    f32x4 acc[2][2][4][2];
#pragma unroll
    for (int a = 0; a < 2; ++a)
#pragma unroll
        for (int b = 0; b < 2; ++b)
#pragma unroll
            for (int m = 0; m < 4; ++m)
#pragma unroll
                for (int n = 0; n < 2; ++n) acc[a][b][m][n] = (f32x4){0.f, 0.f, 0.f, 0.f};
    bf16x8 At[4][2], B0[2][2], B1[2][2];
    const char* cA = (const char*)g.A + (size_t)cur.pm * tstepA; const char* cB = (const char*)g.Bt + (size_t)cur.pn * tstepB;
    PG8_STAGE(PG8_SB(0, 0), cB, voffB); PG8_STAGE(PG8_SB(0, 1), cB + hstepB, voffB); PG8_STAGE(PG8_SA(0, 0), cA, voffA); PG8_STAGE(PG8_SA(0, 1), cA + hstepA, voffA);
    if (wr == 1) PG8_BAR;
    PG8_WAIT_V(2); PG8_BAR;
    PG8_STAGE(PG8_SB(1, 0), cB + kstep, voffB); PG8_STAGE(PG8_SA(1, 0), cA + kstep, voffA); PG8_STAGE(PG8_SB(1, 1), cB + hstepB + kstep, voffB);
    PG8_WAIT_V(6); PG8_BAR;
    for (;;) {
        const bool has_next = S.next(ui + 1, nxt);
        const char* nA = has_next ? (const char*)g.A + (size_t)nxt.pm * tstepA : cA; const char* nB = has_next ? (const char*)g.Bt + (size_t)nxt.pn * tstepB : cB;
        for (int t = 0; t < nt; t += 2) {
            const bool last = (t == nt - 2);
            const char* a1 = cA + (size_t)(t + 1) * kstep;
            const char* a2 = last ? nA : cA + (size_t)(t + 2) * kstep; const char* b2 = last ? nB : cB + (size_t)(t + 2) * kstep;
            const char* a3 = a2 + kstep; const char* b3 = b2 + kstep;
            PG8_LDB(B0, 0, 0); PG8_LDB(B1, 0, 1); PG8_SCHED; PG8_LDA(At, 0, 0); PG8_STAGE(PG8_SA(1, 1), a1 + hstepA, voffA);
            PG8_WAIT_V(8); PG8_WAIT_L(0); PG8_BAR; PG8_MMA(0, 0, At, B0); PG8_MMA(0, 1, At, B1); PG8_BAR; PG8_SCHED;
            PG8_LDA(At, 0, 1); PG8_STAGE(PG8_SB(0, 0), b2, voffB); PG8_STAGE(PG8_SB(0, 1), b2 + hstepB, voffB); PG8_STAGE(PG8_SA(0, 0), a2, voffA);
            PG8_WAIT_V(8); PG8_WAIT_L(0); PG8_BAR; PG8_MMA(1, 0, At, B0); PG8_MMA(1, 1, At, B1); PG8_BAR; PG8_SCHED;
            PG8_LDB(B0, 1, 0); PG8_LDB(B1, 1, 1); PG8_SCHED; PG8_LDA(At, 1, 0); PG8_STAGE(PG8_SA(0, 1), a2 + hstepA, voffA);
            PG8_WAIT_V(8); PG8_WAIT_L(0); PG8_BAR; PG8_MMA(0, 0, At, B0); PG8_MMA(0, 1, At, B1); PG8_BAR; PG8_SCHED;
            PG8_LDA(At, 1, 1); PG8_STAGE(PG8_SB(1, 0), b3, voffB); PG8_STAGE(PG8_SB(1, 1), b3 + hstepB, voffB); PG8_STAGE(PG8_SA(1, 0), a3, voffA);
            PG8_WAIT_V(8); PG8_WAIT_L(0); PG8_BAR; PG8_MMA(1, 0, At, B0); PG8_MMA(1, 1, At, B1); PG8_BAR; PG8_SCHED;
        }
        if constexpr (ALIGN_EPI) { if (wr == 0) PG8_BAR; }
        { int fr_ = fr, fq_ = fq; asm volatile("" : "+v"(fr_), "+v"(fq_)); if constexpr (!Epi::AFTER_DRAIN) E(acc, cur, wr, wc, fr_, fq_); }
        if (!has_next) break;
#pragma unroll
        for (int a = 0; a < 2; ++a)
#pragma unroll
            for (int b = 0; b < 2; ++b)
#pragma unroll
                for (int m = 0; m < 4; ++m)
#pragma unroll
                    for (int n = 0; n < 2; ++n) acc[a][b][m][n] = (f32x4){0.f, 0.f, 0.f, 0.f};
        cur = nxt; cA = nA; cB = nB; ++ui;
        if constexpr (ALIGN_EPI) { if (wr == 1) PG8_BAR; }
    }
    PG8_WAIT_V(0);
    if constexpr (!ALIGN_EPI) { if (wr == 0) PG8_BAR; }
    PG8_BAR;
    if constexpr (Epi::AFTER_DRAIN) { int fr_ = fr, fq_ = fq; asm volatile("" : "+v"(fr_), "+v"(fq_)); E.fused(acc, cur, wr, wc, fr_, fq_); }
#undef PG8_SA
#undef PG8_SB
#undef PG8_STAGE
#undef PG8_LDA
#undef PG8_LDB
#undef PG8_MMA
#undef PG8_WAIT_V
#undef PG8_WAIT_L
#undef PG8_BAR
#undef PG8_SCHED
}
}
using pg8::Unit;
typedef f32x4 Acc[2][2][4][2];

#define EPI_ROWS for (int ai = 0; ai < 2; ++ai) _Pragma("unroll") for (int m = 0; m < 4; ++m)

struct EpiGateUp {
    static constexpr bool AFTER_DRAIN = false;
    bf16_t* O; const float* ss;
    __device__ __forceinline__ void operator()(const Acc& acc, const Unit& u, int wr, int wc, int fr, int fq) const {
#pragma unroll
        EPI_ROWS {
            const int row = u.pm * 256 + ai * 128 + wr * 64 + m * 16 + fr;
            const float s = inv_rms(ss[row]);
            f32x4 o[2];
#pragma unroll
            for (int n = 0; n < 2; ++n) { const f32x4 g = acc[ai][0][m][n] * s, up = acc[ai][1][m][n] * s;
#pragma unroll
                for (int j = 0; j < 4; ++j) o[n][j] = g[j] * fast_sigmoid(g[j]) * up[j]; }
            *(u32x4*)(O + (size_t)row * FF + u.pn * 128 + wc * 32 + 8 * fq) = pack8(o[0], o[1]);
        }
    }
};

template <bool WB> struct EpiRes {
    static constexpr bool AFTER_DRAIN = false;
    const float* Xin; float* Xout; bf16_t* Xb; float* rowss; float coef;
    __device__ __forceinline__ void operator()(const Acc& acc, const Unit& u, int wr, int wc, int fr, int fq) const {
#pragma unroll
        EPI_ROWS {
            const int row = u.pm * 256 + ai * 128 + wr * 64 + m * 16 + fr;
            const size_t off = (size_t)row * DM + u.pn * 256 + wc * 32 + 8 * fq;
            float ss = 0.f;
#pragma unroll
            for (int bj = 0; bj < 2; ++bj) {
                const f32x4 x0 = *(const f32x4*)(Xin + off + bj * 128), x1 = *(const f32x4*)(Xin + off + bj * 128 + 4);
                const f32x4 o0 = x0 + acc[ai][bj][m][0] * coef, o1 = x1 + acc[ai][bj][m][1] * coef;
                *(f32x4*)(Xout + off + bj * 128) = o0; *(f32x4*)(Xout + off + bj * 128 + 4) = o1;
                ss += o0[0] * o0[0] + o0[1] * o0[1] + o0[2] * o0[2] + o0[3] * o0[3] + o1[0] * o1[0] + o1[1] * o1[1] + o1[2] * o1[2] + o1[3] * o1[3];
                if (WB) *(u32x4*)(Xb + off + bj * 128) = pack8(o0, o1);
            }
            ss += __shfl_xor(ss, 16); ss += __shfl_xor(ss, 32);
            if (fq == 0) atomicAdd(rowss + row, ss);
        }
    }
};

struct EpiWin {
    static constexpr bool AFTER_DRAIN = false;
    const float* ss; bf16_t* AP; bf16_t* Q; bf16_t* Kb; bf16_t* VT; bf16_t* GS; bf16_t* GA; const float* rope; float* kmean;
    __device__ __forceinline__ void operator()(const Acc& acc, const Unit& u, int wr, int wc, int fr, int fq) const {
        const int pn = u.pn;
        if (pn < 2) {
            int pm_ = u.pm; asm volatile("" : "+s"(pm_));
#pragma unroll
            EPI_ROWS {
                const int row = pm_ * 256 + ai * 128 + wr * 64 + m * 16 + fr; const float s = inv_rms(ss[row]);
                const int b = row >> 13, tok = row & 8191, c = tok >> 5, sidx = tok & 31;
#pragma unroll
                for (int bj = 0; bj < 2; ++bj) { const int col = pn * 256 + bj * 128 + wc * 32 + 8 * fq; const int g = col >> 4, hh = col & 15;
                    *(u32x4*)(AP + (size_t)(g * 512 + b * 256 + c) * AK + sidx * 16 + hh) = pack8(acc[ai][bj][m][0] * s, acc[ai][bj][m][1] * s); }
            }
        } else if (pn < 6) {
            int pm_ = u.pm; asm volatile("" : "+s"(pm_));
            const bool isq = pn < 4;
            bf16_t* dst = isq ? Q : Kb; const float osc = isq ? QSCALE : 1.f;
            float ks[2][8];
#pragma unroll
            for (int bj = 0; bj < 2; ++bj)
#pragma unroll
                for (int e = 0; e < 8; ++e) ks[bj][e] = 0.f;
#pragma unroll
            EPI_ROWS {
                const int row = pm_ * 256 + ai * 128 + wr * 64 + m * 16 + fr; const float s = inv_rms(ss[row]) * osc;
                const int tok = row & 8191; const int i0 = (wc & 1) * 16 + 4 * fq;
                const f32x4 cs = *(const f32x4*)(rope + (size_t)tok * 32 + i0), sn = *(const f32x4*)(rope + (size_t)SEQ * 32 + (size_t)tok * 32 + i0);
#pragma unroll
                for (int bj = 0; bj < 2; ++bj) { const int head = (pn & 1) * 4 + 2 * bj + (wc >> 1);
                    const f32x4 x1 = acc[ai][bj][m][0] * s, x2 = acc[ai][bj][m][1] * s;
                    const f32x4 o1 = x1 * cs - x2 * sn, o2 = x2 * cs + x1 * sn;
                    u32x2 w1, w2; w1.x = cvt_pk_bf16(o1[0], o1[1]); w1.y = cvt_pk_bf16(o1[2], o1[3]); w2.x = cvt_pk_bf16(o2[0], o2[1]); w2.y = cvt_pk_bf16(o2[2], o2[3]);
                    bf16_t* p = isq ? dst + (size_t)row * 512 + head * 64 + i0 : dst + ((size_t)(((row >> 13) * 8 + head)) * SEQ + tok) * 64 + i0;
                    *(u32x2*)p = w1; *(u32x2*)(p + 32) = w2;
#pragma unroll
                    for (int e = 0; e < 4; ++e) { ks[bj][e] += o1[e]; ks[bj][4 + e] += o2[e]; asm volatile("" : "+v"(ks[bj][e]), "+v"(ks[bj][4 + e])); } }
                asm volatile("" ::: "memory");
            }
            if (!isq) {
                const int b = (pm_ * 256) >> 13, blk = pm_ & 31; const int i0 = (wc & 1) * 16 + 4 * fq;
#pragma unroll
                for (int bj = 0; bj < 2; ++bj) { const int head = (pn & 1) * 4 + 2 * bj + (wc >> 1);
#pragma unroll
                    for (int e = 0; e < 8; ++e) { float v = ks[bj][e]; v += __shfl_xor(v, 1); v += __shfl_xor(v, 2); v += __shfl_xor(v, 4); v += __shfl_xor(v, 8);
                        if (fr == 0) atomicAdd(kmean + (size_t)((b * 8 + head) * 32 + blk) * 64 + i0 + (e & 3) + 32 * (e >> 2), v); } }
            }
        } else if (pn < 8) {
            int pm_ = u.pm; asm volatile("" : "+s"(pm_));
#pragma unroll
            EPI_ROWS {
                const int row = pm_ * 256 + ai * 128 + wr * 64 + m * 16 + fr; const float s = inv_rms(ss[row]);
                const int b = row >> 13, tok = row & 8191;
#pragma unroll
                for (int bj = 0; bj < 2; ++bj) { const int col = (pn - 6) * 256 + bj * 128 + wc * 32 + 8 * fq; const int head = col >> 6, d0 = col & 63;
                    bf16_t* p = VT + ((size_t)(((b * 8 + head) * 32 + (tok >> 8)) * 64 + d0)) * 256 + (tok & 255);
                    const f32x4 v0 = acc[ai][bj][m][0] * s, v1 = acc[ai][bj][m][1] * s;
#pragma unroll
                    for (int e = 0; e < 4; ++e) { p[e * 256] = (bf16_t)(cvt_pk_bf16(v0[e], 0.f) & 0xffffu); p[(4 + e) * 256] = (bf16_t)(cvt_pk_bf16(v1[e], 0.f) & 0xffffu); } }
                asm volatile("" ::: "memory");
            }
        } else {
            int pm_ = u.pm; asm volatile("" : "+s"(pm_));
            bf16_t* dst = pn < 12 ? GS : GA; const int cb = ((pn - 8) & 3) * 256;
#pragma unroll
            EPI_ROWS {
                const int row = pm_ * 256 + ai * 128 + wr * 64 + m * 16 + fr; const float s = inv_rms(ss[row]);
#pragma unroll
                for (int bj = 0; bj < 2; ++bj) { const int col = cb + bj * 128 + wc * 32 + 8 * fq;
                    *(u32x4*)(dst + (size_t)row * DM + col) = pack8(sigmoid4(acc[ai][bj][m][0] * s), sigmoid4(acc[ai][bj][m][1] * s)); }
            }
        }
    }
};


template <bool IN_BF16> struct EpiResB {
    static constexpr bool AFTER_DRAIN = false;
    const void* Xin; bf16_t* Xb; float* rowss; float coef;
    __device__ __forceinline__ void operator()(const Acc& acc, const Unit& u, int wr, int wc, int fr, int fq) const {
#pragma unroll
        EPI_ROWS {
            const int row = u.pm * 256 + ai * 128 + wr * 64 + m * 16 + fr;
            const size_t off = (size_t)row * DM + u.pn * 256 + wc * 32 + 8 * fq;
            float ss = 0.f;
#pragma unroll
            for (int bj = 0; bj < 2; ++bj) {
                f32x4 x0, x1;
                if (IN_BF16) unpack8(*(const u32x4*)((const bf16_t*)Xin + off + bj * 128), x0, x1);
                else { x0 = *(const f32x4*)((const float*)Xin + off + bj * 128); x1 = *(const f32x4*)((const float*)Xin + off + bj * 128 + 4); }
                const f32x4 o0 = x0 + acc[ai][bj][m][0] * coef, o1 = x1 + acc[ai][bj][m][1] * coef;
                ss += o0[0] * o0[0] + o0[1] * o0[1] + o0[2] * o0[2] + o0[3] * o0[3] + o1[0] * o1[0] + o1[1] * o1[1] + o1[2] * o1[2] + o1[3] * o1[3];
                *(u32x4*)(Xb + off + bj * 128) = pack8(o0, o1);
            }
            ss += __shfl_xor(ss, 16); ss += __shfl_xor(ss, 32);
            if (fq == 0) atomicAdd(rowss + row, ss);
        }
    }
};

struct EpiResF {
    static constexpr bool AFTER_DRAIN = false;
    const bf16_t* Xin; float* Xout; float* rowss; float coef;
    __device__ __forceinline__ void operator()(const Acc& acc, const Unit& u, int wr, int wc, int fr, int fq) const {
#pragma unroll
        EPI_ROWS {
            const int row = u.pm * 256 + ai * 128 + wr * 64 + m * 16 + fr;
            const size_t off = (size_t)row * DM + u.pn * 256 + wc * 32 + 8 * fq;
            float ss = 0.f;
#pragma unroll
            for (int bj = 0; bj < 2; ++bj) {
                f32x4 x0, x1; unpack8(*(const u32x4*)(Xin + off + bj * 128), x0, x1);
                const f32x4 o0 = x0 + acc[ai][bj][m][0] * coef, o1 = x1 + acc[ai][bj][m][1] * coef;
                *(f32x4*)(Xout + off + bj * 128) = o0; *(f32x4*)(Xout + off + bj * 128 + 4) = o1;
                ss += o0[0] * o0[0] + o0[1] * o0[1] + o0[2] * o0[2] + o0[3] * o0[3] + o1[0] * o1[0] + o1[1] * o1[1] + o1[2] * o1[2] + o1[3] * o1[3];
            }
            ss += __shfl_xor(ss, 16); ss += __shfl_xor(ss, 32);
            if (fq == 0) atomicAdd(rowss + row, ss);
        }
    }
};

struct EpiResNorm {
    static constexpr bool AFTER_DRAIN = true;
    const bf16_t* Xin; float* Xout; float* rowss; unsigned* pcnt; const float* gain; float coef;
    __device__ __forceinline__ void operator()(Acc&, const Unit&, int, int, int, int) const {}
    __device__ __forceinline__ void fused(Acc& acc, const Unit& u, int wr, int wc, int fr, int fq) const {
#pragma unroll
        EPI_ROWS {
            const int row = u.pm * 256 + ai * 128 + wr * 64 + m * 16 + fr;
            const size_t off = (size_t)row * DM + u.pn * 256 + wc * 32 + 8 * fq;
            float ss = 0.f;
#pragma unroll
            for (int bj = 0; bj < 2; ++bj) {
                f32x4 x0, x1; unpack8(*(const u32x4*)(Xin + off + bj * 128), x0, x1);
                const f32x4 o0 = x0 + acc[ai][bj][m][0] * coef, o1 = x1 + acc[ai][bj][m][1] * coef;
                acc[ai][bj][m][0] = o0; acc[ai][bj][m][1] = o1;
                ss += o0[0] * o0[0] + o0[1] * o0[1] + o0[2] * o0[2] + o0[3] * o0[3] + o1[0] * o1[0] + o1[1] * o1[1] + o1[2] * o1[2] + o1[3] * o1[3];
            }
            ss += __shfl_xor(ss, 16); ss += __shfl_xor(ss, 32);
            if (fq == 0) atomicAdd(rowss + row, ss);
        }
        asm volatile("s_waitcnt vmcnt(0)" ::: "memory");
        __syncthreads();
        if (tidx() == 0) {
            __builtin_amdgcn_fence(__ATOMIC_RELEASE, "agent");
            asm volatile("s_waitcnt vmcnt(0)" ::: "memory");
            __hip_atomic_fetch_add(pcnt + u.pm * 64, 1u, __ATOMIC_RELAXED, __HIP_MEMORY_SCOPE_AGENT);
            unsigned sp = 0;
            while (__hip_atomic_load(pcnt + u.pm * 64, __ATOMIC_RELAXED, __HIP_MEMORY_SCOPE_AGENT) < 4u) { __builtin_amdgcn_s_sleep(1); if (++sp > (1u << 22)) break; }
            __builtin_amdgcn_fence(__ATOMIC_ACQUIRE, "agent");
            asm volatile("s_waitcnt vmcnt(0)" ::: "memory");
        }
        __syncthreads();
#pragma unroll
        EPI_ROWS {
            const int row = u.pm * 256 + ai * 128 + wr * 64 + m * 16 + fr;
            const size_t off = (size_t)row * DM + u.pn * 256 + wc * 32 + 8 * fq;
            const float s = inv_rms(__hip_atomic_load(rowss + row, __ATOMIC_RELAXED, __HIP_MEMORY_SCOPE_AGENT));
#pragma unroll
            for (int bj = 0; bj < 2; ++bj) { const int col = u.pn * 256 + bj * 128 + wc * 32 + 8 * fq;
                const f32x4 g0 = *(const f32x4*)(gain + col), g1 = *(const f32x4*)(gain + col + 4);
                *(f32x4*)(Xout + off + bj * 128) = acc[ai][bj][m][0] * s * g0; *(f32x4*)(Xout + off + bj * 128 + 4) = acc[ai][bj][m][1] * s * g1; }
        }
    }
};

struct EpiS {
    static constexpr bool AFTER_DRAIN = false;
    float* S;
    __device__ __forceinline__ void operator()(const Acc& acc, const Unit& u, int wr, int wc, int fr, int fq) const {
#pragma unroll
        EPI_ROWS {
            const int row = u.pm * 256 + ai * 128 + wr * 64 + m * 16 + fr;
            float* p = S + (size_t)row * 128 + wc * 32 + 8 * fq; *(f32x4*)p = acc[ai][0][m][0]; *(f32x4*)(p + 4) = acc[ai][0][m][1];
        }
    }
};
struct EpiY {
    static constexpr bool AFTER_DRAIN = false;
    bf16_t* Y;
    __device__ __forceinline__ void operator()(const Acc& acc, const Unit& u, int wr, int wc, int fr, int fq) const {
#pragma unroll
        EPI_ROWS {
            const int row = u.pm * 256 + ai * 128 + wr * 64 + m * 16 + fr; const int g = row >> 9, b = (row >> 8) & 1, c = row & 255;
#pragma unroll
            for (int bj = 0; bj < 2; ++bj) { const int n = (u.pn & 1) * 256 + bj * 128 + wc * 32 + 8 * fq; const int t = n >> 4, hh = n & 15;
                f32x4 o0, o1;
#pragma unroll
                for (int e = 0; e < 4; ++e) { o0[e] = gelu_tanh(acc[ai][bj][m][0][e]); o1[e] = gelu_tanh(acc[ai][bj][m][1][e]); }
                *(u32x4*)(Y + (size_t)(b * SEQ + c * TCH + t) * 512 + g * 16 + hh) = pack8(o0, o1); }
        }
    }
};
struct EpiGlu {
    static constexpr bool AFTER_DRAIN = false;
    const bf16_t* Y; const float* bias; bf16_t* O;
    __device__ __forceinline__ void operator()(const Acc& acc, const Unit& u, int wr, int wc, int fr, int fq) const {
#pragma unroll
        EPI_ROWS {
            const int row = u.pm * 256 + ai * 128 + wr * 64 + m * 16 + fr;
#pragma unroll
            for (int bj = 0; bj < 2; ++bj) { const int col = u.pn * 256 + bj * 128 + wc * 32 + 8 * fq;
                const f32x4 b0 = *(const f32x4*)(bias + col), b1 = *(const f32x4*)(bias + col + 4);
                f32x4 y0, y1; unpack8(*(const u32x4*)(Y + (size_t)row * 512 + col), y0, y1);
                *(u32x4*)(O + (size_t)row * 512 + col) = pack8(y0 * sigmoid4(acc[ai][bj][m][0] + b0), y1 * sigmoid4(acc[ai][bj][m][1] + b1)); }
        }
    }
};
template <int MODE> struct EpiBranch {
    static constexpr bool AFTER_DRAIN = false;
    bf16_t* G1; bf16_t* G2;
    __device__ __forceinline__ void operator()(const Acc& acc, const Unit& u, int wr, int wc, int fr, int fq) const {
#pragma unroll
        EPI_ROWS {
            const int row = u.pm * 256 + ai * 128 + wr * 64 + m * 16 + fr;
#pragma unroll
            for (int bj = 0; bj < 2; ++bj) { const size_t off = (size_t)row * DM + u.pn * 256 + bj * 128 + wc * 32 + 8 * fq;
                f32x4 a0, a1; unpack8(*(const u32x4*)(G1 + off), a0, a1);
                if (MODE == 0) { *(u32x4*)(G1 + off) = pack8(a0 * acc[ai][bj][m][0], a1 * acc[ai][bj][m][1]); }
                else { f32x4 g0, g1; unpack8(*(const u32x4*)(G2 + off), g0, g1); *(u32x4*)(G2 + off) = pack8(a0 + g0 * acc[ai][bj][m][0], a1 + g1 * acc[ai][bj][m][1]); } }
        }
    }
};

struct WJob { const float* s0; const float* s1; const float* gain; bf16_t* dst; int K, ld, ndst, mode; };
__device__ __forceinline__ WJob get_job(ArgsP a, int j) {
    unsigned char* ws = a->ws; WJob J;
    switch (j) {
    case 0: J = WJob{a->in[2], a->in[3], a->in[1], (bf16_t*)(ws + WS_W1GU), 1024, 2816, 5632, 1}; break;
    case 1: J = WJob{a->in[4], a->in[4], nullptr, (bf16_t*)(ws + WS_W1D), 2816, 1024, 1024, 0}; break;
    case 2: J = WJob{a->in[6], a->in[6], a->in[5], (bf16_t*)(ws + WS_WIN), 1024, 4096, 4096, 2}; break;
    case 3: J = WJob{a->in[15], a->in[15], nullptr, (bf16_t*)(ws + WS_WGLU), 512, 512, 512, 0}; break;
    case 4: J = WJob{a->in[17], a->in[17], nullptr, (bf16_t*)(ws + WS_WBS), 512, 1024, 1024, 0}; break;
    case 5: J = WJob{a->in[18], a->in[18], nullptr, (bf16_t*)(ws + WS_WBA), 512, 1024, 1024, 0}; break;
    case 6: J = WJob{a->in[19], a->in[19], nullptr, (bf16_t*)(ws + WS_WOUT), 1024, 1024, 1024, 0}; break;
    case 7: J = WJob{a->in[21], a->in[22], a->in[20], (bf16_t*)(ws + WS_W2GU), 1024, 2816, 5632, 1}; break;
    default: J = WJob{a->in[23], a->in[23], nullptr, (bf16_t*)(ws + WS_W2D), 2816, 1024, 1024, 0}; break;
    }
    return J;
}
__device__ __forceinline__ void wconv_item(const WJob& J, int item) {
    const int nkb = J.K >> 6, kb = item % nkb, nb = item / nkb;
    const int tid = tidx(), lane = tid & 63, wave = tid >> 6;
    const int n = nb * 256 + lane * 4, k0 = kb * 64 + wave * 8;
    const float* src = J.s0; int sc = n;
    if (J.mode == 1) { const int tl = n >> 8, wi = n & 255; if (wi >= 128) src = J.s1; sc = tl * 128 + (wi & 127); }
    else if (J.mode == 2) { if (n >= 512 && n < 1536) { const int t_ = n & 255, bj = t_ >> 7, wc = (t_ >> 5) & 3, fq = (t_ >> 3) & 3, n2 = (t_ >> 2) & 1;
            sc = (n & ~255) + 64 * (2 * bj + (wc >> 1)) + (wc & 1) * 16 + 4 * fq + 32 * n2; } }
    f32x4 v[8];
#pragma unroll
    for (int e = 0; e < 8; ++e) v[e] = *(const f32x4*)(src + (size_t)(k0 + e) * J.ld + sc);
    if (J.gain) {
#pragma unroll
        for (int e = 0; e < 8; ++e) v[e] = v[e] * J.gain[k0 + e]; }
#pragma unroll
    for (int j = 0; j < 4; ++j) { u32x4 w; w.x = cvt_pk_bf16(v[0][j], v[1][j]); w.y = cvt_pk_bf16(v[2][j], v[3][j]); w.z = cvt_pk_bf16(v[4][j], v[5][j]); w.w = cvt_pk_bf16(v[6][j], v[7][j]);
        *(u32x4*)(J.dst + (size_t)(n + j) * J.K + k0) = w; }
}

__device__ __forceinline__ void ssm_precompute(LAS unsigned char* lds, ArgsP a, int g, int hsel) {
    LAS float* pwr = (LAS float*)lds; LAS float* pwi = pwr + 33 * 64; LAS float* Bbr = pwi + 33 * 64; LAS float* Bbi = Bbr + 1024;
    LAS float* Cr = Bbi + 1024; LAS float* Ci = Cr + 1024; LAS float* Kt = Ci + 1024;
    const float* a_re = a->in[7]; const float* a_im = a->in[8]; const float* b_re = a->in[9]; const float* b_im = a->in[10];
    const float* c_re = a->in[11]; const float* c_im = a->in[12]; const float* dsk = a->in[13]; const float* log_dt = a->in[14];
    bf16_t* BTY = (bf16_t*)(a->ws + WS_BTY); bf16_t* BTS = (bf16_t*)(a->ws + WS_BTS); float* aT = (float*)(a->ws + WS_AT);
    const int tid = tidx();
    const double dt = exp_d((double)log_dt[g]);
    for (int it = tid; it < 33 * 64; it += 512) { const int tau = it >> 6, p = it & 63; const double ar = a_re[g * 64 + p], ai = a_im[g * 64 + p];
        const double mag = exp_d(tau * ar * dt); double sn, cs; sincos_d(tau * ai * dt, sn, cs); pwr[it] = (float)(mag * cs); pwi[it] = (float)(mag * sn);
        if (tau == 32 && hsel == 0) { aT[(g * 64 + p) * 2] = (float)(mag * cs); aT[(g * 64 + p) * 2 + 1] = (float)(mag * sn); } }
    for (int it = tid; it < 1024; it += 512) { const int p = it >> 4, hh = it & 15; const double ar = a_re[g * 64 + p], ai = a_im[g * 64 + p];
        const double mag = exp_d(ar * dt); double sn, cs; sincos_d(ai * dt, sn, cs); const double nr = mag * cs - 1.0, ni = mag * sn, den = ar * ar + ai * ai;
        const double fr = (nr * ar + ni * ai) / den, fi = (ni * ar - nr * ai) / den; const double br = b_re[(g * 64 + p) * 16 + hh], bi = b_im[(g * 64 + p) * 16 + hh];
        Bbr[it] = (float)(fr * br - fi * bi); Bbi[it] = (float)(fr * bi + fi * br); }
    for (int it = tid; it < 1024; it += 512) { Cr[it] = c_re[g * 1024 + it]; Ci[it] = c_im[g * 1024 + it]; }
    __syncthreads();
    { const int hp = tid & 15, tau = tid >> 4;
      float kacc[16];
#pragma unroll
      for (int h = 0; h < 16; ++h) kacc[h] = 0.f;
      for (int p = 0; p < 64; ++p) { const float pr = pwr[tau * 64 + p], pi = pwi[tau * 64 + p], br = Bbr[p * 16 + hp], bi = Bbi[p * 16 + hp];
          const float er = pr * br - pi * bi, ei = pr * bi + pi * br;
#pragma unroll
          for (int h = 0; h < 16; ++h) kacc[h] += Cr[h * 64 + p] * er - Ci[h * 64 + p] * ei; }
#pragma unroll
      for (int h = 0; h < 16; ++h) { float v = kacc[h]; if (tau == 0 && h == hp) v += dsk[g * 16 + h]; Kt[(tau * 16 + h) * 16 + hp] = v; } }
    __syncthreads();
    for (int it = tid; it < 256 * 80; it += 512) { const int nl = it / 80, o = it - nl * 80, n = hsel * 256 + nl, t = n >> 4, h = n & 15, k0 = o * 8; f32x4 v0, v1;
        if (k0 < 512) { const int s = k0 >> 4, hp0 = k0 & 15;
#pragma unroll
            for (int e = 0; e < 4; ++e) { v0[e] = (s <= t) ? Kt[((t - s) * 16 + h) * 16 + hp0 + e] : 0.f; v1[e] = (s <= t) ? Kt[((t - s) * 16 + h) * 16 + hp0 + 4 + e] : 0.f; } }
        else { const bool im = k0 >= 576; const int p0 = k0 - (im ? 576 : 512);
#pragma unroll
            for (int e = 0; e < 8; ++e) { const int p = p0 + e; const float cr = Cr[h * 64 + p], ci = Ci[h * 64 + p], pr = pwr[(t + 1) * 64 + p], pi = pwi[(t + 1) * 64 + p];
                const float v = im ? -(cr * pi + ci * pr) : (cr * pr - ci * pi); if (e < 4) v0[e] = v; else v1[e - 4] = v; } }
        *(u32x4*)(BTY + ((size_t)(g * 512 + n)) * AK + k0) = pack8(v0, v1); }
    for (int it = tid; it < 128 * 64; it += 512) { const int n = hsel * 128 + (it >> 6), o = it & 63, k0 = o * 8, s = k0 >> 4, hp0 = k0 & 15; f32x4 v0 = {0.f, 0.f, 0.f, 0.f}, v1 = v0;
        if (n < 128) { const int p = n & 63, tau = 31 - s; const float pr = pwr[tau * 64 + p], pi = pwi[tau * 64 + p];
#pragma unroll
            for (int e = 0; e < 8; ++e) { const float br = Bbr[p * 16 + hp0 + e], bi = Bbi[p * 16 + hp0 + e]; const float v = (n < 64) ? (pr * br - pi * bi) : (pr * bi + pi * br);
                if (e < 4) v0[e] = v; else v1[e - 4] = v; } }
        *(u32x4*)(BTS + ((size_t)(g * 256 + n)) * 512 + k0) = pack8(v0, v1); }
    __syncthreads();
}

__device__ __forceinline__ void p0_prologue(LAS unsigned char* lds, ArgsP a) {
    const int tid = tidx(), lane = tid & 63, wave = tid >> 6, G = gridDim.x, bx = blockIdx.x;
    unsigned char* ws = a->ws;
    const bool split = G >= 128;
    if (!split || bx < 64) for (int u = bx; u < 64; u += G) ssm_precompute(lds, a, u >> 1, u & 1);
    if (split && bx < 64) return;
    const int nw = split ? G - 64 : G, wk = split ? bx - 64 : bx;
    { float* z1 = (float*)(ws + WS_RS1); for (int i = wk * 512 + tid; i < 3 * 16384; i += nw * 512) z1[i] = 0.f;
      float* z2 = (float*)(ws + WS_KMEAN); for (int i = wk * 512 + tid; i < 32768; i += nw * 512) z2[i] = 0.f;
      unsigned* z3 = (unsigned*)(ws + WS_PCNT); for (int i = wk * 512 + tid; i < 64 * 64 + 128; i += nw * 512) z3[i] = 0u; }
    { int gi = wk, base = 0; const int jend = (G == 256) ? 2 : 9;
      for (int j = 0; j < jend; ++j) { const WJob J = get_job(a, j); const int cnt = (J.K >> 6) * (J.ndst >> 8);
          while (gi < base + cnt) { wconv_item(J, gi - base); gi += nw; } base += cnt; } }
    { const float* x = a->in[0]; bf16_t* xb = (bf16_t*)(ws + WS_XB); float* rs0 = (float*)(ws + WS_RS0);
      for (int row = (wk * 8 + wave) * 2; row < M; row += nw * 16) { const f32x4* xr = (const f32x4*)(x + (size_t)row * DM); float ss0 = 0.f, ss1 = 0.f; f32x4 v[8];
#pragma unroll
          for (int i = 0; i < 8; ++i) v[i] = xr[lane + 64 * i];
#pragma unroll
          for (int i = 0; i < 8; ++i) { const float q = v[i][0] * v[i][0] + v[i][1] * v[i][1] + v[i][2] * v[i][2] + v[i][3] * v[i][3]; if (i < 4) ss0 += q; else ss1 += q;
              u32x2 w; w.x = cvt_pk_bf16(v[i][0], v[i][1]); w.y = cvt_pk_bf16(v[i][2], v[i][3]); *(u32x2*)(xb + (size_t)row * DM + (lane + 64 * i) * 4) = w; }
#pragma unroll
          for (int o = 32; o > 0; o >>= 1) { ss0 += __shfl_xor(ss0, o); ss1 += __shfl_xor(ss1, o); }
          if (lane == 0) { rs0[row] = ss0; rs0[row + 1] = ss1; } } }
    { float* rope = (float*)(ws + WS_ROPE);
      for (int i = wk * 512 + tid; i < SEQ * 32; i += nw * 512) { const int pos = i >> 5, fi = i & 31;
          const double invf = exp_d(-9.210340371976184 * (double)fi * (1.0 / 32.0)); double sn, cs; sincos_d((double)pos * invf, sn, cs);
          rope[i] = (float)cs; rope[SEQ * 32 + i] = (float)sn; } }
}

#define MFMA32(a, b, c) __builtin_amdgcn_mfma_f32_32x32x16_bf16((a), (b), (c), 0, 0, 0)

__device__ __forceinline__ void moba_assign(const LAS unsigned* mk, int r, int& ql, bool& valid, int& ntile) {
    unsigned tot = 0, word = 0, base = 0; int wsel = 0; bool found = false;
#pragma unroll
    for (int ww = 0; ww < 8; ++ww) { const unsigned m = mk[ww]; const unsigned pc = __popc(m); if (!found && (unsigned)r < tot + pc) { word = m; base = tot; wsel = ww; found = true; } tot += pc; }
    valid = found; ntile = (int)((tot + 31u) >> 5);
    int k = found ? r - (int)base : 0, pos = 0;
#pragma unroll
    for (int sft = 16; sft >= 1; sft >>= 1) { const int c = __popc(word & (((1u << sft) - 1u) << pos)); if (k >= c) { k -= c; pos += sft; } }
    ql = found ? wsel * 32 + (pos & 31) : 0;
}
__device__ __forceinline__ void attn_unit_h(LAS unsigned char* lds, const bf16_t* Q, const bf16_t* Kb, const bf16_t* VT, const float* kmean, bf16_t* O, int b, int h, int qb) {
    const int tid = tidx(), w = tid >> 6, lane = tid & 63, qi = lane & 31, hf = lane >> 5;
    LAS bf16_t* Kt = (LAS bf16_t*)lds;
    LAS bf16_t* Vt = (LAS bf16_t*)(lds + 36864);
    LAS float* km = (LAS float*)(lds + 70656);
    LAS unsigned* msk = (LAS unsigned*)(lds + 78592);
    LAS float* stt = (LAS float*)(lds + 79616);
    const int cur = qb;
    for (int i = tid; i < cur * 64; i += 512) km[i] = kmean[(size_t)((b * 8 + h) * 32) * 64 + i];
    const int row0 = b * SEQ + qb * 256, qown = 32 * w + qi;
    bf16x8 qf[4];
#pragma unroll
    for (int st = 0; st < 4; ++st) qf[st] = *(const bf16x8*)(Q + (size_t)(row0 + qown) * 512 + h * 64 + 16 * st + 8 * hf);
    const int sr = tid >> 3, sc = (tid & 7) * 8;
    const bf16_t* kg = Kb + ((size_t)(b * 8 + h) * SEQ + sr) * 64 + sc;
    const bf16_t* vg = VT + ((size_t)((b * 8 + h) * 32) * 64 + sr) * 256 + sc;
    u32x4 kreg[4], vreg[4];
    { const int kb0 = qb * 256;
#pragma unroll
      for (int p = 0; p < 4; ++p) { kreg[p] = *(const u32x4*)(kg + (size_t)(kb0 + 64 * p) * 64); vreg[p] = *(const u32x4*)(vg + (size_t)(kb0 >> 8) * 16384 + 64 * p); } }
    __syncthreads();
    int i0 = 0, i1 = 1, i2 = 2;
    if (cur > 3) {
        float qv[32];
#pragma unroll
        for (int st = 0; st < 4; ++st)
#pragma unroll
            for (int e = 0; e < 8; ++e) qv[st * 8 + e] = __uint_as_float(((unsigned)(unsigned short)qf[st][e]) << 16);
        float b0 = -3e38f, b1 = -3e38f, b2 = -3e38f;
        for (int j = 0; j < cur; ++j) { float g = 0.f;
#pragma unroll
            for (int st = 0; st < 4; ++st) { const f32x4 k0 = *(const LAS f32x4*)(km + j * 64 + 16 * st + 8 * hf), k1 = *(const LAS f32x4*)(km + j * 64 + 16 * st + 8 * hf + 4);
#pragma unroll
                for (int e = 0; e < 4; ++e) { g += qv[st * 8 + e] * k0[e]; g += qv[st * 8 + 4 + e] * k1[e]; } }
            g += __shfl_xor(g, 32);
            if (g > b0) { b2 = b1; i2 = i1; b1 = b0; i1 = i0; b0 = g; i0 = j; } else if (g > b1) { b2 = b1; i2 = i1; b1 = g; i1 = j; } else if (g > b2) { b2 = g; i2 = j; } }
    }
    for (int j = 0; j < cur; ++j) { const bool sj = (cur <= 3) || j == i0 || j == i1 || j == i2; const unsigned long long bal = __ballot(sj); if (lane == 0) msk[j * 8 + w] = (unsigned)bal; }
#pragma unroll
    for (int p = 0; p < 4; ++p) { *(LAS u32x4*)(Kt + (sr + 64 * p) * 72 + sc) = kreg[p]; *(LAS u32x4*)(Vt + sr * 264 + sc + 64 * p) = vreg[p]; }
    __syncthreads();
    f32x16 o0, o1;
#pragma unroll
    for (int e = 0; e < 16; ++e) { o0[e] = 0.f; o1[e] = 0.f; }
    float mrun = NEGBIG, lrun = 0.f;
    const int krow = (qi & 19) | ((qi & 4) << 1) | ((qi & 8) >> 1);
    int qln = 0, ntn = 0; bool validn = false; bf16x8 gqA[4], gqB[4];
    if (cur > 0) { moba_assign(msk, 32 * w + qi, qln, validn, ntn); if (ntn <= 4) moba_assign(msk, 32 * (w >> 1) + qi, qln, validn, ntn);
#pragma unroll
        for (int st = 0; st < 4; ++st) gqA[st] = *(const bf16x8*)(Q + (size_t)(row0 + qln) * 512 + h * 64 + 16 * st + 8 * hf); }
    int qlc = qown, ntc = 8; bool validc = true; bool pairm = false, second = false; int tq = w;
    { const int blk0 = 0;
    {
        const bool own = true;
        if (blk0 < cur) { const int kb1 = blk0 * 256;
#pragma unroll
            for (int p = 0; p < 4; ++p) { kreg[p] = *(const u32x4*)(kg + (size_t)(kb1 + 64 * p) * 64); vreg[p] = *(const u32x4*)(vg + (size_t)(kb1 >> 8) * 16384 + 64 * p); } }
        if (!own) {
            qlc = qln; ntc = ntn; validc = validn;
            if (blk0 < cur) { moba_assign(msk + blk0 * 8, 32 * w + qi, qln, validn, ntn); if (ntn <= 4) moba_assign(msk + blk0 * 8, 32 * (w >> 1) + qi, qln, validn, ntn);
#pragma unroll
                for (int st = 0; st < 4; ++st) gqA[st] = *(const bf16x8*)(Q + (size_t)(row0 + qln) * 512 + h * 64 + 16 * st + 8 * hf); }
            pairm = ntc <= 4; tq = pairm ? (w >> 1) : w; second = pairm && (w & 1);
            if (second) {
#pragma unroll
                for (int e = 0; e < 16; ++e) { o0[e] = 0.f; o1[e] = 0.f; }
                mrun = NEGBIG; lrun = 0.f;
            } else if (tq < ntc) { const LAS float* sp = stt + qlc * 68;
#pragma unroll
                for (int g4 = 0; g4 < 4; ++g4) { const f32x4 a = *(const LAS f32x4*)(sp + 8 * g4 + 4 * hf), c = *(const LAS f32x4*)(sp + 32 + 8 * g4 + 4 * hf);
#pragma unroll
                    for (int e = 0; e < 4; ++e) { o0[4 * g4 + e] = a[e]; o1[4 * g4 + e] = c[e]; } }
                mrun = sp[64]; lrun = hf == 0 ? sp[65] : 0.f; }
        }
        const bool allowed = own || validc;
        const int tlo = (!own && second) ? 2 : 0, thi = (!own && pairm && !second) ? 2 : 4;
        for (int ti = tlo; ti < thi; ++ti) {
            bool active, partial = false;
            if (own) { const int klo = 64 * ti, qlo = 32 * w; active = !(klo > qlo + 31); partial = (klo + 63 > qlo); }
            else active = (tq < ntc);
            if (active) {
                f32x16 s0, s1;
#pragma unroll
                for (int e = 0; e < 16; ++e) { s0[e] = 0.f; s1[e] = 0.f; }
                const LAS bf16_t* kt = Kt + (64 * ti) * 72;
#pragma unroll
                for (int st = 0; st < 4; ++st) { const bf16x8 a0 = *(const LAS bf16x8*)(kt + krow * 72 + 16 * st + 8 * hf), a1 = *(const LAS bf16x8*)(kt + (32 + krow) * 72 + 16 * st + 8 * hf);
                    s0 = MFMA32(a0, qf[st], s0); s1 = MFMA32(a1, qf[st], s1); }
                if (partial) { const int qrel = 32 * w + qi - 64 * ti;
#pragma unroll
                    for (int e = 0; e < 16; ++e) { const int ko = 16 * (e >> 3) + 8 * hf + (e & 7); if (ko > qrel) s0[e] = NEGBIG; if (ko + 32 > qrel) s1[e] = NEGBIG; } }
                float mx = s0[0];
#pragma unroll
                for (int e = 1; e < 16; ++e) mx = fmaxf(mx, s0[e]);
#pragma unroll
                for (int e = 0; e < 16; ++e) mx = fmaxf(mx, s1[e]);
                if (!allowed) mx = NEGBIG;
                mx = fmaxf(mx, __shfl_xor(mx, 32));
                const bool need = mx > mrun + 40.f;
                if (__ballot(need) != 0ull) {
                    const float mn = need ? mx : mrun, alpha = __builtin_amdgcn_exp2f(mrun - mn); mrun = mn; lrun *= alpha;
#pragma unroll
                    for (int e = 0; e < 16; ++e) { o0[e] *= alpha; o1[e] *= alpha; }
                }
                const float msub = allowed ? mrun : 1e30f;
                f32x2 ps2 = {0.f, 0.f};
#pragma unroll
                for (int e = 0; e < 16; e += 2) { f32x2 d0 = {s0[e], s0[e + 1]}, d1 = {s1[e], s1[e + 1]}; d0 = d0 - msub; d1 = d1 - msub;
                    s0[e] = __builtin_amdgcn_exp2f(d0.x); s0[e + 1] = __builtin_amdgcn_exp2f(d0.y); s1[e] = __builtin_amdgcn_exp2f(d1.x); s1[e + 1] = __builtin_amdgcn_exp2f(d1.y);
                    ps2 = ps2 + (f32x2){s0[e], s0[e + 1]}; ps2 = ps2 + (f32x2){s1[e], s1[e + 1]}; }
                lrun += ps2.x + ps2.y;
                const LAS bf16_t* vt = Vt + 64 * ti;
#pragma unroll
                for (int kh = 0; kh < 2; ++kh)
#pragma unroll
                    for (int s = 0; s < 2; ++s) {
                        union { u32x4 u; bf16x8 v; } pf;
                        if (kh == 0) { pf.u.x = cvt_pk_bf16(s0[8 * s], s0[8 * s + 1]); pf.u.y = cvt_pk_bf16(s0[8 * s + 2], s0[8 * s + 3]); pf.u.z = cvt_pk_bf16(s0[8 * s + 4], s0[8 * s + 5]); pf.u.w = cvt_pk_bf16(s0[8 * s + 6], s0[8 * s + 7]); }
                        else { pf.u.x = cvt_pk_bf16(s1[8 * s], s1[8 * s + 1]); pf.u.y = cvt_pk_bf16(s1[8 * s + 2], s1[8 * s + 3]); pf.u.z = cvt_pk_bf16(s1[8 * s + 4], s1[8 * s + 5]); pf.u.w = cvt_pk_bf16(s1[8 * s + 6], s1[8 * s + 7]); }
                        const bf16x8 v0 = *(const LAS bf16x8*)(vt + qi * 264 + 32 * kh + 16 * s + 8 * hf), v1 = *(const LAS bf16x8*)(vt + (32 + qi) * 264 + 32 * kh + 16 * s + 8 * hf);
                        o0 = MFMA32(v0, pf.v, o0); o1 = MFMA32(v1, pf.v, o1);
                    }
            }
        }
        if (own || (!second && tq < ntc && validc)) {
            const float lt = lrun + __shfl_xor(lrun, 32);
            LAS float* sp = stt + qlc * 68;
#pragma unroll
            for (int g4 = 0; g4 < 4; ++g4) { f32x4 a, c;
#pragma unroll
                for (int e = 0; e < 4; ++e) { a[e] = o0[4 * g4 + e]; c[e] = o1[4 * g4 + e]; }
                *(LAS f32x4*)(sp + 8 * g4 + 4 * hf) = a; *(LAS f32x4*)(sp + 32 + 8 * g4 + 4 * hf) = c; }
            if (hf == 0) { sp[64] = mrun; sp[65] = lt; }
        }
        __syncthreads();
        if (!own && second && tq < ntc && validc) {
            const float lB = lrun + __shfl_xor(lrun, 32);
            LAS float* sp = stt + qlc * 68;
            const float mA = sp[64], lA = sp[65], mM = fmaxf(mA, mrun), ca = __builtin_amdgcn_exp2f(mA - mM), cb = __builtin_amdgcn_exp2f(mrun - mM);
#pragma unroll
            for (int g4 = 0; g4 < 4; ++g4) { f32x4 x = *(const LAS f32x4*)(sp + 8 * g4 + 4 * hf), y = *(const LAS f32x4*)(sp + 32 + 8 * g4 + 4 * hf);
#pragma unroll
                for (int e = 0; e < 4; ++e) { x[e] = x[e] * ca + o0[4 * g4 + e] * cb; y[e] = y[e] * ca + o1[4 * g4 + e] * cb; }
                *(LAS f32x4*)(sp + 8 * g4 + 4 * hf) = x; *(LAS f32x4*)(sp + 32 + 8 * g4 + 4 * hf) = y; }
            if (hf == 0) { sp[64] = mM; sp[65] = lA * ca + lB * cb; }
        }
        if (blk0 < cur) {
#pragma unroll
            for (int p = 0; p < 4; ++p) { *(LAS u32x4*)(Kt + (sr + 64 * p) * 72 + sc) = kreg[p]; *(LAS u32x4*)(Vt + sr * 264 + sc + 64 * p) = vreg[p]; }
            __syncthreads();
        }
        }
    }
    for (int blk = 1; blk <= cur; blk += 2) {
    {
        const bool own = false;
        if (blk < cur) { const int kb1 = blk * 256;
#pragma unroll
            for (int p = 0; p < 4; ++p) { kreg[p] = *(const u32x4*)(kg + (size_t)(kb1 + 64 * p) * 64); vreg[p] = *(const u32x4*)(vg + (size_t)(kb1 >> 8) * 16384 + 64 * p); } }
        if (!own) {
            qlc = qln; ntc = ntn; validc = validn;
            if (blk < cur) { moba_assign(msk + blk * 8, 32 * w + qi, qln, validn, ntn); if (ntn <= 4) moba_assign(msk + blk * 8, 32 * (w >> 1) + qi, qln, validn, ntn);
#pragma unroll
                for (int st = 0; st < 4; ++st) gqB[st] = *(const bf16x8*)(Q + (size_t)(row0 + qln) * 512 + h * 64 + 16 * st + 8 * hf); }
            pairm = ntc <= 4; tq = pairm ? (w >> 1) : w; second = pairm && (w & 1);
            if (second) {
#pragma unroll
                for (int e = 0; e < 16; ++e) { o0[e] = 0.f; o1[e] = 0.f; }
                mrun = NEGBIG; lrun = 0.f;
            } else if (tq < ntc) { const LAS float* sp = stt + qlc * 68;
#pragma unroll
                for (int g4 = 0; g4 < 4; ++g4) { const f32x4 a = *(const LAS f32x4*)(sp + 8 * g4 + 4 * hf), c = *(const LAS f32x4*)(sp + 32 + 8 * g4 + 4 * hf);
#pragma unroll
                    for (int e = 0; e < 4; ++e) { o0[4 * g4 + e] = a[e]; o1[4 * g4 + e] = c[e]; } }
                mrun = sp[64]; lrun = hf == 0 ? sp[65] : 0.f; }
        }
        const bool allowed = own || validc;
        const int tlo = (!own && second) ? 2 : 0, thi = (!own && pairm && !second) ? 2 : 4;
        for (int ti = tlo; ti < thi; ++ti) {
            bool active, partial = false;
            if (own) { const int klo = 64 * ti, qlo = 32 * w; active = !(klo > qlo + 31); partial = (klo + 63 > qlo); }
            else active = (tq < ntc);
            if (active) {
                f32x16 s0, s1;
#pragma unroll
                for (int e = 0; e < 16; ++e) { s0[e] = 0.f; s1[e] = 0.f; }
                const LAS bf16_t* kt = Kt + (64 * ti) * 72;
#pragma unroll
                for (int st = 0; st < 4; ++st) { const bf16x8 a0 = *(const LAS bf16x8*)(kt + krow * 72 + 16 * st + 8 * hf), a1 = *(const LAS bf16x8*)(kt + (32 + krow) * 72 + 16 * st + 8 * hf);
                    s0 = MFMA32(a0, gqA[st], s0); s1 = MFMA32(a1, gqA[st], s1); }
                if (partial) { const int qrel = 32 * w + qi - 64 * ti;
#pragma unroll
                    for (int e = 0; e < 16; ++e) { const int ko = 16 * (e >> 3) + 8 * hf + (e & 7); if (ko > qrel) s0[e] = NEGBIG; if (ko + 32 > qrel) s1[e] = NEGBIG; } }
                float mx = s0[0];
#pragma unroll
                for (int e = 1; e < 16; ++e) mx = fmaxf(mx, s0[e]);
#pragma unroll
                for (int e = 0; e < 16; ++e) mx = fmaxf(mx, s1[e]);
                if (!allowed) mx = NEGBIG;
                mx = fmaxf(mx, __shfl_xor(mx, 32));
                const bool need = mx > mrun + 40.f;
                if (__ballot(need) != 0ull) {
                    const float mn = need ? mx : mrun, alpha = __builtin_amdgcn_exp2f(mrun - mn); mrun = mn; lrun *= alpha;
#pragma unroll
                    for (int e = 0; e < 16; ++e) { o0[e] *= alpha; o1[e] *= alpha; }
                }
                const float msub = allowed ? mrun : 1e30f;
                f32x2 ps2 = {0.f, 0.f};
#pragma unroll
                for (int e = 0; e < 16; e += 2) { f32x2 d0 = {s0[e], s0[e + 1]}, d1 = {s1[e], s1[e + 1]}; d0 = d0 - msub; d1 = d1 - msub;
                    s0[e] = __builtin_amdgcn_exp2f(d0.x); s0[e + 1] = __builtin_amdgcn_exp2f(d0.y); s1[e] = __builtin_amdgcn_exp2f(d1.x); s1[e + 1] = __builtin_amdgcn_exp2f(d1.y);
                    ps2 = ps2 + (f32x2){s0[e], s0[e + 1]}; ps2 = ps2 + (f32x2){s1[e], s1[e + 1]}; }
                lrun += ps2.x + ps2.y;
                const LAS bf16_t* vt = Vt + 64 * ti;
#pragma unroll
                for (int kh = 0; kh < 2; ++kh)
#pragma unroll
                    for (int s = 0; s < 2; ++s) {
                        union { u32x4 u; bf16x8 v; } pf;
                        if (kh == 0) { pf.u.x = cvt_pk_bf16(s0[8 * s], s0[8 * s + 1]); pf.u.y = cvt_pk_bf16(s0[8 * s + 2], s0[8 * s + 3]); pf.u.z = cvt_pk_bf16(s0[8 * s + 4], s0[8 * s + 5]); pf.u.w = cvt_pk_bf16(s0[8 * s + 6], s0[8 * s + 7]); }
                        else { pf.u.x = cvt_pk_bf16(s1[8 * s], s1[8 * s + 1]); pf.u.y = cvt_pk_bf16(s1[8 * s + 2], s1[8 * s + 3]); pf.u.z = cvt_pk_bf16(s1[8 * s + 4], s1[8 * s + 5]); pf.u.w = cvt_pk_bf16(s1[8 * s + 6], s1[8 * s + 7]); }
                        const bf16x8 v0 = *(const LAS bf16x8*)(vt + qi * 264 + 32 * kh + 16 * s + 8 * hf), v1 = *(const LAS bf16x8*)(vt + (32 + qi) * 264 + 32 * kh + 16 * s + 8 * hf);
                        o0 = MFMA32(v0, pf.v, o0); o1 = MFMA32(v1, pf.v, o1);
                    }
            }
        }
        if (own || (!second && tq < ntc && validc)) {
            const float lt = lrun + __shfl_xor(lrun, 32);
            LAS float* sp = stt + qlc * 68;
#pragma unroll
            for (int g4 = 0; g4 < 4; ++g4) { f32x4 a, c;
#pragma unroll
                for (int e = 0; e < 4; ++e) { a[e] = o0[4 * g4 + e]; c[e] = o1[4 * g4 + e]; }
                *(LAS f32x4*)(sp + 8 * g4 + 4 * hf) = a; *(LAS f32x4*)(sp + 32 + 8 * g4 + 4 * hf) = c; }
            if (hf == 0) { sp[64] = mrun; sp[65] = lt; }
        }
        __syncthreads();
        if (!own && second && tq < ntc && validc) {
            const float lB = lrun + __shfl_xor(lrun, 32);
            LAS float* sp = stt + qlc * 68;
            const float mA = sp[64], lA = sp[65], mM = fmaxf(mA, mrun), ca = __builtin_amdgcn_exp2f(mA - mM), cb = __builtin_amdgcn_exp2f(mrun - mM);
#pragma unroll
            for (int g4 = 0; g4 < 4; ++g4) { f32x4 x = *(const LAS f32x4*)(sp + 8 * g4 + 4 * hf), y = *(const LAS f32x4*)(sp + 32 + 8 * g4 + 4 * hf);
#pragma unroll
                for (int e = 0; e < 4; ++e) { x[e] = x[e] * ca + o0[4 * g4 + e] * cb; y[e] = y[e] * ca + o1[4 * g4 + e] * cb; }
                *(LAS f32x4*)(sp + 8 * g4 + 4 * hf) = x; *(LAS f32x4*)(sp + 32 + 8 * g4 + 4 * hf) = y; }
            if (hf == 0) { sp[64] = mM; sp[65] = lA * ca + lB * cb; }
        }
        if (blk < cur) {
#pragma unroll
            for (int p = 0; p < 4; ++p) { *(LAS u32x4*)(Kt + (sr + 64 * p) * 72 + sc) = kreg[p]; *(LAS u32x4*)(Vt + sr * 264 + sc + 64 * p) = vreg[p]; }
            __syncthreads();
        }
        }
        if (blk + 1 <= cur) { const int blkb = blk + 1;
    {
        const bool own = false;
        if (blkb < cur) { const int kb1 = blkb * 256;
#pragma unroll
            for (int p = 0; p < 4; ++p) { kreg[p] = *(const u32x4*)(kg + (size_t)(kb1 + 64 * p) * 64); vreg[p] = *(const u32x4*)(vg + (size_t)(kb1 >> 8) * 16384 + 64 * p); } }
        if (!own) {
            qlc = qln; ntc = ntn; validc = validn;
            if (blkb < cur) { moba_assign(msk + blkb * 8, 32 * w + qi, qln, validn, ntn); if (ntn <= 4) moba_assign(msk + blkb * 8, 32 * (w >> 1) + qi, qln, validn, ntn);
#pragma unroll
                for (int st = 0; st < 4; ++st) gqA[st] = *(const bf16x8*)(Q + (size_t)(row0 + qln) * 512 + h * 64 + 16 * st + 8 * hf); }
            pairm = ntc <= 4; tq = pairm ? (w >> 1) : w; second = pairm && (w & 1);
            if (second) {
#pragma unroll
                for (int e = 0; e < 16; ++e) { o0[e] = 0.f; o1[e] = 0.f; }
                mrun = NEGBIG; lrun = 0.f;
            } else if (tq < ntc) { const LAS float* sp = stt + qlc * 68;
#pragma unroll
                for (int g4 = 0; g4 < 4; ++g4) { const f32x4 a = *(const LAS f32x4*)(sp + 8 * g4 + 4 * hf), c = *(const LAS f32x4*)(sp + 32 + 8 * g4 + 4 * hf);
#pragma unroll
                    for (int e = 0; e < 4; ++e) { o0[4 * g4 + e] = a[e]; o1[4 * g4 + e] = c[e]; } }
                mrun = sp[64]; lrun = hf == 0 ? sp[65] : 0.f; }
        }
        const bool allowed = own || validc;
        const int tlo = (!own && second) ? 2 : 0, thi = (!own && pairm && !second) ? 2 : 4;
        for (int ti = tlo; ti < thi; ++ti) {
            bool active, partial = false;
            if (own) { const int klo = 64 * ti, qlo = 32 * w; active = !(klo > qlo + 31); partial = (klo + 63 > qlo); }
            else active = (tq < ntc);
            if (active) {
                f32x16 s0, s1;
#pragma unroll
                for (int e = 0; e < 16; ++e) { s0[e] = 0.f; s1[e] = 0.f; }
                const LAS bf16_t* kt = Kt + (64 * ti) * 72;
#pragma unroll
                for (int st = 0; st < 4; ++st) { const bf16x8 a0 = *(const LAS bf16x8*)(kt + krow * 72 + 16 * st + 8 * hf), a1 = *(const LAS bf16x8*)(kt + (32 + krow) * 72 + 16 * st + 8 * hf);
                    s0 = MFMA32(a0, gqB[st], s0); s1 = MFMA32(a1, gqB[st], s1); }
                if (partial) { const int qrel = 32 * w + qi - 64 * ti;
#pragma unroll
                    for (int e = 0; e < 16; ++e) { const int ko = 16 * (e >> 3) + 8 * hf + (e & 7); if (ko > qrel) s0[e] = NEGBIG; if (ko + 32 > qrel) s1[e] = NEGBIG; } }
                float mx = s0[0];
#pragma unroll
                for (int e = 1; e < 16; ++e) mx = fmaxf(mx, s0[e]);
#pragma unroll
                for (int e = 0; e < 16; ++e) mx = fmaxf(mx, s1[e]);
                if (!allowed) mx = NEGBIG;
                mx = fmaxf(mx, __shfl_xor(mx, 32));
                const bool need = mx > mrun + 40.f;
                if (__ballot(need) != 0ull) {
                    const float mn = need ? mx : mrun, alpha = __builtin_amdgcn_exp2f(mrun - mn); mrun = mn; lrun *= alpha;
#pragma unroll
                    for (int e = 0; e < 16; ++e) { o0[e] *= alpha; o1[e] *= alpha; }
                }
                const float msub = allowed ? mrun : 1e30f;
                f32x2 ps2 = {0.f, 0.f};
#pragma unroll
                for (int e = 0; e < 16; e += 2) { f32x2 d0 = {s0[e], s0[e + 1]}, d1 = {s1[e], s1[e + 1]}; d0 = d0 - msub; d1 = d1 - msub;
                    s0[e] = __builtin_amdgcn_exp2f(d0.x); s0[e + 1] = __builtin_amdgcn_exp2f(d0.y); s1[e] = __builtin_amdgcn_exp2f(d1.x); s1[e + 1] = __builtin_amdgcn_exp2f(d1.y);
                    ps2 = ps2 + (f32x2){s0[e], s0[e + 1]}; ps2 = ps2 + (f32x2){s1[e], s1[e + 1]}; }
                lrun += ps2.x + ps2.y;
                const LAS bf16_t* vt = Vt + 64 * ti;
#pragma unroll
                for (int kh = 0; kh < 2; ++kh)
#pragma unroll
                    for (int s = 0; s < 2; ++s) {
                        union { u32x4 u; bf16x8 v; } pf;
                        if (kh == 0) { pf.u.x = cvt_pk_bf16(s0[8 * s], s0[8 * s + 1]); pf.u.y = cvt_pk_bf16(s0[8 * s + 2], s0[8 * s + 3]); pf.u.z = cvt_pk_bf16(s0[8 * s + 4], s0[8 * s + 5]); pf.u.w = cvt_pk_bf16(s0[8 * s + 6], s0[8 * s + 7]); }
                        else { pf.u.x = cvt_pk_bf16(s1[8 * s], s1[8 * s + 1]); pf.u.y = cvt_pk_bf16(s1[8 * s + 2], s1[8 * s + 3]); pf.u.z = cvt_pk_bf16(s1[8 * s + 4], s1[8 * s + 5]); pf.u.w = cvt_pk_bf16(s1[8 * s + 6], s1[8 * s + 7]); }
                        const bf16x8 v0 = *(const LAS bf16x8*)(vt + qi * 264 + 32 * kh + 16 * s + 8 * hf), v1 = *(const LAS bf16x8*)(vt + (32 + qi) * 264 + 32 * kh + 16 * s + 8 * hf);
                        o0 = MFMA32(v0, pf.v, o0); o1 = MFMA32(v1, pf.v, o1);
                    }
            }
        }
        if (own || (!second && tq < ntc && validc)) {
            const float lt = lrun + __shfl_xor(lrun, 32);
            LAS float* sp = stt + qlc * 68;
#pragma unroll
            for (int g4 = 0; g4 < 4; ++g4) { f32x4 a, c;
#pragma unroll
                for (int e = 0; e < 4; ++e) { a[e] = o0[4 * g4 + e]; c[e] = o1[4 * g4 + e]; }
                *(LAS f32x4*)(sp + 8 * g4 + 4 * hf) = a; *(LAS f32x4*)(sp + 32 + 8 * g4 + 4 * hf) = c; }
            if (hf == 0) { sp[64] = mrun; sp[65] = lt; }
        }
        __syncthreads();
        if (!own && second && tq < ntc && validc) {
            const float lB = lrun + __shfl_xor(lrun, 32);
            LAS float* sp = stt + qlc * 68;
            const float mA = sp[64], lA = sp[65], mM = fmaxf(mA, mrun), ca = __builtin_amdgcn_exp2f(mA - mM), cb = __builtin_amdgcn_exp2f(mrun - mM);
#pragma unroll
            for (int g4 = 0; g4 < 4; ++g4) { f32x4 x = *(const LAS f32x4*)(sp + 8 * g4 + 4 * hf), y = *(const LAS f32x4*)(sp + 32 + 8 * g4 + 4 * hf);
#pragma unroll
                for (int e = 0; e < 4; ++e) { x[e] = x[e] * ca + o0[4 * g4 + e] * cb; y[e] = y[e] * ca + o1[4 * g4 + e] * cb; }
                *(LAS f32x4*)(sp + 8 * g4 + 4 * hf) = x; *(LAS f32x4*)(sp + 32 + 8 * g4 + 4 * hf) = y; }
            if (hf == 0) { sp[64] = mM; sp[65] = lA * ca + lB * cb; }
        }
        if (blkb < cur) {
#pragma unroll
            for (int p = 0; p < 4; ++p) { *(LAS u32x4*)(Kt + (sr + 64 * p) * 72 + sc) = kreg[p]; *(LAS u32x4*)(Vt + sr * 264 + sc + 64 * p) = vreg[p]; }
            __syncthreads();
        }
        }
        }
    }
    __syncthreads();
    {
        const LAS float* sp = stt + qown * 68; const float il = 1.f / sp[65];
        bf16_t* op = O + (size_t)(row0 + qown) * 512 + h * 64 + 4 * hf;
#pragma unroll
        for (int g4 = 0; g4 < 4; ++g4) { const f32x4 a = *(const LAS f32x4*)(sp + 8 * g4 + 4 * hf), c = *(const LAS f32x4*)(sp + 32 + 8 * g4 + 4 * hf); u32x2 w0, w1;
            w0.x = cvt_pk_bf16(a[0] * il, a[1] * il); w0.y = cvt_pk_bf16(a[2] * il, a[3] * il); w1.x = cvt_pk_bf16(c[0] * il, c[1] * il); w1.y = cvt_pk_bf16(c[2] * il, c[3] * il);
            *(u32x2*)(op + 8 * g4) = w0; *(u32x2*)(op + 32 + 8 * g4) = w1; }
    }
    __syncthreads();
}

__device__ __forceinline__ void ssm_scan_pairs(LAS unsigned char* lds, unsigned char* ws, int pr0, int prstep) {
    const int tid = tidx();
        LAS float* Es = (LAS float*)lds;
        for (int pr = pr0; pr < 64; pr += prstep) { const int g = pr >> 1, b = pr & 1, p = tid & 63, seg = tid >> 6; const int row0 = g * 512 + b * 256 + seg * 32;
            const float* aT = (const float*)(ws + WS_AT); const float ar = aT[(g * 64 + p) * 2], ai = aT[(g * 64 + p) * 2 + 1];
            const float* S = (const float*)(ws + WS_SOUT) + (size_t)row0 * 128; bf16_t* AP = (bf16_t*)(ws + WS_AP) + (size_t)row0 * AK + 512;
            float sr_[32], si_[32];
#pragma unroll
            for (int e = 0; e < 32; ++e) { sr_[e] = S[(size_t)e * 128 + p]; si_[e] = S[(size_t)e * 128 + 64 + p]; }
            float hr = 0.f, hi_ = 0.f;
#pragma unroll
            for (int e = 0; e < 32; ++e) { const float nr = ar * hr - ai * hi_ + sr_[e], ni = ar * hi_ + ai * hr + si_[e]; hr = nr; hi_ = ni; }
            Es[(seg * 64 + p) * 2] = hr; Es[(seg * 64 + p) * 2 + 1] = hi_;
            float a32r = ar, a32i = ai;
#pragma unroll
            for (int q = 0; q < 5; ++q) { const float nr = a32r * a32r - a32i * a32i, ni = 2.f * a32r * a32i; a32r = nr; a32i = ni; }
            __syncthreads();
            hr = 0.f; hi_ = 0.f;
            for (int j = 0; j < seg; ++j) { const float er = Es[(j * 64 + p) * 2], ei = Es[(j * 64 + p) * 2 + 1]; const float nr = a32r * hr - a32i * hi_ + er, ni = a32r * hi_ + a32i * hr + ei; hr = nr; hi_ = ni; }
#pragma unroll
            for (int e = 0; e < 32; ++e) { bf16_t* o = AP + (size_t)e * AK; o[p] = (bf16_t)(cvt_pk_bf16(hr, 0.f) & 0xffffu); o[64 + p] = (bf16_t)(cvt_pk_bf16(hi_, 0.f) & 0xffffu);
                const float nr = ar * hr - ai * hi_ + sr_[e], ni = ar * hi_ + ai * hr + si_[e]; hr = nr; hi_ = ni; }
            __syncthreads(); }
}

#define XB_TMO      128
#define XB_XCNT(j)  (256  + 64 * (j))
#define XB_XSUB(j)  (1280 + 64 * (j))
#define XB_XGEN(j)  (2304 + 64 * (j))
#define XB_TOP      3328
#define XB_TOPGEN   3392
#define XCD_BAR_WORDS 3456
#define XB_SPIN_CAP (1u << 18)
__device__ __forceinline__ unsigned xb_ld(unsigned* p)              { return __hip_atomic_load(p, __ATOMIC_RELAXED, __HIP_MEMORY_SCOPE_AGENT); }
__device__ __forceinline__ unsigned xb_add(unsigned* p, unsigned v) { return __hip_atomic_fetch_add(p, v, __ATOMIC_RELAXED, __HIP_MEMORY_SCOPE_AGENT); }
__device__ __forceinline__ unsigned xb_xcc_id() { return (unsigned)__builtin_amdgcn_s_getreg((3 << 11) | 20) & 0xFu; }
#define XB_SPIN(cond, bar) do { unsigned _sp = 0; while (cond) { __builtin_amdgcn_s_sleep(1); \
    if ((++_sp & 255u) == 0u) { if (xb_ld(&(bar)[XB_TMO])) break; if (_sp > XB_SPIN_CAP) { atomicAdd(&(bar)[XB_TMO], 1u); break; } } } } while (0)
struct XcdBarrier { unsigned* bar; unsigned x; volatile LAS unsigned* st; };
__device__ __forceinline__ XcdBarrier xcd_barrier_post(unsigned* bar, volatile LAS unsigned* st) {
    XcdBarrier b; b.bar = bar; b.x = xb_xcc_id(); b.st = st;
    if (tidx() == 0) (void)xb_add(&bar[XB_XCNT(b.x)], 1u);
    return b;
}
__device__ __forceinline__ void xcd_barrier_complete(unsigned* bar, unsigned x, unsigned& nloc, unsigned& nx) {
    const unsigned G = gridDim.x * gridDim.y * gridDim.z;
    unsigned sum, cnt, mine, sp = 0u;
    for (;;) {
        sum = 0u; cnt = 0u; mine = 0u;
#pragma unroll
        for (unsigned j = 0; j < 16; ++j) { const unsigned c = xb_ld(&bar[XB_XCNT(j)]); sum += c; cnt += (c > 0u) ? 1u : 0u; mine = (j == x) ? c : mine; }
        if (sum == G) break;
        __builtin_amdgcn_s_sleep(1);
        if ((++sp & 255u) == 0u) { if (xb_ld(&bar[XB_TMO])) break; if (sp > XB_SPIN_CAP) { atomicAdd(&bar[XB_TMO], 1u); break; } }
    }
    nloc = mine > 0u ? mine : 1u; nx = cnt > 0u ? cnt : 1u;
}
__device__ __forceinline__ void xcd_barrier(const XcdBarrier& b) {
    asm volatile("s_waitcnt vmcnt(0)" ::: "memory");
    __syncthreads();
    if (tidx() == 0) {
        unsigned* bar = b.bar;
        __builtin_amdgcn_s_waitcnt(0);
        unsigned nloc = b.st[0], nx = b.st[1];
        if (nloc == 0u) { xcd_barrier_complete(bar, b.x, nloc, nx); b.st[0] = nloc; b.st[1] = nx; }
        const unsigned old = xb_add(&bar[XB_XSUB(b.x)], 1u);
        const unsigned gen = old / nloc;
        if (old + 1u == (gen + 1u) * nloc) {
            __builtin_amdgcn_fence(__ATOMIC_RELEASE, "agent");
            asm volatile("s_waitcnt vmcnt(0)" ::: "memory");
            const unsigned og = xb_add(&bar[XB_TOP], 1u);
            const unsigned tg = og / nx;
            if (og + 1u == (tg + 1u) * nx) xb_add(&bar[XB_TOPGEN], 1u);
            else XB_SPIN(xb_ld(&bar[XB_TOPGEN]) == tg, bar);
            __builtin_amdgcn_fence(__ATOMIC_ACQUIRE, "agent");
            xb_add(&bar[XB_XGEN(b.x)], 1u);
            asm volatile("s_waitcnt vmcnt(0)" ::: "memory");
        } else {
            XB_SPIN(xb_ld(&bar[XB_XGEN(b.x)]) == gen, bar);
            __builtin_amdgcn_fence(__ATOMIC_ACQUIRE, "agent");
            asm volatile("s_waitcnt vmcnt(0)" ::: "memory");
        }
    }
    __syncthreads();
}

__global__ void __launch_bounds__(512, 2) fwd_kernel(Args a_unused) {
    const ArgsP ap = (ArgsP)__builtin_amdgcn_kernarg_segment_ptr();
    extern __shared__ __attribute__((aligned(16))) unsigned char lds_raw[];
    LAS unsigned char* lds = (LAS unsigned char*)lds_raw;
    cg::grid_group grid = cg::this_grid();
    const int G = gridDim.x, bx = blockIdx.x, tid = tidx();
    const int lo = ap->lo, hi = ap->hi;
    unsigned char* const ws0 = ap->ws;
    XcdBarrier xbar; xbar.bar = (unsigned*)(ws0 + WS_BAR); xbar.x = 0; xbar.st = (volatile LAS unsigned*)(lds + LDS_CTL);
    if (hi - lo > 1) { if (tid < 2) xbar.st[tid] = 0u; __syncthreads(); xbar = xcd_barrier_post((unsigned*)(ws0 + WS_BAR), (volatile LAS unsigned*)(lds + LDS_CTL)); }
    if (lo < 0) grid.sync();
#ifndef PH_MASK
#define PH_MASK 0xffff
#endif
#ifndef DUP_MASK
#define DUP_MASK 0
#endif
#ifndef EXTRA_SYNCS
#define EXTRA_SYNCS 0
#endif
#define REP(k) for (int rep_ = 0; rep_ < 1 + ((DUP_MASK >> (k)) & 1); ++rep_, ((DUP_MASK >> (k)) & 1) ? GSYNC() : (void)0)
#define IN(k) (((PH_MASK >> (k)) & 1) && lo <= (k) && (k) < hi)
#define GSYNC() xcd_barrier(xbar)
#define SEAM(k) do { if (IN(k) && IN((k) + 1)) GSYNC(); } while (0)
#define PHASE_VARS ArgsP a = ap; asm volatile("" : "+s"(a)); unsigned char* ws = a->ws; float* RS0 = (float*)(ws + WS_RS0); float* RS1 = (float*)(ws + WS_RS1); float* RS2 = (float*)(ws + WS_RS2); float* RS3 = (float*)(ws + WS_RS3); \
    bf16_t* XB = (bf16_t*)(ws + WS_XB); bf16_t* ACT = (bf16_t*)(ws + WS_ACT); (void)RS0; (void)RS1; (void)RS2; (void)RS3; (void)XB; (void)ACT;

    REP(0) if (IN(0)) { PHASE_VARS p0_prologue(lds, a); }
    SEAM(0);
    REP(1) if (IN(1)) { PHASE_VARS pg8::Gemm g{XB, (const bf16_t*)(ws + WS_W1GU), 1024, 1024, 1024}; pg8::StaticOrder S; S.init(M, 5632, G, bx);
        EpiGateUp E{ACT, RS0}; pg8::gemm_phase<EpiGateUp, pg8::StaticOrder, true>(lds, g, S, E);
        if (G == 256) {
            const int nmine = bx >= 128 ? 5 : (bx < 112 ? 1 : 0);
            for (int k = 0; k < nmine; ++k) { int gi = bx >= 128 ? (bx - 128) + 128 * k : 640 + bx, base = 0;
                for (int j = 2; j < 8; ++j) { const WJob J = get_job(a, j); const int cnt = (J.K >> 6) * (J.ndst >> 8);
                    if (gi >= base && gi < base + cnt) wconv_item(J, gi - base);
                    base += cnt; } } } }
    SEAM(1);
    if (IN(2)) { PHASE_VARS pg8::Gemm g{ACT, (const bf16_t*)(ws + WS_W1D), FF, FF, FF}; pg8::StaticOrder S; S.init(M, 1024, G, bx);
        EpiResB<true> E{XB, (bf16_t*)a->out, RS1, 0.5f}; pg8::gemm_phase<EpiResB<true>, pg8::StaticOrder, true>(lds, g, S, E); }
    SEAM(2);
    REP(3) if (IN(3)) { PHASE_VARS pg8::Gemm g{(const bf16_t*)a->out, (const bf16_t*)(ws + WS_WIN), 1024, 1024, 1024}; pg8::StaticOrder S; S.init(M, INW, G, bx);
        EpiWin E{RS1, (bf16_t*)(ws + WS_AP), (bf16_t*)(ws + WS_Q), (bf16_t*)(ws + WS_K), (bf16_t*)(ws + WS_VT), (bf16_t*)(ws + WS_GS), (bf16_t*)(ws + WS_GA), (const float*)(ws + WS_ROPE), (float*)(ws + WS_KMEAN)};
        pg8::gemm_phase<EpiWin, pg8::StaticOrder, true>(lds, g, S, E); }
    SEAM(3);
    const bool merged = (G >= 64);
    if (IN(4)) { PHASE_VARS
        if (merged) {
            if (bx < 64) {
                { pg8::Gemm g{(const bf16_t*)(ws + WS_AP), (const bf16_t*)(ws + WS_BTS), 512, AK, 512}; pg8::RangeOrder S{2, 1, bx, 1};
                  EpiS E{(float*)(ws + WS_SOUT)}; pg8::gemm_phase<EpiS, pg8::RangeOrder, true>(lds, g, S, E); }
                asm volatile("s_waitcnt vmcnt(0)" ::: "memory"); __syncthreads();
                ssm_scan_pairs(lds, ws, bx, 64);
                asm volatile("s_waitcnt vmcnt(0)" ::: "memory"); __syncthreads();
                { pg8::Gemm g{(const bf16_t*)(ws + WS_AP), (const bf16_t*)(ws + WS_BTY), AK, AK, AK}; pg8::RangeOrder S{2, 2, 2 * bx, 2};
                  EpiY E{(bf16_t*)(ws + WS_Y)}; pg8::gemm_phase<EpiY, pg8::RangeOrder, true>(lds, g, S, E); }
                asm volatile("s_waitcnt vmcnt(0)" ::: "memory"); __syncthreads();
                if (tid == 0) { __builtin_amdgcn_fence(__ATOMIC_RELEASE, "agent"); asm volatile("s_waitcnt vmcnt(0)" ::: "memory");
                    __hip_atomic_fetch_add((unsigned*)(ws + WS_ATTQ) + 64, 1u, __ATOMIC_RELAXED, __HIP_MEMORY_SCOPE_AGENT); }
                __syncthreads();
            }
            volatile LAS unsigned* qw = (volatile LAS unsigned*)(lds + LDS_CTL + 16);
            for (;;) {
                if (tid == 0) qw[0] = __hip_atomic_fetch_add((unsigned*)(ws + WS_ATTQ), 1u, __ATOMIC_RELAXED, __HIP_MEMORY_SCOPE_AGENT);
                __syncthreads();
                const unsigned u = qw[0];
                __syncthreads();
                if (u >= 640u) break;
                if (u >= 512u) {
                    if (tid == 0) { unsigned sp = 0; while (__hip_atomic_load((unsigned*)(ws + WS_ATTQ) + 64, __ATOMIC_RELAXED, __HIP_MEMORY_SCOPE_AGENT) < 64u) { __builtin_amdgcn_s_sleep(2); if (++sp > (1u << 22)) break; }
                        __builtin_amdgcn_fence(__ATOMIC_ACQUIRE, "agent"); asm volatile("s_waitcnt vmcnt(0)" ::: "memory"); }
                    __syncthreads();
                    pg8::Gemm g{(const bf16_t*)(ws + WS_Y), (const bf16_t*)(ws + WS_WGLU), 512, 512, 512}; pg8::RangeOrder S{64, 2, (int)u - 512, 1};
                    EpiGlu E{(const bf16_t*)(ws + WS_Y), a->in[16], (bf16_t*)(ws + WS_GT)}; pg8::gemm_phase<EpiGlu, pg8::RangeOrder, true>(lds, g, S, E);
                    __syncthreads();
                    continue;
                }
                const int qb = 31 - (int)(u >> 4), bh = (int)(u & 15);
                attn_unit_h(lds, (const bf16_t*)(ws + WS_Q), (const bf16_t*)(ws + WS_K), (const bf16_t*)(ws + WS_VT), (const float*)(ws + WS_KMEAN), (bf16_t*)(ws + WS_ATT), bh >> 3, bh & 7, qb);
            }
        } else {
            { pg8::Gemm g{(const bf16_t*)(ws + WS_AP), (const bf16_t*)(ws + WS_BTS), 512, AK, 512}; pg8::GroupOrder S{2, 1, 64, G, bx};
              EpiS E{(float*)(ws + WS_SOUT)}; pg8::gemm_phase<EpiS, pg8::GroupOrder, true>(lds, g, S, E); }
            __syncthreads();
            for (int pi = bx; pi < 256; pi += G) { const int b = pi >> 7, h = (pi >> 4) & 7, x = pi & 15;
                attn_unit_h(lds, (const bf16_t*)(ws + WS_Q), (const bf16_t*)(ws + WS_K), (const bf16_t*)(ws + WS_VT), (const float*)(ws + WS_KMEAN), (bf16_t*)(ws + WS_ATT), b, h, 31 - x);
                attn_unit_h(lds, (const bf16_t*)(ws + WS_Q), (const bf16_t*)(ws + WS_K), (const bf16_t*)(ws + WS_VT), (const float*)(ws + WS_KMEAN), (bf16_t*)(ws + WS_ATT), b, h, x); }
        }
    }
    SEAM(4);
    if (!merged) {
    if (IN(5)) { PHASE_VARS ssm_scan_pairs(lds, ws, bx, G); }
    SEAM(5);
    if (IN(6)) { PHASE_VARS pg8::Gemm g{(const bf16_t*)(ws + WS_AP), (const bf16_t*)(ws + WS_BTY), AK, AK, AK}; pg8::GroupOrder S{2, 2, 128, G, bx};
        EpiY E{(bf16_t*)(ws + WS_Y)}; pg8::gemm_phase<EpiY, pg8::GroupOrder, true>(lds, g, S, E); }
    }
    if (!merged) SEAM(6);
    if (!merged) if (IN(7)) { PHASE_VARS pg8::Gemm g{(const bf16_t*)(ws + WS_Y), (const bf16_t*)(ws + WS_WGLU), 512, 512, 512}; pg8::StaticOrder S; S.init(M, 512, G, bx);
        EpiGlu E{(const bf16_t*)(ws + WS_Y), a->in[16], (bf16_t*)(ws + WS_GT)}; pg8::gemm_phase<EpiGlu, pg8::StaticOrder, true>(lds, g, S, E); }
    if (!merged) SEAM(7);
    if (IN(8)) { PHASE_VARS
        { pg8::Gemm g{(const bf16_t*)(ws + WS_GT), (const bf16_t*)(ws + WS_WBS), 512, 512, 512}; pg8::StaticOrder S; S.init(M, 1024, G, bx);
          EpiBranch<0> E{(bf16_t*)(ws + WS_GS), (bf16_t*)(ws + WS_GA)}; pg8::gemm_phase<EpiBranch<0>, pg8::StaticOrder, true>(lds, g, S, E); }
        __syncthreads();
        { pg8::Gemm g{(const bf16_t*)(ws + WS_ATT), (const bf16_t*)(ws + WS_WBA), 512, 512, 512}; pg8::StaticOrder S; S.init(M, 1024, G, bx);
          EpiBranch<1> E{(bf16_t*)(ws + WS_GS), (bf16_t*)(ws + WS_GA)}; pg8::gemm_phase<EpiBranch<1>, pg8::StaticOrder, true>(lds, g, S, E); }
    }
    SEAM(8);
    if (IN(9)) { PHASE_VARS pg8::Gemm g{(const bf16_t*)(ws + WS_GA), (const bf16_t*)(ws + WS_WOUT), 1024, 1024, 1024}; pg8::StaticOrder S; S.init(M, 1024, G, bx);
        EpiResB<true> E{(const bf16_t*)a->out, XB, RS2, 1.0f}; pg8::gemm_phase<EpiResB<true>, pg8::StaticOrder, true>(lds, g, S, E); }
    SEAM(9);
    if (IN(10)) { PHASE_VARS pg8::Gemm g{XB, (const bf16_t*)(ws + WS_W2GU), 1024, 1024, 1024}; pg8::StaticOrder S; S.init(M, 5632, G, bx);
        EpiGateUp E{ACT, RS2}; pg8::gemm_phase<EpiGateUp, pg8::StaticOrder, true>(lds, g, S, E);
        if (G == 256 && bx >= 128) { const WJob J = get_job(a, 8);
            for (int gi = bx - 128; gi < 176; gi += 128) wconv_item(J, gi); } }
    SEAM(10);
    const bool fuse_norm = (G == 256);
    if (IN(11)) { PHASE_VARS pg8::Gemm g{ACT, (const bf16_t*)(ws + WS_W2D), FF, FF, FF}; pg8::StaticOrder S; S.init(M, 1024, G, bx);
        if (fuse_norm) { EpiResNorm E{XB, a->out, RS3, (unsigned*)(ws + WS_PCNT), a->in[24], 0.5f}; pg8::gemm_phase<EpiResNorm, pg8::StaticOrder, true>(lds, g, S, E); }
        else { EpiResF E{XB, a->out, RS3, 0.5f}; pg8::gemm_phase<EpiResF, pg8::StaticOrder, true>(lds, g, S, E); } }
    if (!fuse_norm) {
    SEAM(11);
    for (int es_ = 0; es_ < EXTRA_SYNCS; ++es_) GSYNC();
    if (IN(12)) { PHASE_VARS const float* gain = a->in[24]; const int lane = tid & 63, wave = tid >> 6;
        for (int row = bx * 8 + wave; row < M; row += G * 8) { const float s = inv_rms(RS3[row]); f32x4* xr = (f32x4*)(a->out + (size_t)row * DM);
#pragma unroll
            for (int i = 0; i < 4; ++i) { const f32x4 gv = *(const f32x4*)(gain + (lane + 64 * i) * 4); xr[lane + 64 * i] = xr[lane + 64 * i] * s * gv; } } }
    }
#undef IN
#undef SEAM
}

extern "C" void kernel_launch(void* const* d_in, const int* in_sizes, int n_in, void* d_out, int out_size, void* d_ws, size_t ws_size, hipStream_t stream) {
    static int grid = 0;
    if (grid == 0) {
        if (n_in != 25 || out_size != M * DM || ws_size < WS_END) { fprintf(stderr, "kernel_launch: unexpected problem (n_in %d out %d ws %zu need %zu)\n", n_in, out_size, ws_size, (size_t)WS_END); grid = -1; return; }
        int dev = 0, cus = 0, per_cu = 0;
        hipGetDevice(&dev); hipDeviceGetAttribute(&cus, hipDeviceAttributeMultiprocessorCount, dev);
        if (hipFuncSetAttribute((const void*)fwd_kernel, hipFuncAttributeMaxDynamicSharedMemorySize, LDS_BYTES) != hipSuccess) { fprintf(stderr, "kernel_launch: hipFuncSetAttribute failed\n"); grid = -1; return; }
        if (hipOccupancyMaxActiveBlocksPerMultiprocessor(&per_cu, (const void*)fwd_kernel, 512, LDS_BYTES) != hipSuccess || per_cu < 1) { fprintf(stderr, "kernel_launch: occupancy query says %d\n", per_cu); per_cu = 1; }
        (void)hipGetLastError();
        grid = cus * 1;
        if (grid > 256) grid = 256;
    }
    if (grid < 0) return;
    Args a{};
    for (int i = 0; i < 25; ++i) a.in[i] = (const float*)d_in[i];
    a.out = (float*)d_out; a.ws = (unsigned char*)d_ws;
#if MULTI_LAUNCH
    for (int p = 0; p < NPHASE; ++p) { a.lo = p; a.hi = p + 1; hipLaunchKernelGGL(fwd_kernel, dim3(grid), dim3(512), LDS_BYTES, stream, a); }
#else
    a.lo = 0; a.hi = NPHASE;
    (void)hipMemsetAsync((char*)d_ws + WS_BAR, 0, XCD_BAR_WORDS * 4, stream);
    void* args[] = {&a};
    hipError_t e = hipLaunchCooperativeKernel((const void*)fwd_kernel, dim3(grid), dim3(512), args, LDS_BYTES, stream);
    if (e != hipSuccess) fprintf(stderr, "kernel_launch: cooperative launch failed: %s (grid %d)\n", hipGetErrorString(e), grid);
#endif
}
```
